# Optimizing an MI355X kernel written in HIP

```python
import math
import jax, jax.numpy as jnp
from jax import lax
import numpy as np

D_MODEL = 1024
BATCH = 8
SEQ = 4096
DEPTH = 2

HEAD_DIM = 64
NSA_HEADS = 6
NSA_KV_HEADS = 2
NSA_CMP_BLOCK = 32
NSA_CMP_STRIDE = 16
NSA_SEL_BLOCK = 64
NSA_N_SEL = 16
NSA_WINDOW = 512
NSA_CMP_HIDDEN = 256
NSA_Q_BLOCK = 64
MOBA_HEADS = 4
MOBA_BLOCK = 256
MOBA_TOPK = 3
MOBA_Q_BLOCK = 32
DIL_PATTERNS = ((128, 1), (512, 4), (2048, 16))
DIL_HEADS_PER_GROUP = 2
DIL_HEADS = DIL_HEADS_PER_GROUP * len(DIL_PATTERNS)
N_HEADS_TOTAL = NSA_HEADS + MOBA_HEADS + DIL_HEADS
N_BRANCHES = 3
REL_BUCKETS = 32
REL_MAX_EXACT = 16
REL_MAX_DIST = 2048
D_FF = 2816
NORM_EPS = 1e-6
NEG_INF = -1e30
FORCE_SCORE = 1e4

KV_W = NSA_KV_HEADS * HEAD_DIM
IN_LAYOUT = (
    ('nsa_q', NSA_HEADS * HEAD_DIM),
    ('nsa_k_cmp', KV_W), ('nsa_v_cmp', KV_W),
    ('nsa_k_sel', KV_W), ('nsa_v_sel', KV_W),
    ('nsa_k_win', KV_W), ('nsa_v_win', KV_W),
    ('nsa_gate', NSA_HEADS * 3),
    ('moba_q', MOBA_HEADS * HEAD_DIM), ('moba_k', MOBA_HEADS * HEAD_DIM), ('moba_v', MOBA_HEADS * HEAD_DIM),
    ('dil_q', DIL_HEADS * HEAD_DIM), ('dil_k', DIL_HEADS * HEAD_DIM), ('dil_v', DIL_HEADS * HEAD_DIM),
    ('merge_gate', N_BRANCHES * D_MODEL),
)
D_IN = sum(w for _, w in IN_LAYOUT)

kernel_name = 'hybrid_nsa_moba_dilated_macaron'


def rms_norm(x, gain):
    xf = x.astype(jnp.float32)
    y = xf * lax.rsqrt(jnp.mean(xf * xf, axis=-1, keepdims=True) + NORM_EPS)
    return (y * gain.astype(jnp.float32)).astype(x.dtype)


def swiglu(x, w_gate, w_up, w_down):
    return (jax.nn.silu(x @ w_gate) * (x @ w_up)) @ w_down


def rel_bucket(dist):
    n = jnp.maximum(dist, 0)
    nf = jnp.maximum(n, REL_MAX_EXACT).astype(jnp.float32)
    large = REL_MAX_EXACT + (jnp.log(nf / REL_MAX_EXACT) / math.log(REL_MAX_DIST / REL_MAX_EXACT)
                             * (REL_BUCKETS - REL_MAX_EXACT)).astype(jnp.int32)
    large = jnp.minimum(large, REL_BUCKETS - 1)
    return jnp.where(n < REL_MAX_EXACT, n, large)


def masked_softmax(logits, mask):
    l = jnp.where(mask, logits.astype(jnp.float32), NEG_INF)
    m = jnp.max(l, axis=-1, keepdims=True)
    e = jnp.where(mask, jnp.exp(l - m), 0.0)
    s = jnp.maximum(jnp.sum(e, axis=-1, keepdims=True), 1e-30)
    return e / s, (m + jnp.log(s))[..., 0]


def split_columns(proj):
    offs = np.cumsum([w for _, w in IN_LAYOUT])[:-1]
    parts = jnp.split(proj, offs, axis=-1)
    return {name: p for (name, _), p in zip(IN_LAYOUT, parts)}


def nsa_compress(kv, pe, w1, w2):
    B, S, G, hd = kv.shape
    n_cmp = (S - NSA_CMP_BLOCK) // NSA_CMP_STRIDE + 1
    idx = np.arange(n_cmp)[:, None] * NSA_CMP_STRIDE + np.arange(NSA_CMP_BLOCK)[None, :]
    blocks = kv[:, idx] + pe[None, None, :, None, :]
    blocks = blocks.transpose(0, 3, 1, 2, 4).reshape(B, G, n_cmp, NSA_CMP_BLOCK * hd)
    return jax.nn.gelu(blocks @ w1) @ w2


def nsa_mixer(q, k_cmp, v_cmp, k_sel, v_sel, k_win, v_win, gate_logits, bias_tbl,
              pe_k, pe_v, phi_k1, phi_k2, phi_v1, phi_v2):
    B, S, _ = q.shape
    G, R, hd = NSA_KV_HEADS, NSA_HEADS // NSA_KV_HEADS, HEAD_DIM
    scale = hd ** -0.5
    Qb = NSA_Q_BLOCK
    qh = q.reshape(B, S, G, R, hd).transpose(0, 2, 3, 1, 4)
    gates = jax.nn.sigmoid(gate_logits.reshape(B, S, G, R, 3)).transpose(0, 2, 3, 1, 4)
    tbl = bias_tbl.T.reshape(G, R, REL_BUCKETS)
    heads = lambda t: t.reshape(B, S, G, hd)
    kc = nsa_compress(heads(k_cmp), pe_k, phi_k1, phi_k2)
    vc = nsa_compress(heads(v_cmp), pe_v, phi_v1, phi_v2)
    n_cmp = kc.shape[2]
    cmp_end = jnp.arange(n_cmp) * NSA_CMP_STRIDE + NSA_CMP_BLOCK - 1
    n_slc = S // NSA_SEL_BLOCK
    n_sel = min(NSA_N_SEL, n_slc)
    c_start = np.arange(n_cmp) * NSA_CMP_STRIDE
    s_start = np.arange(n_slc) * NSA_SEL_BLOCK
    overlap = (c_start[:, None] < s_start[None, :] + NSA_SEL_BLOCK) & (c_start[:, None] + NSA_CMP_BLOCK > s_start[None, :])
    cmp_to_slc = jnp.asarray(overlap, dtype=jnp.float32)
    ks_blocks = heads(k_sel).transpose(0, 2, 1, 3).reshape(B, G, n_slc, NSA_SEL_BLOCK, hd)
    vs_blocks = heads(v_sel).transpose(0, 2, 1, 3).reshape(B, G, n_slc, NSA_SEL_BLOCK, hd)
    wpad = ((0, 0), (0, 0), (NSA_WINDOW, 0), (0, 0))
    kw_pad = jnp.pad(heads(k_win).transpose(0, 2, 1, 3), wpad)
    vw_pad = jnp.pad(heads(v_win).transpose(0, 2, 1, 3), wpad)
    bi = jnp.arange(B)[:, None, None, None]
    gi = jnp.arange(G)[None, :, None, None]
    ri = jnp.arange(R)[None, None, :, None, None]
    blk = jnp.arange(n_slc)

    def block_step(j):
        q0 = j * Qb
        t = q0 + jnp.arange(Qb)
        qb = lax.dynamic_slice_in_dim(qh, q0, Qb, axis=3)
        gb = lax.dynamic_slice_in_dim(gates, q0, Qb, axis=3)
        dist_c = t[:, None] - cmp_end[None, :]
        logit_c = jnp.einsum('bgrqd,bgkd->bgrqk', qb, kc).astype(jnp.float32) * scale + tbl[:, :, rel_bucket(dist_c)]
        p_c, _ = masked_softmax(logit_c, dist_c >= 0)
        o_c = jnp.einsum('bgrqk,bgkd->bgrqd', p_c.astype(vc.dtype), vc)
        imp = jnp.einsum('bgrqk,ks->bgqs', p_c, cmp_to_slc)
        cur = t // NSA_SEL_BLOCK
        forced = (blk[None, :] == 0) | (blk[None, :] == cur[:, None]) | (blk[None, :] == cur[:, None] - 1)
        future = blk[None, :] * NSA_SEL_BLOCK > t[:, None]
        imp = jnp.where(future, NEG_INF, jnp.where(forced, FORCE_SCORE, imp))
        _, idx = lax.top_k(imp, n_sel)
        ks = ks_blocks[bi, gi, idx].reshape(B, G, Qb, n_sel * NSA_SEL_BLOCK, hd)
        vs = vs_blocks[bi, gi, idx].reshape(B, G, Qb, n_sel * NSA_SEL_BLOCK, hd)
        pos_s = (idx[..., None] * NSA_SEL_BLOCK + jnp.arange(NSA_SEL_BLOCK)).reshape(B, G, Qb, n_sel * NSA_SEL_BLOCK)
        dist_s = t[None, None, :, None] - pos_s
        bias_s = tbl[gi[..., None], ri, rel_bucket(dist_s)[:, :, None]]
        logit_s = jnp.einsum('bgrqd,bgqkd->bgrqk', qb, ks).astype(jnp.float32) * scale + bias_s
        p_s, _ = masked_softmax(logit_s, (dist_s >= 0)[:, :, None])
        o_s = jnp.einsum('bgrqk,bgqkd->bgrqd', p_s.astype(vs.dtype), vs)
        kw = lax.dynamic_slice_in_dim(kw_pad, q0, NSA_WINDOW + Qb, axis=2)
        vw = lax.dynamic_slice_in_dim(vw_pad, q0, NSA_WINDOW + Qb, axis=2)
        pos_w = q0 - NSA_WINDOW + jnp.arange(NSA_WINDOW + Qb)
        dist_w = t[:, None] - pos_w[None, :]
        mask_w = (pos_w[None, :] >= 0) & (dist_w >= 0) & (dist_w < NSA_WINDOW)
        logit_w = jnp.einsum('bgrqd,bgkd->bgrqk', qb, kw).astype(jnp.float32) * scale + tbl[:, :, rel_bucket(dist_w)]
        p_w, _ = masked_softmax(logit_w, mask_w)
        o_w = jnp.einsum('bgrqk,bgkd->bgrqd', p_w.astype(vw.dtype), vw)
        return gb[..., 0:1] * o_c + gb[..., 1:2] * o_s + gb[..., 2:3] * o_w

    out = lax.map(block_step, jnp.arange(S // Qb))
    return out.transpose(1, 0, 4, 2, 3, 5).reshape(B, S, NSA_HEADS * hd)


def moba_mixer(q, k, v, bias_tbl):
    B, S, _ = q.shape
    H, hd, Qb = MOBA_HEADS, HEAD_DIM, MOBA_Q_BLOCK
    scale = hd ** -0.5
    to_heads = lambda t: t.reshape(B, S, H, hd).transpose(0, 2, 1, 3)
    qh, kh, vh = to_heads(q), to_heads(k), to_heads(v)
    nb = -(-S // MOBA_BLOCK)
    pad = ((0, 0), (0, 0), (0, nb * MOBA_BLOCK - S), (0, 0))
    kp, vp = jnp.pad(kh, pad), jnp.pad(vh, pad)
    k_blocks = kp.reshape(B, H, nb, MOBA_BLOCK, hd)
    v_blocks = vp.reshape(B, H, nb, MOBA_BLOCK, hd)
    k_mean = jnp.mean(k_blocks.astype(jnp.float32), axis=3)
    n_top = min(MOBA_TOPK, nb - 1)
    tbl = bias_tbl.T
    bi = jnp.arange(B)[:, None, None, None]
    hi = jnp.arange(H)[None, :, None, None]

    def block_step(j):
        q0 = j * Qb
        c = q0 // MOBA_BLOCK
        t = q0 + jnp.arange(Qb)
        qb = lax.dynamic_slice_in_dim(qh, q0, Qb, axis=2)
        k_own = lax.dynamic_slice_in_dim(kp, c * MOBA_BLOCK, MOBA_BLOCK, axis=2)
        v_own = lax.dynamic_slice_in_dim(vp, c * MOBA_BLOCK, MOBA_BLOCK, axis=2)
        dist_own = t[:, None] - (c * MOBA_BLOCK + jnp.arange(MOBA_BLOCK))[None, :]
        logit_own = jnp.einsum('bhqd,bhkd->bhqk', qb, k_own).astype(jnp.float32) * scale + tbl[:, rel_bucket(dist_own)]
        mask_own = jnp.broadcast_to(dist_own >= 0, logit_own.shape)
        if n_top > 0:
            gate = jnp.einsum('bhqd,bhnd->bhqn', qb.astype(jnp.float32), k_mean)
            gate = jnp.where(jnp.arange(nb) < c, gate, NEG_INF)
            _, idx = lax.top_k(gate, n_top)
            sel_ok = idx < c
            n_k = n_top * MOBA_BLOCK
            ks = k_blocks[bi, hi, idx].reshape(B, H, Qb, n_k, hd)
            vs = v_blocks[bi, hi, idx].reshape(B, H, Qb, n_k, hd)
            pos = (idx[..., None] * MOBA_BLOCK + jnp.arange(MOBA_BLOCK)).reshape(B, H, Qb, n_k)
            dist_sel = t[None, None, :, None] - pos
            logit_sel = jnp.einsum('bhqd,bhqkd->bhqk', qb, ks).astype(jnp.float32) * scale + tbl[hi, rel_bucket(dist_sel)]
            mask_sel = jnp.repeat(sel_ok, MOBA_BLOCK, axis=-1)
            p, _ = masked_softmax(jnp.concatenate([logit_sel, logit_own], axis=-1),
                                  jnp.concatenate([mask_sel, mask_own], axis=-1))
            p = p.astype(v.dtype)
            return (jnp.einsum('bhqk,bhqkd->bhqd', p[..., :n_k], vs)
                    + jnp.einsum('bhqk,bhkd->bhqd', p[..., n_k:], v_own))
        p, _ = masked_softmax(logit_own, mask_own)
        return jnp.einsum('bhqk,bhkd->bhqd', p.astype(v.dtype), v_own)

    out = lax.map(block_step, jnp.arange(S // Qb))
    return out.transpose(1, 0, 3, 2, 4).reshape(B, S, H * hd)


def dilated_group(q, k, v, tbl, window, dilation):
    B, S, h, hd = q.shape
    scale = hd ** -0.5
    L = S // dilation
    wb = window // dilation
    n_blk = -(-L // wb)
    Lp = n_blk * wb

    def to_sub(t, front):
        t = t.reshape(B, L, dilation, h, hd).transpose(0, 2, 3, 1, 4)
        return jnp.pad(t, ((0, 0), (0, 0), (0, 0), (front, Lp - L), (0, 0)))

    def band(t):
        tp = to_sub(t, wb)
        prev = tp[:, :, :, :Lp].reshape(B, dilation, h, n_blk, wb, hd)
        cur = tp[:, :, :, wb:].reshape(B, dilation, h, n_blk, wb, hd)
        return jnp.concatenate([prev, cur], axis=4)

    qs = to_sub(q, 0).reshape(B, dilation, h, n_blk, wb, hd)
    kb, vb = band(k), band(v)
    qa, ka = np.arange(wb), np.arange(2 * wb)
    delta = wb + qa[:, None] - ka[None, :]
    key_idx = np.arange(n_blk)[:, None] * wb - wb + ka[None, :]
    mask = jnp.asarray(((delta >= 0) & (delta <= wb))[None] & (key_idx >= 0)[:, None, :])
    bias = tbl[:, rel_bucket(jnp.asarray(delta * dilation))]
    logits = jnp.einsum('bdhnqc,bdhnkc->bdhnqk', qs, kb).astype(jnp.float32) * scale + bias[None, None, :, None]
    p, lse = masked_softmax(logits, mask)
    o = jnp.einsum('bdhnqk,bdhnkc->bdhnqc', p.astype(v.dtype), vb)
    o = o.reshape(B, dilation, h, Lp, hd)[:, :, :, :L].transpose(0, 3, 1, 2, 4).reshape(B, S, h, hd)
    lse = lse.reshape(B, dilation, h, Lp)[:, :, :, :L].transpose(0, 3, 1, 2).reshape(B, S, h)
    return o, lse


def dilated_mixer(q, k, v, bias_tbl):
    B, S, _ = q.shape
    h, hd = DIL_HEADS_PER_GROUP, HEAD_DIM
    outs, lses = [], []
    for g, (window, dilation) in enumerate(DIL_PATTERNS):
        sl = slice(g * h * hd, (g + 1) * h * hd)
        o, lse = dilated_group(q[..., sl].reshape(B, S, h, hd), k[..., sl].reshape(B, S, h, hd),
                               v[..., sl].reshape(B, S, h, hd), bias_tbl[:, g * h:(g + 1) * h].T,
                               window, dilation)
        outs.append(o)
        lses.append(lse)
    alpha = jax.nn.softmax(jnp.stack(lses, axis=0), axis=0)
    o = jnp.sum(alpha[..., None].astype(q.dtype) * jnp.stack(outs, axis=0), axis=0)
    return o.reshape(B, S, h * hd)


def hybrid_mixer(h, w_in, rel_bias, pe_k, pe_v, phi_k1, phi_k2, phi_v1, phi_v2, w_up_a, w_up_b, w_up_c, w_o):
    B, S, D = h.shape
    cols = split_columns(h @ w_in)
    bias_a = rel_bias[:, :NSA_HEADS]
    bias_b = rel_bias[:, NSA_HEADS:NSA_HEADS + MOBA_HEADS]
    bias_c = rel_bias[:, NSA_HEADS + MOBA_HEADS:]
    y_a = nsa_mixer(cols['nsa_q'], cols['nsa_k_cmp'], cols['nsa_v_cmp'], cols['nsa_k_sel'], cols['nsa_v_sel'],
                    cols['nsa_k_win'], cols['nsa_v_win'], cols['nsa_gate'], bias_a,
                    pe_k, pe_v, phi_k1, phi_k2, phi_v1, phi_v2)
    y_b = moba_mixer(cols['moba_q'], cols['moba_k'], cols['moba_v'], bias_b)
    y_c = dilated_mixer(cols['dil_q'], cols['dil_k'], cols['dil_v'], bias_c)
    gates = jax.nn.sigmoid(cols['merge_gate']).reshape(B, S, N_BRANCHES, D)
    merged = gates[:, :, 0] * (y_a @ w_up_a) + gates[:, :, 1] * (y_b @ w_up_b) + gates[:, :, 2] * (y_c @ w_up_c)
    return merged @ w_o


def setup_inputs(seed: int = 0) -> dict:
    key = jax.random.key(seed)
    ks = jax.random.split(key, 24)
    f32 = jnp.float32
    nrm = lambda k, shape, fan_in: jax.random.normal(k, shape, f32) * fan_in ** -0.5
    gain = lambda k, shape: 1.0 + 0.01 * jax.random.normal(k, shape, f32)
    L_HD = NSA_CMP_BLOCK * HEAD_DIM
    return {
        'x': jax.random.normal(ks[0], (BATCH, SEQ, D_MODEL), f32),
        'rel_bias': 0.1 * jax.random.normal(ks[1], (REL_BUCKETS, N_HEADS_TOTAL), f32),
        'ffn1_norm': gain(ks[2], (DEPTH, D_MODEL)),
        'ffn1_w_gate': nrm(ks[3], (DEPTH, D_MODEL, D_FF), D_MODEL),
        'ffn1_w_up': nrm(ks[4], (DEPTH, D_MODEL, D_FF), D_MODEL),
        'ffn1_w_down': nrm(ks[5], (DEPTH, D_FF, D_MODEL), D_FF),
        'mix_norm': gain(ks[6], (DEPTH, D_MODEL)),
        'w_in': nrm(ks[7], (DEPTH, D_MODEL, D_IN), D_MODEL),
        'nsa_pe_k': 0.02 * jax.random.normal(ks[8], (DEPTH, NSA_CMP_BLOCK, HEAD_DIM), f32),
        'nsa_pe_v': 0.02 * jax.random.normal(ks[9], (DEPTH, NSA_CMP_BLOCK, HEAD_DIM), f32),
        'nsa_phi_k1': nrm(ks[10], (DEPTH, L_HD, NSA_CMP_HIDDEN), L_HD),
        'nsa_phi_k2': nrm(ks[11], (DEPTH, NSA_CMP_HIDDEN, HEAD_DIM), NSA_CMP_HIDDEN),
        'nsa_phi_v1': nrm(ks[12], (DEPTH, L_HD, NSA_CMP_HIDDEN), L_HD),
        'nsa_phi_v2': nrm(ks[13], (DEPTH, NSA_CMP_HIDDEN, HEAD_DIM), NSA_CMP_HIDDEN),
        'w_up_a': nrm(ks[14], (DEPTH, NSA_HEADS * HEAD_DIM, D_MODEL), NSA_HEADS * HEAD_DIM),
        'w_up_b': nrm(ks[15], (DEPTH, MOBA_HEADS * HEAD_DIM, D_MODEL), MOBA_HEADS * HEAD_DIM),
        'w_up_c': nrm(ks[16], (DEPTH, DIL_HEADS_PER_GROUP * HEAD_DIM, D_MODEL), DIL_HEADS_PER_GROUP * HEAD_DIM),
        'w_o': nrm(ks[17], (DEPTH, D_MODEL, D_MODEL), D_MODEL),
        'ffn2_norm': gain(ks[18], (DEPTH, D_MODEL)),
        'ffn2_w_gate': nrm(ks[19], (DEPTH, D_MODEL, D_FF), D_MODEL),
        'ffn2_w_up': nrm(ks[20], (DEPTH, D_MODEL, D_FF), D_MODEL),
        'ffn2_w_down': nrm(ks[21], (DEPTH, D_FF, D_MODEL), D_FF),
        'final_norm': gain(ks[22], (D_MODEL,)),
    }


def reference(x, rel_bias, ffn1_norm, ffn1_w_gate, ffn1_w_up, ffn1_w_down, mix_norm, w_in,
              nsa_pe_k, nsa_pe_v, nsa_phi_k1, nsa_phi_k2, nsa_phi_v1, nsa_phi_v2,
              w_up_a, w_up_b, w_up_c, w_o, ffn2_norm, ffn2_w_gate, ffn2_w_up, ffn2_w_down, final_norm):
    for l in range(DEPTH):
        x = x + 0.5 * swiglu(rms_norm(x, ffn1_norm[l]), ffn1_w_gate[l], ffn1_w_up[l], ffn1_w_down[l])
        x = x + hybrid_mixer(rms_norm(x, mix_norm[l]), w_in[l], rel_bias,
                             nsa_pe_k[l], nsa_pe_v[l], nsa_phi_k1[l], nsa_phi_k2[l], nsa_phi_v1[l], nsa_phi_v2[l],
                             w_up_a[l], w_up_b[l], w_up_c[l], w_o[l])
        x = x + 0.5 * swiglu(rms_norm(x, ffn2_norm[l]), ffn2_w_gate[l], ffn2_w_up[l], ffn2_w_down[l])
    return rms_norm(x, final_norm)
```

```cpp
#include <hip/hip_runtime.h>
#include <hip/hip_cooperative_groups.h>
#include <stdint.h>
#include <stdio.h>
#include <string.h>
namespace cg = cooperative_groups;

#ifndef MEGA
#define MEGA 1
#endif

typedef unsigned short bf16_t;
typedef short bf16x8 __attribute__((ext_vector_type(8)));
typedef short s16x4 __attribute__((ext_vector_type(4)));
typedef float f32x16 __attribute__((ext_vector_type(16)));
typedef float f32x4 __attribute__((ext_vector_type(4)));
typedef unsigned u32x4 __attribute__((ext_vector_type(4)));
typedef unsigned u32x2 __attribute__((ext_vector_type(2)));

#define DI __device__ __forceinline__
#define MFMA32(a, b, c) __builtin_amdgcn_mfma_f32_32x32x16_bf16((a), (b), (c), 0, 0, 0)
#define NEGINF (-__builtin_inff())

constexpr int NB = 8, SEQ = 4096, DM = 1024, NT = NB * SEQ, DFF = 2816;
constexpr int NTHREADS = 512;

constexpr size_t W_GU = 5632ull * 1024, W_DN = 1024ull * 2816, W_INM = 3200ull * 1024, W_ING = 3072ull * 1024,
                 W_P1 = 256ull * 2048, W_P2 = 128ull * 256, W_UA = 1024ull * 384, W_UB = 1024ull * 256, W_UC = 1024ull * 128, W_WO = 1024ull * 1024;
constexpr size_t OW_GU1 = 0, OW_DN1 = OW_GU1 + W_GU, OW_GU2 = OW_DN1 + W_DN, OW_DN2 = OW_GU2 + W_GU, OW_INM = OW_DN2 + W_DN,
                 OW_ING = OW_INM + W_INM, OW_PK1 = OW_ING + W_ING, OW_PV1 = OW_PK1 + W_P1, OW_PK2 = OW_PV1 + W_P1, OW_PV2 = OW_PK2 + W_P2,
                 OW_UA = OW_PV2 + W_P2, OW_UB = OW_UA + W_UA, OW_UC = OW_UB + W_UB, OW_WO = OW_UC + W_UC, W_LAYER = OW_WO + W_WO;
constexpr size_t OFF_W = 0;
constexpr size_t OFF_MISC = OFF_W + 2 * W_LAYER * 2;
constexpr size_t OFF_HN = OFF_MISC + 8192;
constexpr size_t OFF_C = OFF_HN + (size_t)NT * DM * 2;
constexpr size_t OFF_FFH = OFF_C;
constexpr size_t OFF_QN = OFF_C;
constexpr size_t OFF_QM = OFF_QN + (size_t)NT * 384 * 2;
constexpr size_t OFF_QD = OFF_QM + (size_t)NT * 256 * 2;
constexpr size_t OFF_MERGED = OFF_C;
constexpr size_t SZ_G2 = 16ull * 4096 * 64 * 2;
constexpr size_t OFF_KCMP = OFF_QD + (size_t)NT * 384 * 2;
constexpr size_t OFF_VCMP = OFF_KCMP + SZ_G2 + 4096;
constexpr size_t OFF_KSEL = OFF_VCMP + SZ_G2 + 4096;
constexpr size_t OFF_VSELT = OFF_KSEL + SZ_G2;
constexpr size_t OFF_KWIN = OFF_VSELT + SZ_G2;
constexpr size_t OFF_VWINT = OFF_KWIN + SZ_G2;
constexpr size_t OFF_KM = OFF_VWINT + SZ_G2;
constexpr size_t OFF_VMT = OFF_KM + 2 * SZ_G2;
constexpr size_t OFF_KD = OFF_VMT + 2 * SZ_G2;
constexpr size_t OFF_VDT = OFF_KD + 3 * SZ_G2;
constexpr size_t OFF_GATES = OFF_VDT + 3 * SZ_G2;
constexpr size_t OFF_H1K = OFF_GATES + (size_t)NT * 18 * 4;
constexpr size_t OFF_H1V = OFF_H1K + 4096ull * 256 * 2;
constexpr size_t OFF_KC = OFF_H1V + 4096ull * 256 * 2;
constexpr size_t OFF_VCT = OFF_KC + 16ull * 256 * 64 * 2;
constexpr size_t OFF_KMEAN = OFF_VCT + 16ull * 256 * 64 * 2;
constexpr size_t OFF_SELM = OFF_KMEAN + 32ull * 16 * 64 * 2;
constexpr size_t OFF_OC = OFF_SELM + 16ull * 4096 * 8;
constexpr size_t OFF_Y = OFF_OC + (size_t)NT * 384 * 2;
constexpr size_t OFF_END = OFF_Y + (size_t)NT * 768 * 2;
static_assert(OFF_FFH + (size_t)NT * DFF * 2 <= OFF_END, "ffh fits");

struct Params {
  const float* in[23];
  float* out;
  char* ws;
};

enum { I_X = 0, I_RELB, I_F1N, I_F1G, I_F1U, I_F1D, I_MIXN, I_WIN, I_PEK, I_PEV, I_PK1, I_PK2, I_PV1, I_PV2, I_UA, I_UB, I_UC, I_WO, I_F2N, I_F2G, I_F2U, I_F2D, I_FINN };

DI int get_tid_() { int t = threadIdx.x; asm volatile("" : "+v"(t)); return t; }
#define TIDX get_tid_()
DI float shx32(float v) { const auto r = __builtin_amdgcn_permlane32_swap(__float_as_uint(v), __float_as_uint(v), false, false); return __uint_as_float((threadIdx.x & 32) ? r[0] : r[1]); }
DI int shx32i(int v) { const auto r = __builtin_amdgcn_permlane32_swap((unsigned)v, (unsigned)v, false, false); return (int)((threadIdx.x & 32) ? r[0] : r[1]); }
DI float ex2(float x) { return __builtin_amdgcn_exp2f(x); }
DI size_t kfrag_idx(int pos, int d) { return ((size_t)((pos >> 5) * 4 + (d >> 4)) * 64 + ((d >> 3) & 1) * 32 + (pos & 31)) * 8 + (d & 7); }
DI size_t vfrag_idx(int pos, int d) { return ((size_t)((pos >> 5) * 8 + ((pos >> 4) & 1) * 4 + (d >> 5) * 2 + ((pos >> 3) & 1)) * 64 + ((pos >> 2) & 1) * 32 + (d & 31)) * 4 + (pos & 3); }
DI bf16_t f2bf(float x) { unsigned r; asm("v_cvt_pk_bf16_f32 %0, %1, %1" : "=v"(r) : "v"(x)); return (bf16_t)(r & 0xffffu); }
DI float bf2f(bf16_t b) { return __uint_as_float(((unsigned)b) << 16); }
DI unsigned pack2(float a, float b) { unsigned r; asm("v_cvt_pk_bf16_f32 %0, %1, %2" : "=v"(r) : "v"(a), "v"(b)); return r; }
DI int crow(int i, int h) { return (i & 3) + 8 * (i >> 2) + 4 * h; }
DI float sigmoidf_(float x) { return 1.f / (1.f + __expf(-x)); }

DI int lds_off(int row, int chunk) { return row * 128 + ((chunk ^ ((row >> 1) & 7)) << 4); }

#define LAS __attribute__((address_space(3)))
constexpr int NSTAGE = 3;
constexpr int STAGE_B = 49152;
constexpr int LDS_BYTES = NSTAGE * STAGE_B;
DI void glds16(const void* g, char* l) { __builtin_amdgcn_global_load_lds((const unsigned*)g, (LAS unsigned*)l, 16, 0, 0); }

template <int PART = 0>
DI void gemm_core(const bf16_t* __restrict__ A, int lda, const bf16_t* __restrict__ Bt, int ldb, int K,
                  f32x16 (&acc)[2][2], char* lds) {
  const int tid = TIDX, lane = tid & 63, wid = tid >> 6, wr = wid >> 1, wc = wid & 1, r = lane & 31, h = lane >> 5;
  const int ch = (tid & 7) ^ ((tid >> 4) & 7);
  unsigned avo[4], bvo[2];
#pragma unroll
  for (int i = 0; i < 4; ++i) avo[i] = (unsigned)(((tid >> 3) + 64 * i) * lda * 2 + ch * 16);
#pragma unroll
  for (int i = 0; i < 2; ++i) bvo[i] = (unsigned)(((tid >> 3) + 64 * i) * ldb * 2 + ch * 16);
  const char* Ab = (const char*)A; const char* Bb = (const char*)Bt;
  char* lw = lds + tid * 16;
  const int nk = K >> 6;
  const unsigned swz = (unsigned)((r >> 1) & 7);
  const unsigned arow_u = (unsigned)((wr * 64 + r) * 128), brow_u = (unsigned)((wc * 64 + r) * 128);
  const unsigned co0 = ((0u + h) ^ swz) << 4, co1 = ((2u + h) ^ swz) << 4, co2 = ((4u + h) ^ swz) << 4, co3 = ((6u + h) ^ swz) << 4;
#define GEMM_ISSUE(kt_, st_) do { char* sb_ = lw + (st_) * STAGE_B; const char* ak_ = Ab + (size_t)(kt_) * 128; const char* bk_ = Bb + (size_t)(kt_) * 128; \
    _Pragma("unroll") for (int i_ = 0; i_ < 4; ++i_) glds16(ak_ + avo[i_], sb_ + i_ * 8192); \
    _Pragma("unroll") for (int i_ = 0; i_ < 2; ++i_) glds16(bk_ + bvo[i_], sb_ + 32768 + i_ * 8192); } while (0)
  if (PART != 2) {
    GEMM_ISSUE(0, 0);
    if (nk > 1) GEMM_ISSUE(1, 1);
  }
  if (PART == 1) return;
  int st = 0;
  for (int kt = 0; kt < nk; ++kt) {
    if (kt + 1 < nk) asm volatile("s_waitcnt vmcnt(6)" ::: "memory");
    else asm volatile("s_waitcnt vmcnt(0)" ::: "memory");
    __builtin_amdgcn_s_barrier();
    asm volatile("" ::: "memory");
    if (kt + 2 < nk) { const int st2 = (st >= 1) ? st - 1 : 2; GEMM_ISSUE(kt + 2, st2); }
    const char* la = lds + st * STAGE_B;
    const char* lb = la + 32768;
    const unsigned sa_u = (unsigned)(size_t)la + arow_u, sb_u = (unsigned)(size_t)lb + brow_u;
    const unsigned a0 = sa_u + co0, a1 = sa_u + co1, a2 = sa_u + co2, a3 = sa_u + co3;
    const unsigned b0 = sb_u + co0, b1 = sb_u + co1, b2 = sb_u + co2, b3 = sb_u + co3;
    {
      bf16x8 p0, p1, q0, q1, u0, u1, w0, w1;
      asm volatile(
        "ds_read_b128 %4, %12\n\tds_read_b128 %5, %12 offset:4096\n\tds_read_b128 %6, %16\n\tds_read_b128 %7, %16 offset:4096\n\t"
        "ds_read_b128 %8, %13\n\tds_read_b128 %9, %13 offset:4096\n\tds_read_b128 %10, %17\n\tds_read_b128 %11, %17 offset:4096\n\t"
        "s_waitcnt lgkmcnt(4)\n\t"
        "v_mfma_f32_32x32x16_bf16 %0, %4, %6, %0\n\tv_mfma_f32_32x32x16_bf16 %1, %4, %7, %1\n\tv_mfma_f32_32x32x16_bf16 %2, %5, %6, %2\n\tv_mfma_f32_32x32x16_bf16 %3, %5, %7, %3\n\t"
        "ds_read_b128 %4, %14\n\tds_read_b128 %5, %14 offset:4096\n\tds_read_b128 %6, %18\n\tds_read_b128 %7, %18 offset:4096\n\t"
        "s_waitcnt lgkmcnt(4)\n\t"
        "v_mfma_f32_32x32x16_bf16 %0, %8, %10, %0\n\tv_mfma_f32_32x32x16_bf16 %1, %8, %11, %1\n\tv_mfma_f32_32x32x16_bf16 %2, %9, %10, %2\n\tv_mfma_f32_32x32x16_bf16 %3, %9, %11, %3\n\t"
        "ds_read_b128 %8, %15\n\tds_read_b128 %9, %15 offset:4096\n\tds_read_b128 %10, %19\n\tds_read_b128 %11, %19 offset:4096\n\t"
        "s_waitcnt lgkmcnt(4)\n\t"
        "v_mfma_f32_32x32x16_bf16 %0, %4, %6, %0\n\tv_mfma_f32_32x32x16_bf16 %1, %4, %7, %1\n\tv_mfma_f32_32x32x16_bf16 %2, %5, %6, %2\n\tv_mfma_f32_32x32x16_bf16 %3, %5, %7, %3\n\t"
        "s_waitcnt lgkmcnt(0)\n\t"
        "v_mfma_f32_32x32x16_bf16 %0, %8, %10, %0\n\tv_mfma_f32_32x32x16_bf16 %1, %8, %11, %1\n\tv_mfma_f32_32x32x16_bf16 %2, %9, %10, %2\n\tv_mfma_f32_32x32x16_bf16 %3, %9, %11, %3"
        : "+v"(acc[0][0]), "+v"(acc[0][1]), "+v"(acc[1][0]), "+v"(acc[1][1]),
          "=&v"(p0), "=&v"(p1), "=&v"(q0), "=&v"(q1), "=&v"(u0), "=&v"(u1), "=&v"(w0), "=&v"(w1)
        : "v"(a0), "v"(a1), "v"(a2), "v"(a3), "v"(b0), "v"(b1), "v"(b2), "v"(b3));
    }
    st = (st == 2) ? 0 : st + 1;
  }
  asm volatile("s_nop 15\n\ts_nop 15\n\ts_nop 7" ::: "memory");
  __builtin_amdgcn_s_barrier();
  asm volatile("" ::: "memory");
}

DI void zero_acc(f32x16 (&acc)[2][2]) {
#pragma unroll
  for (int a = 0; a < 2; ++a)
#pragma unroll
    for (int b = 0; b < 2; ++b)
#pragma unroll
      for (int i = 0; i < 16; ++i) acc[a][b][i] = 0.f;
}

DI bool tile_map(int L, int MT, int NTl, int SN, int& mt, int& nt) {
  const int xcd = L & 7, ix = L >> 3, per = 8 * SN, st = ix / per, w = ix % per;
  const int gst = st * 8 + xcd, SNT = NTl / SN, total = (MT >> 3) * SNT;
  if (gst >= total) return false;
  const int smt = gst / SNT, snt = gst % SNT;
  mt = smt * 8 + (w & 7); nt = snt * SN + (w >> 3);
  return true;
}
DI int tile_lmax(int MT, int NTl, int SN) { const int total = (MT >> 3) * (NTl / SN); return ((total + 7) >> 3) * 8 * SN * 8; }

struct EpiSwiglu {
  static constexpr bool PRE = false;
  bf16_t* ffh;
  DI void operator()(const f32x16 (&acc)[2][2], int m0, int n0) const {
    const int tid = TIDX, lane = tid & 63, wid = tid >> 6, wr = wid >> 1, wc = wid & 1, r = lane & 31, h = lane >> 5;
    const int hid = (n0 >> 7) * 64 + wc * 32 + r;
#pragma unroll
    for (int mi = 0; mi < 2; ++mi)
#pragma unroll
      for (int i = 0; i < 16; ++i) {
        const int row = m0 + wr * 64 + mi * 32 + crow(i, h);
        const float g = acc[mi][0][i], u = acc[mi][1][i];
        ffh[(size_t)row * DFF + hid] = f2bf(g * sigmoidf_(g) * u);
      }
  }
};
struct EpiResid {
  const float* res; float* out; float scale;
  static constexpr bool PRE = true;
  DI void pre(float (&rv)[2][2][16], int m0, int n0) const {
    const int tid = TIDX, lane = tid & 63, wid = tid >> 6, wr = wid >> 1, wc = wid & 1, r = lane & 31, h = lane >> 5;
#pragma unroll
    for (int mi = 0; mi < 2; ++mi)
#pragma unroll
      for (int ni = 0; ni < 2; ++ni)
#pragma unroll
        for (int i = 0; i < 16; ++i)
          rv[mi][ni][i] = res[(size_t)(m0 + wr * 64 + mi * 32 + crow(i, h)) * DM + n0 + wc * 64 + ni * 32 + r];
  }
  DI void operator()(const f32x16 (&acc)[2][2], int m0, int n0, const float (&rv)[2][2][16]) const {
    const int tid = TIDX, lane = tid & 63, wid = tid >> 6, wr = wid >> 1, wc = wid & 1, r = lane & 31, h = lane >> 5;
#pragma unroll
    for (int mi = 0; mi < 2; ++mi)
#pragma unroll
      for (int ni = 0; ni < 2; ++ni)
#pragma unroll
        for (int i = 0; i < 16; ++i)
          out[(size_t)(m0 + wr * 64 + mi * 32 + crow(i, h)) * DM + n0 + wc * 64 + ni * 32 + r] = rv[mi][ni][i] + scale * acc[mi][ni][i];
  }
};
struct EpiGelu {
  static constexpr bool PRE = false;
  bf16_t* o; const float* bias;
  DI void operator()(const f32x16 (&acc)[2][2], int m0, int n0) const {
    const int tid = TIDX, lane = tid & 63, wid = tid >> 6, wr = wid >> 1, wc = wid & 1, r = lane & 31, h = lane >> 5;
#pragma unroll
    for (int mi = 0; mi < 2; ++mi)
#pragma unroll
      for (int ni = 0; ni < 2; ++ni) {
        const int col = n0 + wc * 64 + ni * 32 + r;
        const float bv = bias[col];
#pragma unroll
        for (int i = 0; i < 16; ++i) {
          const int row = m0 + wr * 64 + mi * 32 + crow(i, h);
          const float x = acc[mi][ni][i] + bv;
          o[(size_t)row * 256 + col] = f2bf(x * sigmoidf_(1.5957691216057308f * (x + 0.044715f * x * x * x)));
        }
      }
  }
};
template <int transposed> struct EpiCmpOut {
  static constexpr bool PRE = false;
  bf16_t* o;
  DI void operator()(const f32x16 (&acc)[2][2], int m0, int n0) const {
    const int tid = TIDX, lane = tid & 63, wid = tid >> 6, wr = wid >> 1, wc = wid & 1, r = lane & 31, h = lane >> 5;
    if (wc != 0) return;
#pragma unroll
    for (int mi = 0; mi < 2; ++mi)
#pragma unroll
      for (int ni = 0; ni < 2; ++ni) {
        const int col = ni * 32 + r;
#pragma unroll
        for (int i = 0; i < 16; ++i) {
          const int row = m0 + wr * 64 + mi * 32 + crow(i, h);
          const bf16_t v = f2bf(acc[mi][ni][i]);
          if (transposed) o[(size_t)(row >> 8) * 16384 + vfrag_idx(row & 255, col)] = v;
          else o[(size_t)(row >> 8) * 16384 + kfrag_idx(row & 255, col)] = v;
        }
      }
  }
};
struct EpiWin {
  static constexpr bool PRE = false;
  char* ws;
  DI void operator()(const f32x16 (&acc)[2][2], int m0, int n0) const {
    const int tid = TIDX, lane = tid & 63, wid = tid >> 6, wr = wid >> 1, wc = wid & 1, r = lane & 31, h = lane >> 5;
    const int cidx = (n0 >> 6) + wc;
    if (cidx >= 49) return;
    const int rowbase = m0 + wr * 64;
    const int b = rowbase >> 12;
    int kind;
    bf16_t* base; int ld = 0, colb = 0, hb = 0, dil = 1; bool kfrag = false;
    if (cidx < 6) { kind = 0; base = (bf16_t*)(ws + OFF_QN); ld = 384; colb = cidx * 64; }
    else if (cidx < 18) { const int t = (cidx - 6) >> 1, g = (cidx - 6) & 1; hb = b * 2 + g;
      const size_t off = (t == 0) ? OFF_KCMP : (t == 1) ? OFF_VCMP : (t == 2) ? OFF_KSEL : (t == 3) ? OFF_VSELT : (t == 4) ? OFF_KWIN : OFF_VWINT;
      base = (bf16_t*)(ws + off); kind = (t == 3 || t == 5) ? 2 : 1; kfrag = (t == 2 || t == 4); }
    else if (cidx < 22) { kind = 0; base = (bf16_t*)(ws + OFF_QM); ld = 256; colb = (cidx - 18) * 64; }
    else if (cidx < 26) { kind = 1; kfrag = true; base = (bf16_t*)(ws + OFF_KM); hb = b * 4 + (cidx - 22); }
    else if (cidx < 30) { kind = 2; base = (bf16_t*)(ws + OFF_VMT); hb = b * 4 + (cidx - 26); }
    else if (cidx < 36) { kind = 0; base = (bf16_t*)(ws + OFF_QD); ld = 384; colb = (cidx - 30) * 64; }
    else if (cidx < 42) { kind = 1; kfrag = true; base = (bf16_t*)(ws + OFF_KD); hb = b * 6 + (cidx - 36); const int g = (cidx - 36) >> 1; dil = (g == 0) ? 1 : (g == 1 ? 4 : 16); }
    else if (cidx < 48) { kind = 2; base = (bf16_t*)(ws + OFF_VDT); hb = b * 6 + (cidx - 42); const int g = (cidx - 42) >> 1; dil = (g == 0) ? 1 : (g == 1 ? 4 : 16); }
    else { kind = 3; base = nullptr; }
    if (kind == 0) {
#pragma unroll
      for (int mi = 0; mi < 2; ++mi)
#pragma unroll
        for (int ni = 0; ni < 2; ++ni)
#pragma unroll
          for (int i = 0; i < 16; ++i) {
            const int row = rowbase + mi * 32 + crow(i, h);
            base[(size_t)row * ld + colb + ni * 32 + r] = f2bf(acc[mi][ni][i] * 0.18033688011112042f);
          }
    } else if (kind == 1) {
#pragma unroll
      for (int mi = 0; mi < 2; ++mi)
#pragma unroll
        for (int ni = 0; ni < 2; ++ni)
#pragma unroll
          for (int i = 0; i < 16; ++i) {
            const int s = (rowbase & 4095) + mi * 32 + crow(i, h);
            if (kfrag) { const int pos = (dil == 1) ? s : (s % dil) * (4096 / dil) + s / dil; base[(size_t)hb * 262144 + kfrag_idx(pos, ni * 32 + r)] = f2bf(acc[mi][ni][i]); }
            else base[((size_t)hb * 4096 + s) * 64 + ni * 32 + r] = f2bf(acc[mi][ni][i]);
          }
    } else if (kind == 2) {
      if (dil == 1) {
#pragma unroll
        for (int mi = 0; mi < 2; ++mi)
#pragma unroll
          for (int ni = 0; ni < 2; ++ni)
#pragma unroll
            for (int q = 0; q < 4; ++q) {
              const int s = (rowbase & 4095) + mi * 32 + 8 * q + 4 * h;
              u32x2 v; v.x = pack2(acc[mi][ni][4 * q], acc[mi][ni][4 * q + 1]); v.y = pack2(acc[mi][ni][4 * q + 2], acc[mi][ni][4 * q + 3]);
              *(u32x2*)(base + (size_t)hb * 262144 + vfrag_idx(s, ni * 32 + r)) = v;
            }
      } else {
        const int L = 4096 / dil;
#pragma unroll
        for (int mi = 0; mi < 2; ++mi)
#pragma unroll
          for (int ni = 0; ni < 2; ++ni)
#pragma unroll
            for (int i = 0; i < 16; ++i) {
              const int s = (rowbase & 4095) + mi * 32 + crow(i, h);
              const int pos = (s % dil) * L + s / dil;
              base[(size_t)hb * 262144 + vfrag_idx(pos, ni * 32 + r)] = f2bf(acc[mi][ni][i]);
            }
      }
    } else {
      float* gt = (float*)(ws + OFF_GATES);
      if (r < 18) {
#pragma unroll
        for (int mi = 0; mi < 2; ++mi)
#pragma unroll
          for (int i = 0; i < 16; ++i) {
            const int row = rowbase + mi * 32 + crow(i, h);
            gt[(size_t)row * 18 + r] = sigmoidf_(acc[mi][0][i]);
          }
      }
    }
  }
};

template <class Epi>
DI void gemm_phase(const bf16_t* A, int lda, const bf16_t* Bt, int ldb, int K, int MT, int NTl, int SN, const Epi& epi, char* lds) {
  const int lmax = tile_lmax(MT, NTl, SN);
  int L = blockIdx.x, mt = 0, nt = 0;
  bool have = false;
  for (; L < lmax; L += gridDim.x) if (tile_map(L, MT, NTl, SN, mt, nt)) { have = true; break; }
  f32x16 dummy[2][2];
  if (have) gemm_core<1>(A + (size_t)mt * 256 * lda, lda, Bt + (size_t)nt * 128 * ldb, ldb, K, dummy, lds);
  while (have) {
    f32x16 acc[2][2];
    zero_acc(acc);
    const int cmt = mt, cnt = nt;
    float rv[Epi::PRE ? 2 : 1][2][16];
    if constexpr (Epi::PRE) epi.pre(rv, cmt * 256, cnt * 128);
    gemm_core<2>(A + (size_t)cmt * 256 * lda, lda, Bt + (size_t)cnt * 128 * ldb, ldb, K, acc, lds);
    have = false;
    for (L += gridDim.x; L < lmax; L += gridDim.x) if (tile_map(L, MT, NTl, SN, mt, nt)) { have = true; break; }
    if (have) gemm_core<1>(A + (size_t)mt * 256 * lda, lda, Bt + (size_t)nt * 128 * ldb, ldb, K, dummy, lds);
    if constexpr (Epi::PRE) epi(acc, cmt * 256, cnt * 128, rv); else epi(acc, cmt * 256, cnt * 128);
  }
}

struct ConvD { const float* src; const float* src2; bf16_t* dst; int K, Nsrc, Nout, mode, coloff, nvalid; };
constexpr int CONV_NT[14] = {1408, 704, 1408, 704, 800, 768, 128, 128, 8, 8, 96, 64, 32, 256};
constexpr int CONV_PER_LAYER = 6512;

DI ConvD get_conv(const Params& p, int l, int id) {
  ConvD c; c.src2 = nullptr; c.mode = 0; c.coloff = 0;
  bf16_t* wl = (bf16_t*)(p.ws + OFF_W) + (size_t)l * W_LAYER;
  switch (id) {
    case 0: c.src = p.in[I_F1G] + (size_t)l * 1024 * DFF; c.src2 = p.in[I_F1U] + (size_t)l * 1024 * DFF; c.dst = wl + OW_GU1; c.K = 1024; c.Nsrc = DFF; c.Nout = 5632; c.mode = 1; c.nvalid = 5632; break;
    case 1: c.src = p.in[I_F1D] + (size_t)l * DFF * 1024; c.dst = wl + OW_DN1; c.K = DFF; c.Nsrc = 1024; c.Nout = 1024; c.nvalid = 1024; break;
    case 2: c.src = p.in[I_F2G] + (size_t)l * 1024 * DFF; c.src2 = p.in[I_F2U] + (size_t)l * 1024 * DFF; c.dst = wl + OW_GU2; c.K = 1024; c.Nsrc = DFF; c.Nout = 5632; c.mode = 1; c.nvalid = 5632; break;
    case 3: c.src = p.in[I_F2D] + (size_t)l * DFF * 1024; c.dst = wl + OW_DN2; c.K = DFF; c.Nsrc = 1024; c.Nout = 1024; c.nvalid = 1024; break;
    case 4: c.src = p.in[I_WIN] + (size_t)l * 1024 * 6162; c.dst = wl + OW_INM; c.K = 1024; c.Nsrc = 6162; c.Nout = 3200; c.mode = 2; c.nvalid = 3090; break;
    case 5: c.src = p.in[I_WIN] + (size_t)l * 1024 * 6162; c.dst = wl + OW_ING; c.K = 1024; c.Nsrc = 6162; c.Nout = 3072; c.coloff = 3090; c.nvalid = 3072; break;
    case 6: c.src = p.in[I_PK1] + (size_t)l * 2048 * 256; c.dst = wl + OW_PK1; c.K = 2048; c.Nsrc = 256; c.Nout = 256; c.nvalid = 256; break;
    case 7: c.src = p.in[I_PV1] + (size_t)l * 2048 * 256; c.dst = wl + OW_PV1; c.K = 2048; c.Nsrc = 256; c.Nout = 256; c.nvalid = 256; break;
    case 8: c.src = p.in[I_PK2] + (size_t)l * 256 * 64; c.dst = wl + OW_PK2; c.K = 256; c.Nsrc = 64; c.Nout = 128; c.nvalid = 64; break;
    case 9: c.src = p.in[I_PV2] + (size_t)l * 256 * 64; c.dst = wl + OW_PV2; c.K = 256; c.Nsrc = 64; c.Nout = 128; c.nvalid = 64; break;
    case 10: c.src = p.in[I_UA] + (size_t)l * 384 * 1024; c.dst = wl + OW_UA; c.K = 384; c.Nsrc = 1024; c.Nout = 1024; c.nvalid = 1024; break;
    case 11: c.src = p.in[I_UB] + (size_t)l * 256 * 1024; c.dst = wl + OW_UB; c.K = 256; c.Nsrc = 1024; c.Nout = 1024; c.nvalid = 1024; break;
    case 12: c.src = p.in[I_UC] + (size_t)l * 128 * 1024; c.dst = wl + OW_UC; c.K = 128; c.Nsrc = 1024; c.Nout = 1024; c.nvalid = 1024; break;
    default: c.src = p.in[I_WO] + (size_t)l * 1024 * 1024; c.dst = wl + OW_WO; c.K = 1024; c.Nsrc = 1024; c.Nout = 1024; c.nvalid = 1024; break;
  }
  return c;
}

DI void conv_tile(const ConvD& c, int tn, int tk, float* lds) {
  const int tid = TIDX;
  const int n0 = tn * 64, k0 = tk * 64;
  {
    const int j = tid & 63, np = n0 + j;
    const float* sp = c.src; int col = -1;
    if (c.mode == 0) { if (np < c.nvalid) col = c.coloff + np; }
    else if (c.mode == 1) { const int tile = np >> 7, within = np & 127, wc = within >> 6, part = (within & 63) >> 5, jj = within & 31;
      col = tile * 64 + wc * 32 + jj; if (part) sp = c.src2; }
    else { if (np < 1152) col = np; else if (np < 3072) col = 1170 + (np - 1152); else if (np < 3090) col = 1152 + (np - 3072); }
    float tv[8];
#pragma unroll
    for (int i = 0; i < 8; ++i) {
      const int kk = (tid >> 6) + 8 * i;
      tv[i] = (col >= 0) ? sp[(size_t)(k0 + kk) * c.Nsrc + col] : 0.f;
    }
#pragma unroll
    for (int i = 0; i < 8; ++i) lds[((tid >> 6) + 8 * i) * 65 + j] = tv[i];
  }
  __syncthreads();
  {
    const int kk = tid & 63;
#pragma unroll
    for (int i = 0; i < 8; ++i) {
      const int j = (tid >> 6) + 8 * i;
      c.dst[(size_t)(n0 + j) * c.K + k0 + kk] = f2bf(lds[kk * 65 + j]);
    }
  }
  __syncthreads();
}

DI void rms_phase(const float* x, const float* gain, bf16_t* hn) {
  const int lane = TIDX & 63;
  const int gw = blockIdx.x * 8 + (TIDX >> 6), nw = gridDim.x * 8;
  f32x4 g[4];
#pragma unroll
  for (int i = 0; i < 4; ++i) g[i] = *(const f32x4*)(gain + i * 256 + lane * 4);
  for (int row = gw; row < NT; row += 2 * nw) {
    const int row2 = (row + nw < NT) ? row + nw : row;
    f32x4 v[4], w2[4]; float ss = 0.f, ss2 = 0.f;
#pragma unroll
    for (int i = 0; i < 4; ++i) { v[i] = *(const f32x4*)(x + (size_t)row * DM + i * 256 + lane * 4); w2[i] = *(const f32x4*)(x + (size_t)row2 * DM + i * 256 + lane * 4); }
#pragma unroll
    for (int i = 0; i < 4; ++i) { ss += v[i][0] * v[i][0] + v[i][1] * v[i][1] + v[i][2] * v[i][2] + v[i][3] * v[i][3]; ss2 += w2[i][0] * w2[i][0] + w2[i][1] * w2[i][1] + w2[i][2] * w2[i][2] + w2[i][3] * w2[i][3]; }
#pragma unroll
    for (int o = 32; o >= 1; o >>= 1) { ss += __shfl_xor(ss, o); ss2 += __shfl_xor(ss2, o); }
    const float rs = rsqrtf(ss * (1.f / 1024.f) + 1e-6f), rs2 = rsqrtf(ss2 * (1.f / 1024.f) + 1e-6f);
#pragma unroll
    for (int i = 0; i < 4; ++i) {
      u32x2 w; w.x = pack2(v[i][0] * rs * g[i][0], v[i][1] * rs * g[i][1]); w.y = pack2(v[i][2] * rs * g[i][2], v[i][3] * rs * g[i][3]);
      *(u32x2*)(hn + (size_t)row * DM + i * 256 + lane * 4) = w;
      u32x2 w3; w3.x = pack2(w2[i][0] * rs2 * g[i][0], w2[i][1] * rs2 * g[i][1]); w3.y = pack2(w2[i][2] * rs2 * g[i][2], w2[i][3] * rs2 * g[i][3]);
      *(u32x2*)(hn + (size_t)row2 * DM + i * 256 + lane * 4) = w3;
    }
  }
}
DI void final_norm_phase(float* x, const float* gain) {
  const int lane = TIDX & 63;
  const int gw = blockIdx.x * 8 + (TIDX >> 6), nw = gridDim.x * 8;
  f32x4 g[4];
#pragma unroll
  for (int i = 0; i < 4; ++i) g[i] = *(const f32x4*)(gain + i * 256 + lane * 4);
  for (int row = gw; row < NT; row += nw) {
    f32x4 v[4]; float ss = 0.f;
#pragma unroll
    for (int i = 0; i < 4; ++i) { v[i] = *(const f32x4*)(x + (size_t)row * DM + i * 256 + lane * 4); ss += v[i][0] * v[i][0] + v[i][1] * v[i][1] + v[i][2] * v[i][2] + v[i][3] * v[i][3]; }
#pragma unroll
    for (int o = 32; o >= 1; o >>= 1) ss += __shfl_xor(ss, o);
    const float rs = rsqrtf(ss * (1.f / 1024.f) + 1e-6f);
#pragma unroll
    for (int i = 0; i < 4; ++i) {
      f32x4 w; w[0] = v[i][0] * rs * g[i][0]; w[1] = v[i][1] * rs * g[i][1]; w[2] = v[i][2] * rs * g[i][2]; w[3] = v[i][3] * rs * g[i][3];
      *(f32x4*)(x + (size_t)row * DM + i * 256 + lane * 4) = w;
    }
  }
}

DI void phase0(const Params& p, char* lds) {
  if (blockIdx.x == 0 && TIDX < 64) { ((unsigned*)(p.ws + OFF_MISC))[TIDX] = 0u; ((unsigned*)(p.ws + OFF_MISC + 6144))[TIDX] = 0u; }
  for (int it = blockIdx.x; it < 4; it += gridDim.x) {
    const int l = it >> 1, kv = it & 1;
    const float* pe = p.in[kv ? I_PEV : I_PEK] + (size_t)l * 2048;
    const float* w = p.in[kv ? I_PV1 : I_PK1] + (size_t)l * 2048 * 256;
    const int n = TIDX;
    if (n < 256) {
      float s = 0.f;
      for (int k = 0; k < 2048; ++k) s += pe[k] * w[(size_t)k * 256 + n];
      ((float*)(p.ws + OFF_MISC + 256))[it * 256 + n] = s;
    }
  }
  for (int w = blockIdx.x; w < 2 * CONV_PER_LAYER; w += gridDim.x) {
    const int l = w / CONV_PER_LAYER; int ww = w % CONV_PER_LAYER; int id = 0;
#pragma unroll
    for (int i = 0; i < 14; ++i) { if (id == i && ww >= CONV_NT[i]) { ww -= CONV_NT[i]; id = i + 1; } }
    const ConvD c = get_conv(p, l, id);
    const int ntn = c.Nout >> 6;
    conv_tile(c, ww % ntn, ww / ntn, (float*)lds);
  }
  rms_phase(p.in[I_X], p.in[I_F1N], (bf16_t*)(p.ws + OFF_HN));
}

constexpr int BK_THR[15] = {22, 30, 40, 54, 73, 99, 134, 182, 246, 332, 450, 609, 825, 1117, 1513};
struct AttnSt { float m, l; f32x16 o0, o1; };
DI void attn_init(AttnSt& st) { st.m = NEGINF; st.l = 0.f;
#pragma unroll
  for (int i = 0; i < 16; ++i) { st.o0[i] = 0.f; st.o1[i] = 0.f; } }

DI void load_q(bf16x8 (&qf)[4], const bf16_t* qrow) {
#pragma unroll
  for (int s = 0; s < 4; ++s) qf[s] = *(const bf16x8*)(qrow + 16 * s);
}
DI f32x16 qk_tile(const bf16x8 (&qf)[4], const bf16_t* krow) {
  f32x16 s;
#pragma unroll
  for (int i = 0; i < 16; ++i) s[i] = 0.f;
#pragma unroll
  for (int ss = 0; ss < 4; ++ss) { const bf16x8 kf = *(const bf16x8*)(krow + 512 * ss); s = MFMA32(kf, qf[ss], s); }
  return s;
}
DI void pv_tile(AttnSt& st, const float (&pr)[16], const bf16_t* v0, size_t rowstride) {
#pragma unroll
  for (int s2 = 0; s2 < 2; ++s2) {
    u32x4 pk; pk.x = pack2(pr[8 * s2], pr[8 * s2 + 1]); pk.y = pack2(pr[8 * s2 + 2], pr[8 * s2 + 3]); pk.z = pack2(pr[8 * s2 + 4], pr[8 * s2 + 5]); pk.w = pack2(pr[8 * s2 + 6], pr[8 * s2 + 7]);
    const bf16x8 pb = __builtin_bit_cast(bf16x8, pk);
    {
      const s16x4 lo = *(const s16x4*)(v0 + 256 * (s2 * 4 + 0)), hi = *(const s16x4*)(v0 + 256 * (s2 * 4 + 1));
      const bf16x8 va = __builtin_shufflevector(lo, hi, 0, 1, 2, 3, 4, 5, 6, 7);
      st.o0 = MFMA32(va, pb, st.o0);
    }
    {
      const s16x4 lo = *(const s16x4*)(v0 + 256 * (s2 * 4 + 2)), hi = *(const s16x4*)(v0 + 256 * (s2 * 4 + 3));
      const bf16x8 va = __builtin_shufflevector(lo, hi, 0, 1, 2, 3, 4, 5, 6, 7);
      st.o1 = MFMA32(va, pb, st.o1);
    }
  }
}
DI void softmax_step(AttnSt& st, const float (&lg)[16], const bf16_t* v0, size_t rowstride) {
  float mx = NEGINF;
#pragma unroll
  for (int i = 0; i < 16; ++i) mx = fmaxf(mx, lg[i]);
  mx = fmaxf(mx, shx32(mx));
  if (__ballot(mx > NEGINF) == 0ull) return;
  const float mnew = fmaxf(st.m, mx);
  const float muse = (mnew == NEGINF) ? 0.f : mnew;
  const float alpha = ex2(st.m - muse);
  float pr[16]; float rs = 0.f;
#pragma unroll
  for (int i = 0; i < 16; ++i) { pr[i] = ex2(lg[i] - muse); rs += pr[i]; }
  st.l = st.l * alpha + rs; st.m = mnew;
#pragma unroll
  for (int i = 0; i < 16; ++i) { st.o0[i] *= alpha; st.o1[i] *= alpha; }
  pv_tile(st, pr, v0, rowstride);
}

struct KVT { bf16x8 k[4]; s16x4 v[8]; };
DI void load_kv(KVT& t, const bf16_t* krow, const bf16_t* v0, size_t rowstride) {
#pragma unroll
  for (int ss = 0; ss < 4; ++ss) t.k[ss] = *(const bf16x8*)(krow + 512 * ss);
#pragma unroll
  for (int j = 0; j < 8; ++j) t.v[j] = *(const s16x4*)(v0 + 256 * j);
}
DI void softmax_step_r(AttnSt& st, const float (&lg)[16], const KVT& t) {
  float mx = NEGINF;
#pragma unroll
  for (int i = 0; i < 16; ++i) mx = fmaxf(mx, lg[i]);
  mx = fmaxf(mx, shx32(mx));
  if (__ballot(mx > NEGINF) == 0ull) return;
  const float mnew = fmaxf(st.m, mx);
  const float muse = (mnew == NEGINF) ? 0.f : mnew;
  const float alpha = ex2(st.m - muse);
  float pr[16]; float rs = 0.f;
#pragma unroll
  for (int i = 0; i < 16; ++i) { pr[i] = ex2(lg[i] - muse); rs += pr[i]; }
  st.l = st.l * alpha + rs;
  if (__ballot(mnew != st.m) != 0ull) {
#pragma unroll
    for (int i = 0; i < 16; ++i) { st.o0[i] *= alpha; st.o1[i] *= alpha; }
  }
  st.m = mnew;
#pragma unroll
  for (int s2 = 0; s2 < 2; ++s2) {
    u32x4 pk; pk.x = pack2(pr[8 * s2], pr[8 * s2 + 1]); pk.y = pack2(pr[8 * s2 + 2], pr[8 * s2 + 3]); pk.z = pack2(pr[8 * s2 + 4], pr[8 * s2 + 5]); pk.w = pack2(pr[8 * s2 + 6], pr[8 * s2 + 7]);
    const bf16x8 pb = __builtin_bit_cast(bf16x8, pk);
    const bf16x8 va0 = __builtin_shufflevector(t.v[s2 * 4 + 0], t.v[s2 * 4 + 1], 0, 1, 2, 3, 4, 5, 6, 7);
    st.o0 = MFMA32(va0, pb, st.o0);
    const bf16x8 va1 = __builtin_shufflevector(t.v[s2 * 4 + 2], t.v[s2 * 4 + 3], 0, 1, 2, 3, 4, 5, 6, 7);
    st.o1 = MFMA32(va1, pb, st.o1);
  }
}
template <class KP, class VP, class ACT, class FILL>
DI void attn_loop(AttnSt& st, const bf16x8 (&qf)[4], int k0, int k1, size_t vstride, KP kp, VP vp, ACT act, FILL fill) {
  KVT cur, nxt;
  {
    KVT t0; load_kv(t0, kp(k0), vp(k0), vstride);
#pragma unroll
    for (int i = 0; i < 8; ++i) cur.v[i] = t0.v[i];
#pragma unroll
    for (int i = 0; i < 4; ++i) cur.k[i] = t0.k[i];
  }
  f32x16 s_cur;
  { const float z = 0.f;
#pragma unroll
    for (int i = 0; i < 16; ++i) s_cur[i] = z; }
#pragma unroll
  for (int ss = 0; ss < 4; ++ss) s_cur = MFMA32(cur.k[ss], qf[ss], s_cur);
  {
    const int kn = (k0 < k1) ? k0 + 1 : k1;
    const bf16_t* krow = kp(kn);
#pragma unroll
    for (int ss = 0; ss < 4; ++ss) nxt.k[ss] = *(const bf16x8*)(krow + 512 * ss);
  }
  for (int kt = k0; kt <= k1; ++kt) {
    const int kn = (kt < k1) ? kt + 1 : k1;
    const int kn2 = (kt + 2 <= k1) ? kt + 2 : k1;
    {
      const bf16_t* v0 = vp(kn);
#pragma unroll
      for (int j = 0; j < 8; ++j) nxt.v[j] = *(const s16x4*)(v0 + 256 * j);
    }
    bf16x8 k2[4];
    {
      const bf16_t* krow = kp(kn2);
#pragma unroll
      for (int ss = 0; ss < 4; ++ss) k2[ss] = *(const bf16x8*)(krow + 512 * ss);
    }
    f32x16 s_next;
#pragma unroll
    for (int i = 0; i < 16; ++i) s_next[i] = 0.f;
#pragma unroll
    for (int ss = 0; ss < 4; ++ss) s_next = MFMA32(nxt.k[ss], qf[ss], s_next);
    if (act(kt)) {
      float lg[16];
      fill(kt, s_cur, lg);
      softmax_step_r(st, lg, cur);
    }
    s_cur = s_next;
#pragma unroll
    for (int i = 0; i < 8; ++i) cur.v[i] = nxt.v[i];
#pragma unroll
    for (int ss = 0; ss < 4; ++ss) nxt.k[ss] = k2[ss];
  }
}

DI float lut_bias(const unsigned char* blut, const float* tblh, int dist) {
  const int d = dist < 0 ? 0 : (dist > 2048 ? 2048 : dist);
  return tblh[blut[d]];
}
DI void bias16(const unsigned char* blut, const float* tblh, const int (&dist)[16], float (&bv)[16]) {
  int bk[16];
#pragma unroll
  for (int i = 0; i < 16; ++i) { const int d = dist[i] < 0 ? 0 : (dist[i] > 2048 ? 2048 : dist[i]); bk[i] = blut[d]; }
#pragma unroll
  for (int i = 0; i < 16; ++i) asm volatile("" : "+v"(bk[i]));
#pragma unroll
  for (int i = 0; i < 16; ++i) bv[i] = tblh[bk[i]];
#pragma unroll
  for (int i = 0; i < 16; ++i) asm volatile("" : "+v"(bv[i]));
}
DI void store_o(bf16_t* dst, const f32x16& o0, const f32x16& o1, int h) {
#pragma unroll
  for (int g = 0; g < 4; ++g) {
    u32x2 a; a.x = pack2(o0[4 * g], o0[4 * g + 1]); a.y = pack2(o0[4 * g + 2], o0[4 * g + 3]);
    *(u32x2*)(dst + 8 * g + 4 * h) = a;
    u32x2 b; b.x = pack2(o1[4 * g], o1[4 * g + 1]); b.y = pack2(o1[4 * g + 2], o1[4 * g + 3]);
    *(u32x2*)(dst + 32 + 8 * g + 4 * h) = b;
  }
}

DI void build_lut(unsigned char* blut, float* tbl, const float* rel_bias) {
  for (int n = TIDX; n < 2049; n += NTHREADS) {
    int bk = n;
    if (n >= 16) { bk = 16;
#pragma unroll
      for (int k = 0; k < 15; ++k) bk += (n >= BK_THR[k]) ? 1 : 0; }
    blut[n] = (unsigned char)bk;
  }
  for (int i = TIDX; i < 512; i += NTHREADS) { const int hd = i >> 5, bk = i & 31; tbl[i] = rel_bias[bk * 16 + hd] * 1.4426950408889634f; }
  __syncthreads();
}

DI int wave_fetch(unsigned* ctr) {
  int v = 0;
  if ((TIDX & 63) == 0) v = (int)atomicAdd(ctr, 1u);
  return __shfl(v, 0);
}

DI void nsa_cmp_item(const Params& p, int item, const unsigned char* blut, const float* tbl, float* impw) {
  const int lane = TIDX & 63, r = lane & 31, h = lane >> 5;
  const int qb = 127 - (item >> 4), bg = item & 15, b = bg >> 1, g = bg & 1;
  const int t = qb * 32 + r;
  const int ntile = (qb >> 4) + 1;
  const bf16_t* KC = (const bf16_t*)(p.ws + OFF_KC) + (size_t)bg * 256 * 64;
  const bf16_t* VCT = (const bf16_t*)(p.ws + OFF_VCT) + (size_t)bg * 64 * 256;
  const float* gates = (const float*)(p.ws + OFF_GATES) + (size_t)(b * 4096 + t) * 18;
#pragma unroll 4
  for (int j = 0; j < 32; ++j) impw[r * 65 + 2 * j + h] = 0.f;
  for (int rr = 0; rr < 3; ++rr) {
    const int head = g * 3 + rr;
    const float* tblh = tbl + head * 32;
    bf16x8 qf[4];
    load_q(qf, (const bf16_t*)(p.ws + OFF_QN) + (size_t)(b * 4096 + t) * 384 + head * 64 + 8 * h);
    float m = NEGINF, l = 0.f;
    for (int kt = 0; kt < ntile; ++kt) {
      const f32x16 s = qk_tile(qf, KC + (size_t)kt * 2048 + (h * 32 + r) * 8);
      float lg[16]; float mx = NEGINF;
      int dist[16]; float bv[16];
#pragma unroll
      for (int i = 0; i < 16; ++i) dist[i] = t - (16 * (kt * 32 + crow(i, h)) + 31);
      bias16(blut, tblh, dist, bv);
#pragma unroll
      for (int i = 0; i < 16; ++i) { lg[i] = (dist[i] >= 0) ? s[i] + bv[i] : NEGINF; mx = fmaxf(mx, lg[i]); }
      mx = fmaxf(mx, shx32(mx));
      const float mnew = fmaxf(m, mx), muse = (mnew == NEGINF) ? 0.f : mnew;
      float rs = 0.f;
#pragma unroll
      for (int i = 0; i < 16; ++i) rs += ex2(lg[i] - muse);
      l = l * ex2(m - muse) + rs; m = mnew;
    }
    l += shx32(l);
    const float muse = (m == NEGINF) ? 0.f : m;
    const float inv = (l > 0.f) ? 1.f / l : 0.f;
    AttnSt st; attn_init(st);
    float prev3 = 0.f;
#pragma unroll 1
    for (int kt = 0; kt < ntile; ++kt) {
      {
        const f32x16 s = qk_tile(qf, KC + (size_t)kt * 2048 + (h * 32 + r) * 8);
        float pr[16];
        int dist[16]; float bv[16];
#pragma unroll
        for (int i = 0; i < 16; ++i) dist[i] = t - (16 * (kt * 32 + crow(i, h)) + 31);
        bias16(blut, tblh, dist, bv);
#pragma unroll
        for (int i = 0; i < 16; ++i) pr[i] = (dist[i] >= 0) ? ex2(s[i] + bv[i] - muse) * inv : 0.f;
        float recv[4];
#pragma unroll
        for (int q = 0; q < 4; ++q) recv[q] = shx32(pr[4 * q + 3]);
#pragma unroll
        for (int q = 0; q < 4; ++q) {
          const float qs = (pr[4 * q] + pr[4 * q + 1]) + (pr[4 * q + 2] + pr[4 * q + 3]);
          const float cin = h ? recv[q] : (q ? recv[q > 0 ? q - 1 : 0] : prev3);
          impw[r * 65 + 8 * kt + 2 * q + h] += qs + cin;
        }
        prev3 = recv[3];
        pv_tile(st, pr, VCT + (size_t)kt * 2048 + (h * 32 + r) * 4, 256);
      }
    }
    const float g0 = gates[head * 3 + 0];
#pragma unroll
    for (int i = 0; i < 16; ++i) { st.o0[i] *= g0; st.o1[i] *= g0; }
    store_o((bf16_t*)(p.ws + OFF_OC) + (size_t)(b * 4096 + t) * 384 + head * 64, st.o0, st.o1, h);
  }
  const int cur = t >> 6;
  unsigned long long mask;
  if (cur < 16) {
    mask = (2ull << cur) - 1ull;
  } else {
    float own[32], oth[32];
#pragma unroll
    for (int j = 0; j < 32; ++j) {
      const int u = 2 * j + h, uo = 2 * j + 1 - h;
      const float a = impw[r * 65 + u], bb = impw[r * 65 + uo];
      own[j] = ((u >= 1) && (u <= cur - 2)) ? a : -1.f;
      oth[j] = ((uo >= 1) && (uo <= cur - 2)) ? bb : -1.f;
    }
    float prev = __builtin_inff();
#pragma unroll 1
    for (int round = 0; round < 13; ++round) {
      float m = -2.f;
#pragma unroll
      for (int j = 0; j < 32; ++j) { m = fmaxf(m, own[j] < prev ? own[j] : -2.f); m = fmaxf(m, oth[j] < prev ? oth[j] : -2.f); }
      prev = m;
    }
    unsigned mlo = 0u, mhi = 0u;
#pragma unroll
    for (int j = 0; j < 32; ++j) {
      const int u = 2 * j + h;
      const bool forced = (u == 0) || (u == cur) || (u == cur - 1);
      const bool cand = (u >= 1) && (u <= cur - 2);
      const bool sel = forced || (cand && own[j] >= prev);
      if (j < 16) mlo |= sel ? (1u << u) : 0u; else mhi |= sel ? (1u << (u - 32)) : 0u;
    }
    mlo |= (unsigned)shx32i((int)mlo);
    mhi |= (unsigned)shx32i((int)mhi);
    mask = ((unsigned long long)mhi << 32) | mlo;
  }
  if (h == 0) ((unsigned long long*)(p.ws + OFF_SELM))[(size_t)bg * 4096 + t] = mask;
}

DI void nsa_main_item(const Params& p, int b, int head, int qb, const unsigned char* blut, const float* tbl) {
  const int lane = TIDX & 63, r = lane & 31, h = lane >> 5;
  const int g = head / 3, bg = b * 2 + g;
  const int t = qb * 32 + r;
  const float* tblh = tbl + head * 32;
  bf16x8 qf[4];
  load_q(qf, (const bf16_t*)(p.ws + OFF_QN) + (size_t)(b * 4096 + t) * 384 + head * 64 + 8 * h);
  const unsigned long long selm = ((const unsigned long long*)(p.ws + OFF_SELM))[(size_t)bg * 4096 + t];
  const float* gates = (const float*)(p.ws + OFF_GATES) + (size_t)(b * 4096 + t) * 18 + head * 3;
  const float g1 = gates[1], g2 = gates[2];
  f32x16 y0, y1;
  {
    const bf16_t* oc = (const bf16_t*)(p.ws + OFF_OC) + (size_t)(b * 4096 + t) * 384 + head * 64;
#pragma unroll
    for (int i = 0; i < 16; ++i) { y0[i] = bf2f(oc[crow(i, h)]); y1[i] = bf2f(oc[32 + crow(i, h)]); }
  }
  {
    const bf16_t* K = (const bf16_t*)(p.ws + OFF_KSEL) + (size_t)bg * 4096 * 64;
    const bf16_t* Vt = (const bf16_t*)(p.ws + OFF_VSELT) + (size_t)bg * 64 * 4096;
    AttnSt st; attn_init(st);
    attn_loop(st, qf, 0, qb, 32,
      [&](int kt) { return K + (size_t)kt * 2048 + (h * 32 + r) * 8; },
      [&](int kt) { return Vt + (size_t)kt * 2048 + (h * 32 + r) * 4; },
      [&](int kt) { return __ballot((selm >> (kt >> 1)) & 1ull) != 0ull; },
      [&](int kt, const f32x16& s, float (&lg)[16]) {
        const bool bs = (selm >> (kt >> 1)) & 1ull;
        if (qb * 32 - (kt * 32 + 31) >= 1513) {
          const float b31 = tblh[31];
#pragma unroll
          for (int i = 0; i < 16; ++i) lg[i] = bs ? s[i] + b31 : NEGINF;
        } else {
          int dist[16]; float bv[16];
#pragma unroll
          for (int i = 0; i < 16; ++i) dist[i] = t - (kt * 32 + crow(i, h));
          bias16(blut, tblh, dist, bv);
#pragma unroll
          for (int i = 0; i < 16; ++i) lg[i] = (bs && dist[i] >= 0) ? s[i] + bv[i] : NEGINF;
        }
      });
    float l = st.l + shx32(st.l);
    const float sc = (l > 0.f) ? g1 / l : 0.f;
#pragma unroll
    for (int i = 0; i < 16; ++i) { y0[i] += sc * st.o0[i]; y1[i] += sc * st.o1[i]; }
  }
  {
    const bf16_t* K = (const bf16_t*)(p.ws + OFF_KWIN) + (size_t)bg * 4096 * 64;
    const bf16_t* Vt = (const bf16_t*)(p.ws + OFF_VWINT) + (size_t)bg * 64 * 4096;
    AttnSt st; attn_init(st);
    const int k0 = qb >= 16 ? qb - 16 : 0;
    attn_loop(st, qf, k0, qb, 32,
      [&](int kt) { return K + (size_t)kt * 2048 + (h * 32 + r) * 8; },
      [&](int kt) { return Vt + (size_t)kt * 2048 + (h * 32 + r) * 4; },
      [&](int kt) { return true; },
      [&](int kt, const f32x16& s, float (&lg)[16]) {
        int dist[16]; float bv[16];
#pragma unroll
        for (int i = 0; i < 16; ++i) dist[i] = t - (kt * 32 + crow(i, h));
        bias16(blut, tblh, dist, bv);
#pragma unroll
        for (int i = 0; i < 16; ++i) lg[i] = (dist[i] >= 0 && dist[i] < 512) ? s[i] + bv[i] : NEGINF;
      });
    float l = st.l + shx32(st.l);
    const float sc = (l > 0.f) ? g2 / l : 0.f;
#pragma unroll
    for (int i = 0; i < 16; ++i) { y0[i] += sc * st.o0[i]; y1[i] += sc * st.o1[i]; }
  }
  store_o((bf16_t*)(p.ws + OFF_Y) + (size_t)(b * 4096 + t) * 768 + head * 64, y0, y1, h);
}

DI void moba_item(const Params& p, int b, int hd, int qb, const unsigned char* blut, const float* tbl) {
  const int lane = TIDX & 63, r = lane & 31, h = lane >> 5;
  const int bh = b * 4 + hd;
  const int t = qb * 32 + r;
  const int c = qb >> 3;
  const float* tblh = tbl + (6 + hd) * 32;
  bf16x8 qf[4];
  load_q(qf, (const bf16_t*)(p.ws + OFF_QM) + (size_t)(b * 4096 + t) * 256 + hd * 64 + 8 * h);
  unsigned mmask = 0u;
  if (c > 0) {
    const bf16_t* km = (const bf16_t*)(p.ws + OFF_KMEAN) + (size_t)bh * 16 * 64 + (size_t)(r & 15) * 64 + 8 * h;
    f32x16 s;
#pragma unroll
    for (int i = 0; i < 16; ++i) s[i] = 0.f;
#pragma unroll
    for (int ss = 0; ss < 4; ++ss) {
      bf16x8 kf = *(const bf16x8*)(km + 16 * ss);
      if (r >= 16) {
#pragma unroll
        for (int j = 0; j < 8; ++j) kf[j] = 0;
      }
      s = MFMA32(kf, qf[ss], s);
    }
    float g16[16];
#pragma unroll
    for (int i = 0; i < 8; ++i) {
      const float own = s[i], oth = shx32(own);
      const int base = (i & 3) + 8 * (i >> 2);
      g16[base] = h ? oth : own;
      g16[base + 4] = h ? own : oth;
    }
#pragma unroll
    for (int n = 0; n < 16; ++n) g16[n] = (n < c) ? g16[n] : NEGINF;
#pragma unroll
    for (int round = 0; round < 3; ++round) {
      float best = NEGINF; int bi = -1;
#pragma unroll
      for (int n = 0; n < 16; ++n) if (g16[n] > best) { best = g16[n]; bi = n; }
      if (bi >= 0) mmask |= 1u << bi;
#pragma unroll
      for (int n = 0; n < 16; ++n) if (n == bi) g16[n] = NEGINF;
    }
  }
  mmask |= 1u << c;
  const bf16_t* K = (const bf16_t*)(p.ws + OFF_KM) + (size_t)bh * 4096 * 64;
  const bf16_t* Vt = (const bf16_t*)(p.ws + OFF_VMT) + (size_t)bh * 64 * 4096;
  AttnSt st; attn_init(st);
  attn_loop(st, qf, 0, qb, 32,
    [&](int kt) { return K + (size_t)kt * 2048 + (h * 32 + r) * 8; },
    [&](int kt) { return Vt + (size_t)kt * 2048 + (h * 32 + r) * 4; },
    [&](int kt) { return __ballot((mmask >> (kt >> 3)) & 1u) != 0ull; },
    [&](int kt, const f32x16& s, float (&lg)[16]) {
      const bool bs = (mmask >> (kt >> 3)) & 1u;
      if (qb * 32 - (kt * 32 + 31) >= 1513) {
        const float b31 = tblh[31];
#pragma unroll
        for (int i = 0; i < 16; ++i) lg[i] = bs ? s[i] + b31 : NEGINF;
      } else {
        int dist[16]; float bv[16];
#pragma unroll
        for (int i = 0; i < 16; ++i) dist[i] = t - (kt * 32 + crow(i, h));
        bias16(blut, tblh, dist, bv);
#pragma unroll
        for (int i = 0; i < 16; ++i) lg[i] = (bs && dist[i] >= 0) ? s[i] + bv[i] : NEGINF;
      }
    });
  float l = st.l + shx32(st.l);
  const float sc = (l > 0.f) ? 1.f / l : 0.f;
#pragma unroll
  for (int i = 0; i < 16; ++i) { st.o0[i] *= sc; st.o1[i] *= sc; }
  store_o((bf16_t*)(p.ws + OFF_Y) + (size_t)(b * 4096 + t) * 768 + 384 + hd * 64, st.o0, st.o1, h);
}

DI void dil_item(const Params& p, int b, int j, int qi, const unsigned char* blut, const float* tbl) {
  const int lane = TIDX & 63, r = lane & 31, h = lane >> 5;
  const int rho = qi & 15, ub = qi >> 4;
  const int t = rho + 16 * (ub * 32 + r);
  const int tmin = rho + 16 * (ub * 32), tmax = rho + 16 * (ub * 32 + 31);
  AttnSt st; attn_init(st);
#pragma unroll
  for (int g = 0; g < 3; ++g) {
    const int dil = (g == 0) ? 1 : (g == 1 ? 4 : 16), window = 128 * dil, L = 4096 / dil;
    const int hd = 2 * g + j;
    const float* tblh = tbl + (10 + hd) * 32;
    const int rg = rho % dil;
    bf16x8 qf[4];
    load_q(qf, (const bf16_t*)(p.ws + OFF_QD) + (size_t)(b * 4096 + t) * 384 + hd * 64 + 8 * h);
    const bf16_t* K = (const bf16_t*)(p.ws + OFF_KD) + (size_t)(b * 6 + hd) * 4096 * 64;
    const bf16_t* Vt = (const bf16_t*)(p.ws + OFF_VDT) + (size_t)(b * 6 + hd) * 64 * 4096 + (size_t)(rg * L >> 5) * 2048;
    int vlo = tmin / dil - 128; if (vlo < 0) vlo = 0;
    const int vhi = tmax / dil;
    attn_loop(st, qf, vlo >> 5, vhi >> 5, 32,
      [&](int kt) { return K + (size_t)((rg * L >> 5) + kt) * 2048 + (h * 32 + r) * 8; },
      [&](int kt) { return Vt + (size_t)kt * 2048 + (h * 32 + r) * 4; },
      [&](int kt) { return true; },
      [&](int kt, const f32x16& s, float (&lg)[16]) {
        int dist[16]; float bv[16];
#pragma unroll
        for (int i = 0; i < 16; ++i) dist[i] = t - ((kt * 32 + crow(i, h)) * dil + rg);
        bias16(blut, tblh, dist, bv);
#pragma unroll
        for (int i = 0; i < 16; ++i) lg[i] = (dist[i] >= 0 && dist[i] <= window) ? s[i] + bv[i] : NEGINF;
      });
  }
  float l = st.l + shx32(st.l);
  const float sc = (l > 0.f) ? 1.f / l : 0.f;
#pragma unroll
  for (int i = 0; i < 16; ++i) { st.o0[i] *= sc; st.o1[i] *= sc; }
  store_o((bf16_t*)(p.ws + OFF_Y) + (size_t)(b * 4096 + t) * 768 + 640 + j * 64, st.o0, st.o1, h);
}

DI void phaseX(const Params& p, int layer, char* lds, int rep = 0) {
  unsigned char* blut = (unsigned char*)lds; float* tbl = (float*)(lds + 4096);
  build_lut(blut, tbl, p.in[I_RELB]);
  unsigned* ctr = (unsigned*)(p.ws + OFF_MISC) + layer * 2 + rep * 8;
  for (;;) {
    const int item = wave_fetch(ctr);
    if (item >= 2048 + 128 * 48) break;
    if (item < 2048) nsa_cmp_item(p, item, blut, tbl, (float*)(lds + 8192) + (TIDX >> 6) * (32 * 65));
    else {
      const int it2 = item - 2048, qb = 127 - it2 / 48, sub = it2 % 48;
      if (sub < 32) moba_item(p, sub >> 2, sub & 3, qb, blut, tbl);
      else dil_item(p, (sub - 32) >> 1, (sub - 32) & 1, qb, blut, tbl);
    }
  }
  __syncthreads();
}
DI void phaseY(const Params& p, int layer, char* lds, int rep = 0) {
  unsigned char* blut = (unsigned char*)lds; float* tbl = (float*)(lds + 4096);
  build_lut(blut, tbl, p.in[I_RELB]);
  unsigned* ctr = (unsigned*)(p.ws + OFF_MISC) + layer * 2 + 1 + rep * 8;
  for (;;) {
    const int item = wave_fetch(ctr);
    if (item >= 128 * 48) break;
    const int qb = 127 - item / 48, sub = item % 48;
    nsa_main_item(p, sub / 6, sub % 6, qb, blut, tbl);
  }
  __syncthreads();
}

DI void kmean_phase(const Params& p) {
  const int lane = TIDX & 63;
  const int gw = blockIdx.x * 8 + (TIDX >> 6), nw = gridDim.x * 8;
  const bf16_t* KM = (const bf16_t*)(p.ws + OFF_KM);
  bf16_t* o = (bf16_t*)(p.ws + OFF_KMEAN);
  for (int it = gw; it < 512; it += nw) {
    const bf16_t* src = KM + (size_t)it * 256 * 64;
    float s = 0.f;
    for (int k = 0; k < 256; ++k) s += bf2f(KM[(size_t)(it >> 4) * 262144 + kfrag_idx((it & 15) * 256 + k, lane)]);
    o[it * 64 + lane] = f2bf(s * (1.f / 256.f));
  }
}

DI void merge_phase(const Params& p, int layer, char* lds) {
  const bf16_t* wl = (const bf16_t*)(p.ws + OFF_W) + (size_t)layer * W_LAYER;
  const bf16_t* hn = (const bf16_t*)(p.ws + OFF_HN);
  const bf16_t* y = (const bf16_t*)(p.ws + OFF_Y);
  bf16_t* mg = (bf16_t*)(p.ws + OFF_MERGED);
  const int lmax = tile_lmax(128, 8, 4);
  for (int L = blockIdx.x; L < lmax; L += gridDim.x) {
    int mt, nt;
    if (!tile_map(L, 128, 8, 4, mt, nt)) continue;
    f32x16 macc[2][2];
    zero_acc(macc);
#pragma unroll 1
    for (int br = 0; br < 3; ++br) {
      const int kw = (br == 0) ? 384 : (br == 1 ? 256 : 128);
      const int yo = (br == 0) ? 0 : (br == 1 ? 384 : 640);
      const bf16_t* wu = wl + ((br == 0) ? OW_UA : (br == 1 ? OW_UB : OW_UC));
      unsigned sg[2][2][8];
      {
        f32x16 ag[2][2];
        zero_acc(ag);
        gemm_core(hn + (size_t)mt * 256 * 1024, 1024, wl + OW_ING + (size_t)(br * 1024 + nt * 128) * 1024, 1024, 1024, ag, lds);
#pragma unroll
        for (int a = 0; a < 2; ++a)
#pragma unroll
          for (int c = 0; c < 2; ++c)
#pragma unroll
            for (int i = 0; i < 8; ++i) sg[a][c][i] = pack2(sigmoidf_(ag[a][c][2 * i]), sigmoidf_(ag[a][c][2 * i + 1]));
      }
      f32x16 au[2][2];
      zero_acc(au);
      gemm_core(y + (size_t)mt * 256 * 768 + yo, 768, wu + (size_t)nt * 128 * kw, kw, kw, au, lds);
#pragma unroll
      for (int a = 0; a < 2; ++a)
#pragma unroll
        for (int c = 0; c < 2; ++c)
#pragma unroll
          for (int i = 0; i < 8; ++i) {
            macc[a][c][2 * i] += __uint_as_float(sg[a][c][i] << 16) * au[a][c][2 * i];
            macc[a][c][2 * i + 1] += __uint_as_float(sg[a][c][i] & 0xffff0000u) * au[a][c][2 * i + 1];
          }
    }
    const int tid = TIDX, lane = tid & 63, wid = tid >> 6, wr = wid >> 1, wc = wid & 1, r = lane & 31, h = lane >> 5;
#pragma unroll
    for (int a = 0; a < 2; ++a)
#pragma unroll
      for (int c = 0; c < 2; ++c)
#pragma unroll
        for (int i = 0; i < 16; ++i)
          mg[(size_t)(mt * 256 + wr * 64 + a * 32 + crow(i, h)) * 1024 + nt * 128 + wc * 64 + c * 32 + r] = f2bf(macc[a][c][i]);
  }
}

constexpr int NPHASE = 1 + 2 * 14 + 1;

DI void run_phase(const Params& p, int ph, char* lds, int rep = 0) {
#ifdef TESTQ
  if (ph == 0) { if (TESTQ == 100) phase0(p, lds); return; }
  if ((ph - 1) % 14 != TESTQ) return;
#endif
  if (ph == 0) { phase0(p, lds); return; }
  if (ph == NPHASE - 1) { final_norm_phase(p.out, p.in[I_FINN]); return; }
  const int layer = (ph - 1) / 14, q = (ph - 1) % 14;
  const bf16_t* wl = (const bf16_t*)(p.ws + OFF_W) + (size_t)layer * W_LAYER;
  bf16_t* hn = (bf16_t*)(p.ws + OFF_HN);
  switch (q) {
    case 0: { EpiSwiglu e{(bf16_t*)(p.ws + OFF_FFH)}; gemm_phase(hn, 1024, wl + OW_GU1, 1024, 1024, 128, 44, 4, e, lds); } break;
    case 1: { EpiResid e{layer == 0 ? p.in[I_X] : p.out, p.out, 0.5f}; gemm_phase((const bf16_t*)(p.ws + OFF_FFH), DFF, wl + OW_DN1, DFF, DFF, 128, 8, 4, e, lds); } break;
    case 2: rms_phase(p.out, p.in[I_MIXN] + layer * 1024, hn); break;
    case 3: { EpiWin e{p.ws}; gemm_phase(hn, 1024, wl + OW_INM, 1024, 1024, 128, 25, 5, e, lds); } break;
    case 4: {
      { EpiGelu e{(bf16_t*)(p.ws + OFF_H1K), (const float*)(p.ws + OFF_MISC + 256) + (layer * 2 + 0) * 256}; gemm_phase((const bf16_t*)(p.ws + OFF_KCMP), 1024, wl + OW_PK1, 2048, 2048, 16, 2, 2, e, lds); }
      { EpiGelu e{(bf16_t*)(p.ws + OFF_H1V), (const float*)(p.ws + OFF_MISC + 256) + (layer * 2 + 1) * 256}; gemm_phase((const bf16_t*)(p.ws + OFF_VCMP), 1024, wl + OW_PV1, 2048, 2048, 16, 2, 2, e, lds); }
      kmean_phase(p);
    } break;
    case 5: {
      { EpiCmpOut<0> e{(bf16_t*)(p.ws + OFF_KC)}; gemm_phase((const bf16_t*)(p.ws + OFF_H1K), 256, wl + OW_PK2, 256, 256, 16, 1, 1, e, lds); }
      { EpiCmpOut<1> e{(bf16_t*)(p.ws + OFF_VCT)}; gemm_phase((const bf16_t*)(p.ws + OFF_H1V), 256, wl + OW_PV2, 256, 256, 16, 1, 1, e, lds); }
    } break;
    case 6: phaseX(p, layer, lds, rep); break;
    case 7: phaseY(p, layer, lds, rep); break;
    case 8: merge_phase(p, layer, lds); break;
    case 9: { EpiResid e{p.out, p.out, 1.0f}; gemm_phase((const bf16_t*)(p.ws + OFF_MERGED), 1024, wl + OW_WO, 1024, 1024, 128, 8, 4, e, lds); } break;
    case 10: rms_phase(p.out, p.in[I_F2N] + layer * 1024, hn); break;
    case 11: { EpiSwiglu e{(bf16_t*)(p.ws + OFF_FFH)}; gemm_phase(hn, 1024, wl + OW_GU2, 1024, 1024, 128, 44, 4, e, lds); } break;
    case 12: { EpiResid e{p.out, p.out, 0.5f}; gemm_phase((const bf16_t*)(p.ws + OFF_FFH), DFF, wl + OW_DN2, DFF, DFF, 128, 8, 4, e, lds); } break;
    default: if (layer == 0) rms_phase(p.out, p.in[I_F1N] + 1024, hn); break;
  }
}


DI void grid_barrier(unsigned* ctr, unsigned target) {
  __syncthreads();
  if (threadIdx.x == 0) {
    __threadfence();
    __hip_atomic_fetch_add(ctr, 1u, __ATOMIC_RELAXED, __HIP_MEMORY_SCOPE_AGENT);
    unsigned spins = 0;
    while (__hip_atomic_load(ctr, __ATOMIC_RELAXED, __HIP_MEMORY_SCOPE_AGENT) < target && spins < (1u << 26)) { __builtin_amdgcn_s_sleep(2); ++spins; }
    __threadfence();
  }
  __syncthreads();
}
#if MEGA
__global__ void __launch_bounds__(NTHREADS) mega_kernel(Params p) {
  extern __shared__ __attribute__((aligned(16))) char lds[];
  cg::grid_group grid = cg::this_grid();
  unsigned bar_gen = 0;
  for (int ph = 0; ph < NPHASE; ++ph) {
#ifdef REPQ
    const int nrep = (REPQ >= 100) ? ((ph == REPQ - 100) ? 2 : 1) : ((ph > 0 && ph < NPHASE - 1 && (ph - 1) % 14 == REPQ) ? 2 : 1);
#else
    const int nrep = 1;
#endif
    if (ph == NPHASE - 2) continue;
    for (int rep = 0; rep < nrep; ++rep) {
      run_phase(p, ph, lds, rep);
      if (ph + 1 < NPHASE) {
        if (ph == 0) grid.sync();
        else { ++bar_gen; grid_barrier((unsigned*)(p.ws + OFF_MISC + 6144), bar_gen * gridDim.x); }
      }
    }
  }
}
#else
__global__ void __launch_bounds__(NTHREADS) phase_kernel(Params p, int ph) {
  extern __shared__ __attribute__((aligned(16))) char lds[];
  run_phase(p, ph, lds);
}
#endif

extern "C" void kernel_launch(void* const* d_in, const int* in_sizes, int n_in, void* d_out, int out_size, void* d_ws, size_t ws_size, hipStream_t stream) {
  Params p;
  memset(&p, 0, sizeof(p));
  for (int i = 0; i < 23; ++i) p.in[i] = (const float*)d_in[i];
  p.out = (float*)d_out;
  p.ws = (char*)d_ws;
  if (ws_size < OFF_END) fprintf(stderr, "workspace too small: %zu < %zu\n", ws_size, (size_t)OFF_END);
  static int grid_blocks = 0;
  if (!grid_blocks) {
    int dev = 0, cus = 0, per_cu = 0;
    (void)hipGetDevice(&dev);
    (void)hipDeviceGetAttribute(&cus, hipDeviceAttributeMultiprocessorCount, dev);
#if MEGA
    if (hipFuncSetAttribute((const void*)mega_kernel, hipFuncAttributeMaxDynamicSharedMemorySize, LDS_BYTES) != hipSuccess) fprintf(stderr, "hipFuncSetAttribute failed\n");
    (void)hipOccupancyMaxActiveBlocksPerMultiprocessor(&per_cu, mega_kernel, NTHREADS, LDS_BYTES);
#else
    per_cu = 1;
#endif
    if (per_cu < 1) per_cu = 1;
    if (per_cu > 2) per_cu = 2;
    grid_blocks = cus * per_cu;
  }
#if MEGA
  void* args[] = {&p};
  hipError_t e = hipLaunchCooperativeKernel((void*)mega_kernel, dim3(grid_blocks), dim3(NTHREADS), args, LDS_BYTES, stream);
  if (e != hipSuccess) fprintf(stderr, "cooperative launch failed: %s (grid %d)\n", hipGetErrorString(e), grid_blocks);
#else
  for (int ph = 0; ph < NPHASE; ++ph) phase_kernel<<<grid_blocks, NTHREADS, LDS_BYTES, stream>>>(p, ph);
#endif
}
```

```cpp
#include <hip/hip_runtime.h>
#include <hip/hip_cooperative_groups.h>
#include <stdint.h>
#include <stdio.h>
#include <string.h>
namespace cg = cooperative_groups;

#ifndef MEGA
#define MEGA 1
#endif

typedef unsigned short bf16_t;
typedef short bf16x8 __attribute__((ext_vector_type(8)));
typedef short s16x4 __attribute__((ext_vector_type(4)));
typedef float f32x16 __attribute__((ext_vector_type(16)));
typedef float f32x4 __attribute__((ext_vector_type(4)));
typedef unsigned u32x4 __attribute__((ext_vector_type(4)));
typedef unsigned u32x2 __attribute__((ext_vector_type(2)));

#define DI __device__ __forceinline__
#define MFMA32(a, b, c) __builtin_amdgcn_mfma_f32_32x32x16_bf16((a), (b), (c), 0, 0, 0)
#define NEGINF (-__builtin_inff())

constexpr int NB = 8, SEQ = 4096, DM = 1024, NT = NB * SEQ, DFF = 2816;
constexpr int NTHREADS = 512;

constexpr size_t W_GU = 5632ull * 1024, W_DN = 1024ull * 2816, W_INM = 3200ull * 1024, W_ING = 3072ull * 1024,
                 W_P1 = 256ull * 2048, W_P2 = 128ull * 256, W_UA = 1024ull * 384, W_UB = 1024ull * 256, W_UC = 1024ull * 128, W_WO = 1024ull * 1024;
constexpr size_t OW_GU1 = 0, OW_DN1 = OW_GU1 + W_GU, OW_GU2 = OW_DN1 + W_DN, OW_DN2 = OW_GU2 + W_GU, OW_INM = OW_DN2 + W_DN,
                 OW_ING = OW_INM + W_INM, OW_PK1 = OW_ING + W_ING, OW_PV1 = OW_PK1 + W_P1, OW_PK2 = OW_PV1 + W_P1, OW_PV2 = OW_PK2 + W_P2,
                 OW_UA = OW_PV2 + W_P2, OW_UB = OW_UA + W_UA, OW_UC = OW_UB + W_UB, OW_WO = OW_UC + W_UC, W_LAYER = OW_WO + W_WO;
constexpr size_t OFF_W = 0;
constexpr size_t OFF_MISC = OFF_W + 2 * W_LAYER * 2;
constexpr size_t OFF_HN = OFF_MISC + 8192;
constexpr size_t OFF_C = OFF_HN + (size_t)NT * DM * 2;
constexpr size_t OFF_FFH = OFF_C;
constexpr size_t OFF_QN = OFF_C;
constexpr size_t OFF_QM = OFF_QN + (size_t)NT * 384 * 2;
constexpr size_t OFF_QD = OFF_QM + (size_t)NT * 256 * 2;
constexpr size_t OFF_MERGED = OFF_C;
constexpr size_t SZ_G2 = 16ull * 4096 * 64 * 2;
constexpr size_t OFF_KCMP = OFF_QD + (size_t)NT * 384 * 2;
constexpr size_t OFF_VCMP = OFF_KCMP + SZ_G2 + 4096;
constexpr size_t OFF_KSEL = OFF_VCMP + SZ_G2 + 4096;
constexpr size_t OFF_VSELT = OFF_KSEL + SZ_G2;
constexpr size_t OFF_KWIN = OFF_VSELT + SZ_G2;
constexpr size_t OFF_VWINT = OFF_KWIN + SZ_G2;
constexpr size_t OFF_KM = OFF_VWINT + SZ_G2;
constexpr size_t OFF_VMT = OFF_KM + 2 * SZ_G2;
constexpr size_t OFF_KD = OFF_VMT + 2 * SZ_G2;
constexpr size_t OFF_VDT = OFF_KD + 3 * SZ_G2;
constexpr size_t OFF_GATES = OFF_VDT + 3 * SZ_G2;
constexpr size_t OFF_H1K = OFF_GATES + (size_t)NT * 18 * 4;
constexpr size_t OFF_H1V = OFF_H1K + 4096ull * 256 * 2;
constexpr size_t OFF_KC = OFF_H1V + 4096ull * 256 * 2;
constexpr size_t OFF_VCT = OFF_KC + 16ull * 256 * 64 * 2;
constexpr size_t OFF_KMEAN = OFF_VCT + 16ull * 256 * 64 * 2;
constexpr size_t OFF_SELM = OFF_KMEAN + 32ull * 16 * 64 * 2;
constexpr size_t OFF_OC = OFF_SELM + 16ull * 4096 * 8;
constexpr size_t OFF_Y = OFF_OC + (size_t)NT * 384 * 2;
constexpr size_t OFF_END = OFF_Y + (size_t)NT * 768 * 2;
static_assert(OFF_FFH + (size_t)NT * DFF * 2 <= OFF_END, "ffh fits");

struct Params {
  const float* in[23];
  float* out;
  char* ws;
};

enum { I_X = 0, I_RELB, I_F1N, I_F1G, I_F1U, I_F1D, I_MIXN, I_WIN, I_PEK, I_PEV, I_PK1, I_PK2, I_PV1, I_PV2, I_UA, I_UB, I_UC, I_WO, I_F2N, I_F2G, I_F2U, I_F2D, I_FINN };

DI int get_tid_() { int t = threadIdx.x; asm volatile("" : "+v"(t)); return t; }
#define TIDX get_tid_()
DI float shx32(float v) { const auto r = __builtin_amdgcn_permlane32_swap(__float_as_uint(v), __float_as_uint(v), false, false); return __uint_as_float((threadIdx.x & 32) ? r[0] : r[1]); }
DI int shx32i(int v) { const auto r = __builtin_amdgcn_permlane32_swap((unsigned)v, (unsigned)v, false, false); return (int)((threadIdx.x & 32) ? r[0] : r[1]); }
DI float ex2(float x) { return __builtin_amdgcn_exp2f(x); }
DI size_t kfrag_idx(int pos, int d) { return ((size_t)((pos >> 5) * 4 + (d >> 4)) * 64 + ((d >> 3) & 1) * 32 + (pos & 31)) * 8 + (d & 7); }
DI size_t vfrag_idx(int pos, int d) { return ((size_t)((pos >> 5) * 8 + ((pos >> 4) & 1) * 4 + (d >> 5) * 2 + ((pos >> 3) & 1)) * 64 + ((pos >> 2) & 1) * 32 + (d & 31)) * 4 + (pos & 3); }
DI bf16_t f2bf(float x) { unsigned r; asm("v_cvt_pk_bf16_f32 %0, %1, %1" : "=v"(r) : "v"(x)); return (bf16_t)(r & 0xffffu); }
DI float bf2f(bf16_t b) { return __uint_as_float(((unsigned)b) << 16); }
DI unsigned pack2(float a, float b) { unsigned r; asm("v_cvt_pk_bf16_f32 %0, %1, %2" : "=v"(r) : "v"(a), "v"(b)); return r; }
DI int crow(int i, int h) { return (i & 3) + 8 * (i >> 2) + 4 * h; }
DI float sigmoidf_(float x) { return 1.f / (1.f + __expf(-x)); }

DI int lds_off(int row, int chunk) { return row * 128 + ((chunk ^ ((row >> 1) & 7)) << 4); }

#define LAS __attribute__((address_space(3)))
constexpr int NSTAGE = 3;
constexpr int STAGE_B = 49152;
constexpr int LDS_BYTES = NSTAGE * STAGE_B;
DI void glds16(const void* g, char* l) { __builtin_amdgcn_global_load_lds((const unsigned*)g, (LAS unsigned*)l, 16, 0, 0); }

template <int PART = 0>
DI void gemm_core(const bf16_t* __restrict__ A, int lda, const bf16_t* __restrict__ Bt, int ldb, int K,
                  f32x16 (&acc)[2][2], char* lds) {
  const int tid = TIDX, lane = tid & 63, wid = tid >> 6, wr = wid >> 1, wc = wid & 1, r = lane & 31, h = lane >> 5;
  const int ch = (tid & 7) ^ ((tid >> 4) & 7);
  unsigned avo[4], bvo[2];
#pragma unroll
  for (int i = 0; i < 4; ++i) avo[i] = (unsigned)(((tid >> 3) + 64 * i) * lda * 2 + ch * 16);
#pragma unroll
  for (int i = 0; i < 2; ++i) bvo[i] = (unsigned)(((tid >> 3) + 64 * i) * ldb * 2 + ch * 16);
  const char* Ab = (const char*)A; const char* Bb = (const char*)Bt;
  char* lw = lds + tid * 16;
  const int nk = K >> 6;
  const unsigned swz = (unsigned)((r >> 1) & 7);
  const unsigned arow_u = (unsigned)((wr * 64 + r) * 128), brow_u = (unsigned)((wc * 64 + r) * 128);
  const unsigned co0 = ((0u + h) ^ swz) << 4, co1 = ((2u + h) ^ swz) << 4, co2 = ((4u + h) ^ swz) << 4, co3 = ((6u + h) ^ swz) << 4;
#define GEMM_ISSUE(kt_, st_) do { char* sb_ = lw + (st_) * STAGE_B; const char* ak_ = Ab + (size_t)(kt_) * 128; const char* bk_ = Bb + (size_t)(kt_) * 128; \
    _Pragma("unroll") for (int i_ = 0; i_ < 4; ++i_) glds16(ak_ + avo[i_], sb_ + i_ * 8192); \
    _Pragma("unroll") for (int i_ = 0; i_ < 2; ++i_) glds16(bk_ + bvo[i_], sb_ + 32768 + i_ * 8192); } while (0)
  if (PART != 2) {
    GEMM_ISSUE(0, 0);
    if (nk > 1) GEMM_ISSUE(1, 1);
  }
  if (PART == 1) return;
  int st = 0;
  for (int kt = 0; kt < nk; ++kt) {
    if (kt + 1 < nk) asm volatile("s_waitcnt vmcnt(6)" ::: "memory");
    else asm volatile("s_waitcnt vmcnt(0)" ::: "memory");
    __builtin_amdgcn_s_barrier();
    asm volatile("" ::: "memory");
    if (kt + 2 < nk) { const int st2 = (st >= 1) ? st - 1 : 2; GEMM_ISSUE(kt + 2, st2); }
    const char* la = lds + st * STAGE_B;
    const char* lb = la + 32768;
    const unsigned sa_u = (unsigned)(size_t)la + arow_u, sb_u = (unsigned)(size_t)lb + brow_u;
    const unsigned a0 = sa_u + co0, a1 = sa_u + co1, a2 = sa_u + co2, a3 = sa_u + co3;
    const unsigned b0 = sb_u + co0, b1 = sb_u + co1, b2 = sb_u + co2, b3 = sb_u + co3;
    {
      bf16x8 p0, p1, q0, q1, u0, u1, w0, w1;
      asm volatile(
        "ds_read_b128 %4, %12\n\tds_read_b128 %5, %12 offset:4096\n\tds_read_b128 %6, %16\n\tds_read_b128 %7, %16 offset:4096\n\t"
        "ds_read_b128 %8, %13\n\tds_read_b128 %9, %13 offset:4096\n\tds_read_b128 %10, %17\n\tds_read_b128 %11, %17 offset:4096\n\t"
        "s_waitcnt lgkmcnt(4)\n\t"
        "v_mfma_f32_32x32x16_bf16 %0, %4, %6, %0\n\tv_mfma_f32_32x32x16_bf16 %1, %4, %7, %1\n\tv_mfma_f32_32x32x16_bf16 %2, %5, %6, %2\n\tv_mfma_f32_32x32x16_bf16 %3, %5, %7, %3\n\t"
        "ds_read_b128 %4, %14\n\tds_read_b128 %5, %14 offset:4096\n\tds_read_b128 %6, %18\n\tds_read_b128 %7, %18 offset:4096\n\t"
        "s_waitcnt lgkmcnt(4)\n\t"
        "v_mfma_f32_32x32x16_bf16 %0, %8, %10, %0\n\tv_mfma_f32_32x32x16_bf16 %1, %8, %11, %1\n\tv_mfma_f32_32x32x16_bf16 %2, %9, %10, %2\n\tv_mfma_f32_32x32x16_bf16 %3, %9, %11, %3\n\t"
        "ds_read_b128 %8, %15\n\tds_read_b128 %9, %15 offset:4096\n\tds_read_b128 %10, %19\n\tds_read_b128 %11, %19 offset:4096\n\t"
        "s_waitcnt lgkmcnt(4)\n\t"
        "v_mfma_f32_32x32x16_bf16 %0, %4, %6, %0\n\tv_mfma_f32_32x32x16_bf16 %1, %4, %7, %1\n\tv_mfma_f32_32x32x16_bf16 %2, %5, %6, %2\n\tv_mfma_f32_32x32x16_bf16 %3, %5, %7, %3\n\t"
        "s_waitcnt lgkmcnt(0)\n\t"
        "v_mfma_f32_32x32x16_bf16 %0, %8, %10, %0\n\tv_mfma_f32_32x32x16_bf16 %1, %8, %11, %1\n\tv_mfma_f32_32x32x16_bf16 %2, %9, %10, %2\n\tv_mfma_f32_32x32x16_bf16 %3, %9, %11, %3"
        : "+v"(acc[0][0]), "+v"(acc[0][1]), "+v"(acc[1][0]), "+v"(acc[1][1]),
          "=&v"(p0), "=&v"(p1), "=&v"(q0), "=&v"(q1), "=&v"(u0), "=&v"(u1), "=&v"(w0), "=&v"(w1)
        : "v"(a0), "v"(a1), "v"(a2), "v"(a3), "v"(b0), "v"(b1), "v"(b2), "v"(b3));
    }
    st = (st == 2) ? 0 : st + 1;
  }
  asm volatile("s_nop 15\n\ts_nop 15\n\ts_nop 7" ::: "memory");
  __builtin_amdgcn_s_barrier();
  asm volatile("" ::: "memory");
}

DI void zero_acc(f32x16 (&acc)[2][2]) {
#pragma unroll
  for (int a = 0; a < 2; ++a)
#pragma unroll
    for (int b = 0; b < 2; ++b)
#pragma unroll
      for (int i = 0; i < 16; ++i) acc[a][b][i] = 0.f;
}

DI bool tile_map(int L, int MT, int NTl, int SN, int& mt, int& nt) {
  const int xcd = L & 7, ix = L >> 3, per = 8 * SN, st = ix / per, w = ix % per;
  const int gst = st * 8 + xcd, SNT = NTl / SN, total = (MT >> 3) * SNT;
  if (gst >= total) return false;
  const int smt = gst / SNT, snt = gst % SNT;
  mt = smt * 8 + (w & 7); nt = snt * SN + (w >> 3);
  return true;
}
DI int tile_lmax(int MT, int NTl, int SN) { const int total = (MT >> 3) * (NTl / SN); return ((total + 7) >> 3) * 8 * SN * 8; }

struct EpiSwiglu {
  static constexpr bool PRE = false;
  bf16_t* ffh;
  DI void operator()(const f32x16 (&acc)[2][2], int m0, int n0) const {
    const int tid = TIDX, lane = tid & 63, wid = tid >> 6, wr = wid >> 1, wc = wid & 1, r = lane & 31, h = lane >> 5;
    const int hid = (n0 >> 7) * 64 + wc * 32 + r;
#pragma unroll
    for (int mi = 0; mi < 2; ++mi)
#pragma unroll
      for (int i = 0; i < 16; ++i) {
        const int row = m0 + wr * 64 + mi * 32 + crow(i, h);
        const float g = acc[mi][0][i], u = acc[mi][1][i];
        ffh[(size_t)row * DFF + hid] = f2bf(g * sigmoidf_(g) * u);
      }
  }
};
struct EpiResid {
  const float* res; float* out; float scale;
  static constexpr bool PRE = true;
  DI void pre(float (&rv)[2][2][16], int m0, int n0) const {
    const int tid = TIDX, lane = tid & 63, wid = tid >> 6, wr = wid >> 1, wc = wid & 1, r = lane & 31, h = lane >> 5;
#pragma unroll
    for (int mi = 0; mi < 2; ++mi)
#pragma unroll
      for (int ni = 0; ni < 2; ++ni)
#pragma unroll
        for (int i = 0; i < 16; ++i)
          rv[mi][ni][i] = res[(size_t)(m0 + wr * 64 + mi * 32 + crow(i, h)) * DM + n0 + wc * 64 + ni * 32 + r];
  }
  DI void operator()(const f32x16 (&acc)[2][2], int m0, int n0, const float (&rv)[2][2][16]) const {
    const int tid = TIDX, lane = tid & 63, wid = tid >> 6, wr = wid >> 1, wc = wid & 1, r = lane & 31, h = lane >> 5;
#pragma unroll
    for (int mi = 0; mi < 2; ++mi)
#pragma unroll
      for (int ni = 0; ni < 2; ++ni)
#pragma unroll
        for (int i = 0; i < 16; ++i)
          out[(size_t)(m0 + wr * 64 + mi * 32 + crow(i, h)) * DM + n0 + wc * 64 + ni * 32 + r] = rv[mi][ni][i] + scale * acc[mi][ni][i];
  }
};
struct EpiGelu {
  static constexpr bool PRE = false;
  bf16_t* o; const float* bias;
  DI void operator()(const f32x16 (&acc)[2][2], int m0, int n0) const {
    const int tid = TIDX, lane = tid & 63, wid = tid >> 6, wr = wid >> 1, wc = wid & 1, r = lane & 31, h = lane >> 5;
#pragma unroll
    for (int mi = 0; mi < 2; ++mi)
#pragma unroll
      for (int ni = 0; ni < 2; ++ni) {
        const int col = n0 + wc * 64 + ni * 32 + r;
        const float bv = bias[col];
#pragma unroll
        for (int i = 0; i < 16; ++i) {
          const int row = m0 + wr * 64 + mi * 32 + crow(i, h);
          const float x = acc[mi][ni][i] + bv;
          o[(size_t)row * 256 + col] = f2bf(x * sigmoidf_(1.5957691216057308f * (x + 0.044715f * x * x * x)));
        }
      }
  }
};
template <int transposed> struct EpiCmpOut {
  static constexpr bool PRE = false;
  bf16_t* o;
  DI void operator()(const f32x16 (&acc)[2][2], int m0, int n0) const {
    const int tid = TIDX, lane = tid & 63, wid = tid >> 6, wr = wid >> 1, wc = wid & 1, r = lane & 31, h = lane >> 5;
    if (wc != 0) return;
#pragma unroll
    for (int mi = 0; mi < 2; ++mi)
#pragma unroll
      for (int ni = 0; ni < 2; ++ni) {
        const int col = ni * 32 + r;
#pragma unroll
        for (int i = 0; i < 16; ++i) {
          const int row = m0 + wr * 64 + mi * 32 + crow(i, h);
          const bf16_t v = f2bf(acc[mi][ni][i]);
          if (transposed) o[(size_t)(row >> 8) * 16384 + vfrag_idx(row & 255, col)] = v;
          else o[(size_t)(row >> 8) * 16384 + kfrag_idx(row & 255, col)] = v;
        }
      }
  }
};
struct EpiWin {
  static constexpr bool PRE = false;
  char* ws;
  DI void operator()(const f32x16 (&acc)[2][2], int m0, int n0) const {
    const int tid = TIDX, lane = tid & 63, wid = tid >> 6, wr = wid >> 1, wc = wid & 1, r = lane & 31, h = lane >> 5;
    const int cidx = (n0 >> 6) + wc;
    if (cidx >= 49) return;
    const int rowbase = m0 + wr * 64;
    const int b = rowbase >> 12;
    int kind;
    bf16_t* base; int ld = 0, colb = 0, hb = 0, dil = 1; bool kfrag = false;
    if (cidx < 6) { kind = 0; base = (bf16_t*)(ws + OFF_QN); ld = 384; colb = cidx * 64; }
    else if (cidx < 18) { const int t = (cidx - 6) >> 1, g = (cidx - 6) & 1; hb = b * 2 + g;
      const size_t off = (t == 0) ? OFF_KCMP : (t == 1) ? OFF_VCMP : (t == 2) ? OFF_KSEL : (t == 3) ? OFF_VSELT : (t == 4) ? OFF_KWIN : OFF_VWINT;
      base = (bf16_t*)(ws + off); kind = (t == 3 || t == 5) ? 2 : 1; kfrag = (t == 2 || t == 4); }
    else if (cidx < 22) { kind = 0; base = (bf16_t*)(ws + OFF_QM); ld = 256; colb = (cidx - 18) * 64; }
    else if (cidx < 26) { kind = 1; kfrag = true; base = (bf16_t*)(ws + OFF_KM); hb = b * 4 + (cidx - 22); }
    else if (cidx < 30) { kind = 2; base = (bf16_t*)(ws + OFF_VMT); hb = b * 4 + (cidx - 26); }
    else if (cidx < 36) { kind = 0; base = (bf16_t*)(ws + OFF_QD); ld = 384; colb = (cidx - 30) * 64; }
    else if (cidx < 42) { kind = 1; kfrag = true; base = (bf16_t*)(ws + OFF_KD); hb = b * 6 + (cidx - 36); const int g = (cidx - 36) >> 1; dil = (g == 0) ? 1 : (g == 1 ? 4 : 16); }
    else if (cidx < 48) { kind = 2; base = (bf16_t*)(ws + OFF_VDT); hb = b * 6 + (cidx - 42); const int g = (cidx - 42) >> 1; dil = (g == 0) ? 1 : (g == 1 ? 4 : 16); }
    else { kind = 3; base = nullptr; }
    if (kind == 0) {
#pragma unroll
      for (int mi = 0; mi < 2; ++mi)
#pragma unroll
        for (int ni = 0; ni < 2; ++ni)
#pragma unroll
          for (int i = 0; i < 16; ++i) {
            const int row = rowbase + mi * 32 + crow(i, h);
            base[(size_t)row * ld + colb + ni * 32 + r] = f2bf(acc[mi][ni][i] * 0.18033688011112042f);
          }
    } else if (kind == 1) {
#pragma unroll
      for (int mi = 0; mi < 2; ++mi)
#pragma unroll
        for (int ni = 0; ni < 2; ++ni)
#pragma unroll
          for (int i = 0; i < 16; ++i) {
            const int s = (rowbase & 4095) + mi * 32 + crow(i, h);
            if (kfrag) { const int pos = (dil == 1) ? s : (s % dil) * (4096 / dil) + s / dil; base[(size_t)hb * 262144 + kfrag_idx(pos, ni * 32 + r)] = f2bf(acc[mi][ni][i]); }
            else base[((size_t)hb * 4096 + s) * 64 + ni * 32 + r] = f2bf(acc[mi][ni][i]);
          }
    } else if (kind == 2) {
      if (dil == 1) {
#pragma unroll
        for (int mi = 0; mi < 2; ++mi)
#pragma unroll
          for (int ni = 0; ni < 2; ++ni)
#pragma unroll
            for (int q = 0; q < 4; ++q) {
              const int s = (rowbase & 4095) + mi * 32 + 8 * q + 4 * h;
              u32x2 v; v.x = pack2(acc[mi][ni][4 * q], acc[mi][ni][4 * q + 1]); v.y = pack2(acc[mi][ni][4 * q + 2], acc[mi][ni][4 * q + 3]);
              *(u32x2*)(base + (size_t)hb * 262144 + vfrag_idx(s, ni * 32 + r)) = v;
            }
      } else {
        const int L = 4096 / dil;
#pragma unroll
        for (int mi = 0; mi < 2; ++mi)
#pragma unroll
          for (int ni = 0; ni < 2; ++ni)
#pragma unroll
            for (int i = 0; i < 16; ++i) {
              const int s = (rowbase & 4095) + mi * 32 + crow(i, h);
              const int pos = (s % dil) * L + s / dil;
              base[(size_t)hb * 262144 + vfrag_idx(pos, ni * 32 + r)] = f2bf(acc[mi][ni][i]);
            }
      }
    } else {
      float* gt = (float*)(ws + OFF_GATES);
      if (r < 18) {
#pragma unroll
        for (int mi = 0; mi < 2; ++mi)
#pragma unroll
          for (int i = 0; i < 16; ++i) {
            const int row = rowbase + mi * 32 + crow(i, h);
            gt[(size_t)row * 18 + r] = sigmoidf_(acc[mi][0][i]);
          }
      }
    }
  }
};

template <class Epi>
DI void gemm_phase(const bf16_t* A, int lda, const bf16_t* Bt, int ldb, int K, int MT, int NTl, int SN, const Epi& epi, char* lds, bool rev = false) {
  const int lmax = tile_lmax(MT, NTl, SN);
  int L = blockIdx.x, mt = 0, nt = 0;
  bool have = false;
  for (; L < lmax; L += gridDim.x) if (tile_map(L, MT, NTl, SN, mt, nt)) { have = true; if (rev) mt = MT - 1 - mt; break; }
  f32x16 dummy[2][2];
  if (have) gemm_core<1>(A + (size_t)mt * 256 * lda, lda, Bt + (size_t)nt * 128 * ldb, ldb, K, dummy, lds);
  while (have) {
    f32x16 acc[2][2];
    zero_acc(acc);
    const int cmt = mt, cnt = nt;
    float rv[Epi::PRE ? 2 : 1][2][16];
    if constexpr (Epi::PRE) epi.pre(rv, cmt * 256, cnt * 128);
    gemm_core<2>(A + (size_t)cmt * 256 * lda, lda, Bt + (size_t)cnt * 128 * ldb, ldb, K, acc, lds);
    have = false;
    for (L += gridDim.x; L < lmax; L += gridDim.x) if (tile_map(L, MT, NTl, SN, mt, nt)) { have = true; if (rev) mt = MT - 1 - mt; break; }
    if (have) gemm_core<1>(A + (size_t)mt * 256 * lda, lda, Bt + (size_t)nt * 128 * ldb, ldb, K, dummy, lds);
    if constexpr (Epi::PRE) epi(acc, cmt * 256, cnt * 128, rv); else epi(acc, cmt * 256, cnt * 128);
  }
}

struct ConvD { const float* src; const float* src2; bf16_t* dst; int K, Nsrc, Nout, mode, coloff, nvalid; };
constexpr int CONV_NT[14] = {1408, 704, 1408, 704, 800, 768, 128, 128, 8, 8, 96, 64, 32, 256};
constexpr int CONV_PER_LAYER = 6512;

DI ConvD get_conv(const Params& p, int l, int id) {
  ConvD c; c.src2 = nullptr; c.mode = 0; c.coloff = 0;
  bf16_t* wl = (bf16_t*)(p.ws + OFF_W) + (size_t)l * W_LAYER;
  switch (id) {
    case 0: c.src = p.in[I_F1G] + (size_t)l * 1024 * DFF; c.src2 = p.in[I_F1U] + (size_t)l * 1024 * DFF; c.dst = wl + OW_GU1; c.K = 1024; c.Nsrc = DFF; c.Nout = 5632; c.mode = 1; c.nvalid = 5632; break;
    case 1: c.src = p.in[I_F1D] + (size_t)l * DFF * 1024; c.dst = wl + OW_DN1; c.K = DFF; c.Nsrc = 1024; c.Nout = 1024; c.nvalid = 1024; break;
    case 2: c.src = p.in[I_F2G] + (size_t)l * 1024 * DFF; c.src2 = p.in[I_F2U] + (size_t)l * 1024 * DFF; c.dst = wl + OW_GU2; c.K = 1024; c.Nsrc = DFF; c.Nout = 5632; c.mode = 1; c.nvalid = 5632; break;
    case 3: c.src = p.in[I_F2D] + (size_t)l * DFF * 1024; c.dst = wl + OW_DN2; c.K = DFF; c.Nsrc = 1024; c.Nout = 1024; c.nvalid = 1024; break;
    case 4: c.src = p.in[I_WIN] + (size_t)l * 1024 * 6162; c.dst = wl + OW_INM; c.K = 1024; c.Nsrc = 6162; c.Nout = 3200; c.mode = 2; c.nvalid = 3090; break;
    case 5: c.src = p.in[I_WIN] + (size_t)l * 1024 * 6162; c.dst = wl + OW_ING; c.K = 1024; c.Nsrc = 6162; c.Nout = 3072; c.coloff = 3090; c.nvalid = 3072; break;
    case 6: c.src = p.in[I_PK1] + (size_t)l * 2048 * 256; c.dst = wl + OW_PK1; c.K = 2048; c.Nsrc = 256; c.Nout = 256; c.nvalid = 256; break;
    case 7: c.src = p.in[I_PV1] + (size_t)l * 2048 * 256; c.dst = wl + OW_PV1; c.K = 2048; c.Nsrc = 256; c.Nout = 256; c.nvalid = 256; break;
    case 8: c.src = p.in[I_PK2] + (size_t)l * 256 * 64; c.dst = wl + OW_PK2; c.K = 256; c.Nsrc = 64; c.Nout = 128; c.nvalid = 64; break;
    case 9: c.src = p.in[I_PV2] + (size_t)l * 256 * 64; c.dst = wl + OW_PV2; c.K = 256; c.Nsrc = 64; c.Nout = 128; c.nvalid = 64; break;
    case 10: c.src = p.in[I_UA] + (size_t)l * 384 * 1024; c.dst = wl + OW_UA; c.K = 384; c.Nsrc = 1024; c.Nout = 1024; c.nvalid = 1024; break;
    case 11: c.src = p.in[I_UB] + (size_t)l * 256 * 1024; c.dst = wl + OW_UB; c.K = 256; c.Nsrc = 1024; c.Nout = 1024; c.nvalid = 1024; break;
    case 12: c.src = p.in[I_UC] + (size_t)l * 128 * 1024; c.dst = wl + OW_UC; c.K = 128; c.Nsrc = 1024; c.Nout = 1024; c.nvalid = 1024; break;
    default: c.src = p.in[I_WO] + (size_t)l * 1024 * 1024; c.dst = wl + OW_WO; c.K = 1024; c.Nsrc = 1024; c.Nout = 1024; c.nvalid = 1024; break;
  }
  return c;
}

DI void conv_tile(const ConvD& c, int tn, int tk, float* lds) {
  const int tid = TIDX;
  const int n0 = tn * 64, k0 = tk * 64;
  {
    const int j = tid & 63, np = n0 + j;
    const float* sp = c.src; int col = -1;
    if (c.mode == 0) { if (np < c.nvalid) col = c.coloff + np; }
    else if (c.mode == 1) { const int tile = np >> 7, within = np & 127, wc = within >> 6, part = (within & 63) >> 5, jj = within & 31;
      col = tile * 64 + wc * 32 + jj; if (part) sp = c.src2; }
    else { if (np < 1152) col = np; else if (np < 3072) col = 1170 + (np - 1152); else if (np < 3090) col = 1152 + (np - 3072); }
    float tv[8];
#pragma unroll
    for (int i = 0; i < 8; ++i) {
      const int kk = (tid >> 6) + 8 * i;
      tv[i] = (col >= 0) ? sp[(size_t)(k0 + kk) * c.Nsrc + col] : 0.f;
    }
#pragma unroll
    for (int i = 0; i < 8; ++i) lds[((tid >> 6) + 8 * i) * 65 + j] = tv[i];
  }
  __syncthreads();
  {
    const int kk = tid & 63;
#pragma unroll
    for (int i = 0; i < 8; ++i) {
      const int j = (tid >> 6) + 8 * i;
      c.dst[(size_t)(n0 + j) * c.K + k0 + kk] = f2bf(lds[kk * 65 + j]);
    }
  }
  __syncthreads();
}

DI void rms_phase(const float* x, const float* gain, bf16_t* hn) {
  const int lane = TIDX & 63;
  const int gw = blockIdx.x * 8 + (TIDX >> 6), nw = gridDim.x * 8;
  f32x4 g[4];
#pragma unroll
  for (int i = 0; i < 4; ++i) g[i] = *(const f32x4*)(gain + i * 256 + lane * 4);
  for (int row = gw; row < NT; row += 2 * nw) {
    const int row2 = (row + nw < NT) ? row + nw : row;
    f32x4 v[4], w2[4]; float ss = 0.f, ss2 = 0.f;
#pragma unroll
    for (int i = 0; i < 4; ++i) { v[i] = *(const f32x4*)(x + (size_t)row * DM + i * 256 + lane * 4); w2[i] = *(const f32x4*)(x + (size_t)row2 * DM + i * 256 + lane * 4); }
#pragma unroll
    for (int i = 0; i < 4; ++i) { ss += v[i][0] * v[i][0] + v[i][1] * v[i][1] + v[i][2] * v[i][2] + v[i][3] * v[i][3]; ss2 += w2[i][0] * w2[i][0] + w2[i][1] * w2[i][1] + w2[i][2] * w2[i][2] + w2[i][3] * w2[i][3]; }
#pragma unroll
    for (int o = 32; o >= 1; o >>= 1) { ss += __shfl_xor(ss, o); ss2 += __shfl_xor(ss2, o); }
    const float rs = rsqrtf(ss * (1.f / 1024.f) + 1e-6f), rs2 = rsqrtf(ss2 * (1.f / 1024.f) + 1e-6f);
#pragma unroll
    for (int i = 0; i < 4; ++i) {
      u32x2 w; w.x = pack2(v[i][0] * rs * g[i][0], v[i][1] * rs * g[i][1]); w.y = pack2(v[i][2] * rs * g[i][2], v[i][3] * rs * g[i][3]);
      *(u32x2*)(hn + (size_t)row * DM + i * 256 + lane * 4) = w;
      u32x2 w3; w3.x = pack2(w2[i][0] * rs2 * g[i][0], w2[i][1] * rs2 * g[i][1]); w3.y = pack2(w2[i][2] * rs2 * g[i][2], w2[i][3] * rs2 * g[i][3]);
      *(u32x2*)(hn + (size_t)row2 * DM + i * 256 + lane * 4) = w3;
    }
  }
}
DI void final_norm_phase(float* x, const float* gain) {
  const int lane = TIDX & 63;
  const int gw = blockIdx.x * 8 + (TIDX >> 6), nw = gridDim.x * 8;
  f32x4 g[4];
#pragma unroll
  for (int i = 0; i < 4; ++i) g[i] = *(const f32x4*)(gain + i * 256 + lane * 4);
  for (int row = gw; row < NT; row += nw) {
    f32x4 v[4]; float ss = 0.f;
#pragma unroll
    for (int i = 0; i < 4; ++i) { v[i] = *(const f32x4*)(x + (size_t)row * DM + i * 256 + lane * 4); ss += v[i][0] * v[i][0] + v[i][1] * v[i][1] + v[i][2] * v[i][2] + v[i][3] * v[i][3]; }
#pragma unroll
    for (int o = 32; o >= 1; o >>= 1) ss += __shfl_xor(ss, o);
    const float rs = rsqrtf(ss * (1.f / 1024.f) + 1e-6f);
#pragma unroll
    for (int i = 0; i < 4; ++i) {
      f32x4 w; w[0] = v[i][0] * rs * g[i][0]; w[1] = v[i][1] * rs * g[i][1]; w[2] = v[i][2] * rs * g[i][2]; w[3] = v[i][3] * rs * g[i][3];
      *(f32x4*)(x + (size_t)row * DM + i * 256 + lane * 4) = w;
    }
  }
}

DI void phase0(const Params& p, char* lds) {
  if (blockIdx.x == 0 && TIDX < 64) { ((unsigned*)(p.ws + OFF_MISC))[TIDX] = 0u; ((unsigned*)(p.ws + OFF_MISC + 6144))[TIDX] = 0u; }
  for (int it = blockIdx.x; it < 4; it += gridDim.x) {
    const int l = it >> 1, kv = it & 1;
    const float* pe = p.in[kv ? I_PEV : I_PEK] + (size_t)l * 2048;
    const float* w = p.in[kv ? I_PV1 : I_PK1] + (size_t)l * 2048 * 256;
    const int n = TIDX;
    if (n < 256) {
      float s = 0.f;
      for (int k = 0; k < 2048; ++k) s += pe[k] * w[(size_t)k * 256 + n];
      ((float*)(p.ws + OFF_MISC + 256))[it * 256 + n] = s;
    }
  }
  for (int w = blockIdx.x; w < 2 * CONV_PER_LAYER; w += gridDim.x) {
    const int l = w / CONV_PER_LAYER; int ww = w % CONV_PER_LAYER; int id = 0;
#pragma unroll
    for (int i = 0; i < 14; ++i) { if (id == i && ww >= CONV_NT[i]) { ww -= CONV_NT[i]; id = i + 1; } }
    const ConvD c = get_conv(p, l, id);
    const int ntn = c.Nout >> 6;
    conv_tile(c, ww % ntn, ww / ntn, (float*)lds);
  }
  rms_phase(p.in[I_X], p.in[I_F1N], (bf16_t*)(p.ws + OFF_HN));
}

constexpr int BK_THR[15] = {22, 30, 40, 54, 73, 99, 134, 182, 246, 332, 450, 609, 825, 1117, 1513};
struct AttnSt { float m, l; f32x16 o0, o1; };
DI void attn_init(AttnSt& st) { st.m = NEGINF; st.l = 0.f;
#pragma unroll
  for (int i = 0; i < 16; ++i) { st.o0[i] = 0.f; st.o1[i] = 0.f; } }

DI void load_q(bf16x8 (&qf)[4], const bf16_t* qrow) {
#pragma unroll
  for (int s = 0; s < 4; ++s) qf[s] = *(const bf16x8*)(qrow + 16 * s);
}
DI f32x16 qk_tile(const bf16x8 (&qf)[4], const bf16_t* krow) {
  f32x16 s;
#pragma unroll
  for (int i = 0; i < 16; ++i) s[i] = 0.f;
#pragma unroll
  for (int ss = 0; ss < 4; ++ss) { const bf16x8 kf = *(const bf16x8*)(krow + 512 * ss); s = MFMA32(kf, qf[ss], s); }
  return s;
}
DI void pv_tile(AttnSt& st, const float (&pr)[16], const bf16_t* v0, size_t rowstride) {
#pragma unroll
  for (int s2 = 0; s2 < 2; ++s2) {
    u32x4 pk; pk.x = pack2(pr[8 * s2], pr[8 * s2 + 1]); pk.y = pack2(pr[8 * s2 + 2], pr[8 * s2 + 3]); pk.z = pack2(pr[8 * s2 + 4], pr[8 * s2 + 5]); pk.w = pack2(pr[8 * s2 + 6], pr[8 * s2 + 7]);
    const bf16x8 pb = __builtin_bit_cast(bf16x8, pk);
    {
      const s16x4 lo = *(const s16x4*)(v0 + 256 * (s2 * 4 + 0)), hi = *(const s16x4*)(v0 + 256 * (s2 * 4 + 1));
      const bf16x8 va = __builtin_shufflevector(lo, hi, 0, 1, 2, 3, 4, 5, 6, 7);
      st.o0 = MFMA32(va, pb, st.o0);
    }
    {
      const s16x4 lo = *(const s16x4*)(v0 + 256 * (s2 * 4 + 2)), hi = *(const s16x4*)(v0 + 256 * (s2 * 4 + 3));
      const bf16x8 va = __builtin_shufflevector(lo, hi, 0, 1, 2, 3, 4, 5, 6, 7);
      st.o1 = MFMA32(va, pb, st.o1);
    }
  }
}
DI void softmax_step(AttnSt& st, const float (&lg)[16], const bf16_t* v0, size_t rowstride) {
  float mx = NEGINF;
#pragma unroll
  for (int i = 0; i < 16; ++i) mx = fmaxf(mx, lg[i]);
  mx = fmaxf(mx, shx32(mx));
  if (__ballot(mx > NEGINF) == 0ull) return;
  const float mnew = fmaxf(st.m, mx);
  const float muse = (mnew == NEGINF) ? 0.f : mnew;
  const float alpha = ex2(st.m - muse);
  float pr[16]; float rs = 0.f;
#pragma unroll
  for (int i = 0; i < 16; ++i) { pr[i] = ex2(lg[i] - muse); rs += pr[i]; }
  st.l = st.l * alpha + rs; st.m = mnew;
#pragma unroll
  for (int i = 0; i < 16; ++i) { st.o0[i] *= alpha; st.o1[i] *= alpha; }
  pv_tile(st, pr, v0, rowstride);
}

struct KVT { bf16x8 k[4]; s16x4 v[8]; };
DI void load_kv(KVT& t, const bf16_t* krow, const bf16_t* v0, size_t rowstride) {
#pragma unroll
  for (int ss = 0; ss < 4; ++ss) t.k[ss] = *(const bf16x8*)(krow + 512 * ss);
#pragma unroll
  for (int j = 0; j < 8; ++j) t.v[j] = *(const s16x4*)(v0 + 256 * j);
}
DI void softmax_step_r(AttnSt& st, const float (&lg)[16], const KVT& t) {
  float mx = NEGINF;
#pragma unroll
  for (int i = 0; i < 16; ++i) mx = fmaxf(mx, lg[i]);
  mx = fmaxf(mx, shx32(mx));
  if (__ballot(mx > NEGINF) == 0ull) return;
  const float mnew = fmaxf(st.m, mx);
  const float muse = (mnew == NEGINF) ? 0.f : mnew;
  const float alpha = ex2(st.m - muse);
  float pr[16]; float rs = 0.f;
#pragma unroll
  for (int i = 0; i < 16; ++i) { pr[i] = ex2(lg[i] - muse); rs += pr[i]; }
  st.l = st.l * alpha + rs;
  if (__ballot(mnew != st.m) != 0ull) {
#pragma unroll
    for (int i = 0; i < 16; ++i) { st.o0[i] *= alpha; st.o1[i] *= alpha; }
  }
  st.m = mnew;
#pragma unroll
  for (int s2 = 0; s2 < 2; ++s2) {
    u32x4 pk; pk.x = pack2(pr[8 * s2], pr[8 * s2 + 1]); pk.y = pack2(pr[8 * s2 + 2], pr[8 * s2 + 3]); pk.z = pack2(pr[8 * s2 + 4], pr[8 * s2 + 5]); pk.w = pack2(pr[8 * s2 + 6], pr[8 * s2 + 7]);
    const bf16x8 pb = __builtin_bit_cast(bf16x8, pk);
    const bf16x8 va0 = __builtin_shufflevector(t.v[s2 * 4 + 0], t.v[s2 * 4 + 1], 0, 1, 2, 3, 4, 5, 6, 7);
    st.o0 = MFMA32(va0, pb, st.o0);
    const bf16x8 va1 = __builtin_shufflevector(t.v[s2 * 4 + 2], t.v[s2 * 4 + 3], 0, 1, 2, 3, 4, 5, 6, 7);
    st.o1 = MFMA32(va1, pb, st.o1);
  }
}
template <class KP, class VP, class ACT, class FILL>
DI void attn_loop(AttnSt& st, const bf16x8 (&qf)[4], int k0, int k1, size_t vstride, KP kp, VP vp, ACT act, FILL fill) {
  KVT cur, nxt;
  {
    KVT t0; load_kv(t0, kp(k0), vp(k0), vstride);
#pragma unroll
    for (int i = 0; i < 8; ++i) cur.v[i] = t0.v[i];
#pragma unroll
    for (int i = 0; i < 4; ++i) cur.k[i] = t0.k[i];
  }
  f32x16 s_cur;
  { const float z = 0.f;
#pragma unroll
    for (int i = 0; i < 16; ++i) s_cur[i] = z; }
#pragma unroll
  for (int ss = 0; ss < 4; ++ss) s_cur = MFMA32(cur.k[ss], qf[ss], s_cur);
  {
    const int kn = (k0 < k1) ? k0 + 1 : k1;
    const bf16_t* krow = kp(kn);
#pragma unroll
    for (int ss = 0; ss < 4; ++ss) nxt.k[ss] = *(const bf16x8*)(krow + 512 * ss);
  }
  for (int kt = k0; kt <= k1; ++kt) {
    const int kn = (kt < k1) ? kt + 1 : k1;
    const int kn2 = (kt + 2 <= k1) ? kt + 2 : k1;
    {
      const bf16_t* v0 = vp(kn);
#pragma unroll
      for (int j = 0; j < 8; ++j) nxt.v[j] = *(const s16x4*)(v0 + 256 * j);
    }
    bf16x8 k2[4];
    {
      const bf16_t* krow = kp(kn2);
#pragma unroll
      for (int ss = 0; ss < 4; ++ss) k2[ss] = *(const bf16x8*)(krow + 512 * ss);
    }
    f32x16 s_next;
#pragma unroll
    for (int i = 0; i < 16; ++i) s_next[i] = 0.f;
#pragma unroll
    for (int ss = 0; ss < 4; ++ss) s_next = MFMA32(nxt.k[ss], qf[ss], s_next);
    if (act(kt)) {
      float lg[16];
      fill(kt, s_cur, lg);
      softmax_step_r(st, lg, cur);
    }
    s_cur = s_next;
#pragma unroll
    for (int i = 0; i < 8; ++i) cur.v[i] = nxt.v[i];
#pragma unroll
    for (int ss = 0; ss < 4; ++ss) nxt.k[ss] = k2[ss];
  }
}

DI float lut_bias(const unsigned char* blut, const float* tblh, int dist) {
  const int d = dist < 0 ? 0 : (dist > 2048 ? 2048 : dist);
  return tblh[blut[d]];
}
DI void bias16(const unsigned char* blut, const float* tblh, const int (&dist)[16], float (&bv)[16]) {
  int bk[16];
#pragma unroll
  for (int i = 0; i < 16; ++i) { const int d = dist[i] < 0 ? 0 : (dist[i] > 2048 ? 2048 : dist[i]); bk[i] = blut[d]; }
#pragma unroll
  for (int i = 0; i < 16; ++i) asm volatile("" : "+v"(bk[i]));
#pragma unroll
  for (int i = 0; i < 16; ++i) bv[i] = tblh[bk[i]];
#pragma unroll
  for (int i = 0; i < 16; ++i) asm volatile("" : "+v"(bv[i]));
}
DI void store_o(bf16_t* dst, const f32x16& o0, const f32x16& o1, int h) {
#pragma unroll
  for (int g = 0; g < 4; ++g) {
    u32x2 a; a.x = pack2(o0[4 * g], o0[4 * g + 1]); a.y = pack2(o0[4 * g + 2], o0[4 * g + 3]);
    *(u32x2*)(dst + 8 * g + 4 * h) = a;
    u32x2 b; b.x = pack2(o1[4 * g], o1[4 * g + 1]); b.y = pack2(o1[4 * g + 2], o1[4 * g + 3]);
    *(u32x2*)(dst + 32 + 8 * g + 4 * h) = b;
  }
}

DI void build_lut(unsigned char* blut, float* tbl, const float* rel_bias) {
  for (int n = TIDX; n < 2049; n += NTHREADS) {
    int bk = n;
    if (n >= 16) { bk = 16;
#pragma unroll
      for (int k = 0; k < 15; ++k) bk += (n >= BK_THR[k]) ? 1 : 0; }
    blut[n] = (unsigned char)bk;
  }
  for (int i = TIDX; i < 512; i += NTHREADS) { const int hd = i >> 5, bk = i & 31; tbl[i] = rel_bias[bk * 16 + hd] * 1.4426950408889634f; }
  __syncthreads();
}

DI int wave_fetch(unsigned* ctr) {
  int v = 0;
  if ((TIDX & 63) == 0) v = (int)atomicAdd(ctr, 1u);
  return __shfl(v, 0);
}

DI void nsa_cmp_item(const Params& p, int item, const unsigned char* blut, const float* tbl, float* impw) {
  const int lane = TIDX & 63, r = lane & 31, h = lane >> 5;
  const int qb = 127 - (item >> 4), bg = item & 15, b = bg >> 1, g = bg & 1;
  const int t = qb * 32 + r;
  const int ntile = (qb >> 4) + 1;
  const bf16_t* KC = (const bf16_t*)(p.ws + OFF_KC) + (size_t)bg * 256 * 64;
  const bf16_t* VCT = (const bf16_t*)(p.ws + OFF_VCT) + (size_t)bg * 64 * 256;
  const float* gates = (const float*)(p.ws + OFF_GATES) + (size_t)(b * 4096 + t) * 18;
#pragma unroll 4
  for (int j = 0; j < 32; ++j) impw[r * 65 + 2 * j + h] = 0.f;
  for (int rr = 0; rr < 3; ++rr) {
    const int head = g * 3 + rr;
    const float* tblh = tbl + head * 32;
    bf16x8 qf[4];
    load_q(qf, (const bf16_t*)(p.ws + OFF_QN) + (size_t)(b * 4096 + t) * 384 + head * 64 + 8 * h);
    float m = NEGINF, l = 0.f;
    for (int kt = 0; kt < ntile; ++kt) {
      const f32x16 s = qk_tile(qf, KC + (size_t)kt * 2048 + (h * 32 + r) * 8);
      float lg[16]; float mx = NEGINF;
      int dist[16]; float bv[16];
#pragma unroll
      for (int i = 0; i < 16; ++i) dist[i] = t - (16 * (kt * 32 + crow(i, h)) + 31);
      bias16(blut, tblh, dist, bv);
#pragma unroll
      for (int i = 0; i < 16; ++i) { lg[i] = (dist[i] >= 0) ? s[i] + bv[i] : NEGINF; mx = fmaxf(mx, lg[i]); }
      mx = fmaxf(mx, shx32(mx));
      const float mnew = fmaxf(m, mx), muse = (mnew == NEGINF) ? 0.f : mnew;
      float rs = 0.f;
#pragma unroll
      for (int i = 0; i < 16; ++i) rs += ex2(lg[i] - muse);
      l = l * ex2(m - muse) + rs; m = mnew;
    }
    l += shx32(l);
    const float muse = (m == NEGINF) ? 0.f : m;
    const float inv = (l > 0.f) ? 1.f / l : 0.f;
    AttnSt st; attn_init(st);
    float prev3 = 0.f;
#pragma unroll 1
    for (int kt = 0; kt < ntile; ++kt) {
      {
        const f32x16 s = qk_tile(qf, KC + (size_t)kt * 2048 + (h * 32 + r) * 8);
        float pr[16];
        int dist[16]; float bv[16];
#pragma unroll
        for (int i = 0; i < 16; ++i) dist[i] = t - (16 * (kt * 32 + crow(i, h)) + 31);
        bias16(blut, tblh, dist, bv);
#pragma unroll
        for (int i = 0; i < 16; ++i) pr[i] = (dist[i] >= 0) ? ex2(s[i] + bv[i] - muse) * inv : 0.f;
        float recv[4];
#pragma unroll
        for (int q = 0; q < 4; ++q) recv[q] = shx32(pr[4 * q + 3]);
#pragma unroll
        for (int q = 0; q < 4; ++q) {
          const float qs = (pr[4 * q] + pr[4 * q + 1]) + (pr[4 * q + 2] + pr[4 * q + 3]);
          const float cin = h ? recv[q] : (q ? recv[q > 0 ? q - 1 : 0] : prev3);
          impw[r * 65 + 8 * kt + 2 * q + h] += qs + cin;
        }
        prev3 = recv[3];
        pv_tile(st, pr, VCT + (size_t)kt * 2048 + (h * 32 + r) * 4, 256);
      }
    }
    const float g0 = gates[head * 3 + 0];
#pragma unroll
    for (int i = 0; i < 16; ++i) { st.o0[i] *= g0; st.o1[i] *= g0; }
    store_o((bf16_t*)(p.ws + OFF_OC) + (size_t)(b * 4096 + t) * 384 + head * 64, st.o0, st.o1, h);
  }
  const int cur = t >> 6;
  unsigned long long mask;
  if (cur < 16) {
    mask = (2ull << cur) - 1ull;
  } else {
    float own[32], oth[32];
#pragma unroll
    for (int j = 0; j < 32; ++j) {
      const int u = 2 * j + h, uo = 2 * j + 1 - h;
      const float a = impw[r * 65 + u], bb = impw[r * 65 + uo];
      own[j] = ((u >= 1) && (u <= cur - 2)) ? a : -1.f;
      oth[j] = ((uo >= 1) && (uo <= cur - 2)) ? bb : -1.f;
    }
    float prev = __builtin_inff();
#pragma unroll 1
    for (int round = 0; round < 13; ++round) {
      float m = -2.f;
#pragma unroll
      for (int j = 0; j < 32; ++j) { m = fmaxf(m, own[j] < prev ? own[j] : -2.f); m = fmaxf(m, oth[j] < prev ? oth[j] : -2.f); }
      prev = m;
    }
    unsigned mlo = 0u, mhi = 0u;
#pragma unroll
    for (int j = 0; j < 32; ++j) {
      const int u = 2 * j + h;
      const bool forced = (u == 0) || (u == cur) || (u == cur - 1);
      const bool cand = (u >= 1) && (u <= cur - 2);
      const bool sel = forced || (cand && own[j] >= prev);
      if (j < 16) mlo |= sel ? (1u << u) : 0u; else mhi |= sel ? (1u << (u - 32)) : 0u;
    }
    mlo |= (unsigned)shx32i((int)mlo);
    mhi |= (unsigned)shx32i((int)mhi);
    mask = ((unsigned long long)mhi << 32) | mlo;
  }
  if (h == 0) ((unsigned long long*)(p.ws + OFF_SELM))[(size_t)bg * 4096 + t] = mask;
}

DI void nsa_main_item(const Params& p, int b, int head, int qb, const unsigned char* blut, const float* tbl) {
  const int lane = TIDX & 63, r = lane & 31, h = lane >> 5;
  const int g = head / 3, bg = b * 2 + g;
  const int t = qb * 32 + r;
  const float* tblh = tbl + head * 32;
  bf16x8 qf[4];
  load_q(qf, (const bf16_t*)(p.ws + OFF_QN) + (size_t)(b * 4096 + t) * 384 + head * 64 + 8 * h);
  const unsigned long long selm = ((const unsigned long long*)(p.ws + OFF_SELM))[(size_t)bg * 4096 + t];
  const float* gates = (const float*)(p.ws + OFF_GATES) + (size_t)(b * 4096 + t) * 18 + head * 3;
  const float g1 = gates[1], g2 = gates[2];
  f32x16 y0, y1;
  {
    const bf16_t* oc = (const bf16_t*)(p.ws + OFF_OC) + (size_t)(b * 4096 + t) * 384 + head * 64;
#pragma unroll
    for (int i = 0; i < 16; ++i) { y0[i] = bf2f(oc[crow(i, h)]); y1[i] = bf2f(oc[32 + crow(i, h)]); }
  }
  {
    const bf16_t* K = (const bf16_t*)(p.ws + OFF_KSEL) + (size_t)bg * 4096 * 64;
    const bf16_t* Vt = (const bf16_t*)(p.ws + OFF_VSELT) + (size_t)bg * 64 * 4096;
    AttnSt st; attn_init(st);
    attn_loop(st, qf, 0, qb, 32,
      [&](int kt) { return K + (size_t)kt * 2048 + (h * 32 + r) * 8; },
      [&](int kt) { return Vt + (size_t)kt * 2048 + (h * 32 + r) * 4; },
      [&](int kt) { return __ballot((selm >> (kt >> 1)) & 1ull) != 0ull; },
      [&](int kt, const f32x16& s, float (&lg)[16]) {
        const bool bs = (selm >> (kt >> 1)) & 1ull;
        if (qb * 32 - (kt * 32 + 31) >= 1513) {
          const float b31 = tblh[31];
#pragma unroll
          for (int i = 0; i < 16; ++i) lg[i] = bs ? s[i] + b31 : NEGINF;
        } else {
          int dist[16]; float bv[16];
#pragma unroll
          for (int i = 0; i < 16; ++i) dist[i] = t - (kt * 32 + crow(i, h));
          bias16(blut, tblh, dist, bv);
#pragma unroll
          for (int i = 0; i < 16; ++i) lg[i] = (bs && dist[i] >= 0) ? s[i] + bv[i] : NEGINF;
        }
      });
    float l = st.l + shx32(st.l);
    const float sc = (l > 0.f) ? g1 / l : 0.f;
#pragma unroll
    for (int i = 0; i < 16; ++i) { y0[i] += sc * st.o0[i]; y1[i] += sc * st.o1[i]; }
  }
  {
    const bf16_t* K = (const bf16_t*)(p.ws + OFF_KWIN) + (size_t)bg * 4096 * 64;
    const bf16_t* Vt = (const bf16_t*)(p.ws + OFF_VWINT) + (size_t)bg * 64 * 4096;
    AttnSt st; attn_init(st);
    const int k0 = qb >= 16 ? qb - 16 : 0;
    attn_loop(st, qf, k0, qb, 32,
      [&](int kt) { return K + (size_t)kt * 2048 + (h * 32 + r) * 8; },
      [&](int kt) { return Vt + (size_t)kt * 2048 + (h * 32 + r) * 4; },
      [&](int kt) { return true; },
      [&](int kt, const f32x16& s, float (&lg)[16]) {
        int dist[16]; float bv[16];
#pragma unroll
        for (int i = 0; i < 16; ++i) dist[i] = t - (kt * 32 + crow(i, h));
        bias16(blut, tblh, dist, bv);
#pragma unroll
        for (int i = 0; i < 16; ++i) lg[i] = (dist[i] >= 0 && dist[i] < 512) ? s[i] + bv[i] : NEGINF;
      });
    float l = st.l + shx32(st.l);
    const float sc = (l > 0.f) ? g2 / l : 0.f;
#pragma unroll
    for (int i = 0; i < 16; ++i) { y0[i] += sc * st.o0[i]; y1[i] += sc * st.o1[i]; }
  }
  store_o((bf16_t*)(p.ws + OFF_Y) + (size_t)(b * 4096 + t) * 768 + head * 64, y0, y1, h);
}

DI void moba_item(const Params& p, int b, int hd, int qb, const unsigned char* blut, const float* tbl) {
  const int lane = TIDX & 63, r = lane & 31, h = lane >> 5;
  const int bh = b * 4 + hd;
  const int t = qb * 32 + r;
  const int c = qb >> 3;
  const float* tblh = tbl + (6 + hd) * 32;
  bf16x8 qf[4];
  load_q(qf, (const bf16_t*)(p.ws + OFF_QM) + (size_t)(b * 4096 + t) * 256 + hd * 64 + 8 * h);
  unsigned mmask = 0u;
  if (c > 0) {
    const bf16_t* km = (const bf16_t*)(p.ws + OFF_KMEAN) + (size_t)bh * 16 * 64 + (size_t)(r & 15) * 64 + 8 * h;
    f32x16 s;
#pragma unroll
    for (int i = 0; i < 16; ++i) s[i] = 0.f;
#pragma unroll
    for (int ss = 0; ss < 4; ++ss) {
      bf16x8 kf = *(const bf16x8*)(km + 16 * ss);
      if (r >= 16) {
#pragma unroll
        for (int j = 0; j < 8; ++j) kf[j] = 0;
      }
      s = MFMA32(kf, qf[ss], s);
    }
    float g16[16];
#pragma unroll
    for (int i = 0; i < 8; ++i) {
      const float own = s[i], oth = shx32(own);
      const int base = (i & 3) + 8 * (i >> 2);
      g16[base] = h ? oth : own;
      g16[base + 4] = h ? own : oth;
    }
#pragma unroll
    for (int n = 0; n < 16; ++n) g16[n] = (n < c) ? g16[n] : NEGINF;
#pragma unroll
    for (int round = 0; round < 3; ++round) {
      float best = NEGINF; int bi = -1;
#pragma unroll
      for (int n = 0; n < 16; ++n) if (g16[n] > best) { best = g16[n]; bi = n; }
      if (bi >= 0) mmask |= 1u << bi;
#pragma unroll
      for (int n = 0; n < 16; ++n) if (n == bi) g16[n] = NEGINF;
    }
  }
  mmask |= 1u << c;
  const bf16_t* K = (const bf16_t*)(p.ws + OFF_KM) + (size_t)bh * 4096 * 64;
  const bf16_t* Vt = (const bf16_t*)(p.ws + OFF_VMT) + (size_t)bh * 64 * 4096;
  AttnSt st; attn_init(st);
  attn_loop(st, qf, 0, qb, 32,
    [&](int kt) { return K + (size_t)kt * 2048 + (h * 32 + r) * 8; },
    [&](int kt) { return Vt + (size_t)kt * 2048 + (h * 32 + r) * 4; },
    [&](int kt) { return __ballot((mmask >> (kt >> 3)) & 1u) != 0ull; },
    [&](int kt, const f32x16& s, float (&lg)[16]) {
      const bool bs = (mmask >> (kt >> 3)) & 1u;
      if (qb * 32 - (kt * 32 + 31) >= 1513) {
        const float b31 = tblh[31];
#pragma unroll
        for (int i = 0; i < 16; ++i) lg[i] = bs ? s[i] + b31 : NEGINF;
      } else {
        int dist[16]; float bv[16];
#pragma unroll
        for (int i = 0; i < 16; ++i) dist[i] = t - (kt * 32 + crow(i, h));
        bias16(blut, tblh, dist, bv);
#pragma unroll
        for (int i = 0; i < 16; ++i) lg[i] = (bs && dist[i] >= 0) ? s[i] + bv[i] : NEGINF;
      }
    });
  float l = st.l + shx32(st.l);
  const float sc = (l > 0.f) ? 1.f / l : 0.f;
#pragma unroll
  for (int i = 0; i < 16; ++i) { st.o0[i] *= sc; st.o1[i] *= sc; }
  store_o((bf16_t*)(p.ws + OFF_Y) + (size_t)(b * 4096 + t) * 768 + 384 + hd * 64, st.o0, st.o1, h);
}

DI void dil_item(const Params& p, int b, int j, int qi, const unsigned char* blut, const float* tbl) {
  const int lane = TIDX & 63, r = lane & 31, h = lane >> 5;
  const int rho = qi & 15, ub = qi >> 4;
  const int t = rho + 16 * (ub * 32 + r);
  const int tmin = rho + 16 * (ub * 32), tmax = rho + 16 * (ub * 32 + 31);
  AttnSt st; attn_init(st);
#pragma unroll
  for (int g = 0; g < 3; ++g) {
    const int dil = (g == 0) ? 1 : (g == 1 ? 4 : 16), window = 128 * dil, L = 4096 / dil;
    const int hd = 2 * g + j;
    const float* tblh = tbl + (10 + hd) * 32;
    const int rg = rho % dil;
    bf16x8 qf[4];
    load_q(qf, (const bf16_t*)(p.ws + OFF_QD) + (size_t)(b * 4096 + t) * 384 + hd * 64 + 8 * h);
    const bf16_t* K = (const bf16_t*)(p.ws + OFF_KD) + (size_t)(b * 6 + hd) * 4096 * 64;
    const bf16_t* Vt = (const bf16_t*)(p.ws + OFF_VDT) + (size_t)(b * 6 + hd) * 64 * 4096 + (size_t)(rg * L >> 5) * 2048;
    int vlo = tmin / dil - 128; if (vlo < 0) vlo = 0;
    const int vhi = tmax / dil;
    attn_loop(st, qf, vlo >> 5, vhi >> 5, 32,
      [&](int kt) { return K + (size_t)((rg * L >> 5) + kt) * 2048 + (h * 32 + r) * 8; },
      [&](int kt) { return Vt + (size_t)kt * 2048 + (h * 32 + r) * 4; },
      [&](int kt) { return true; },
      [&](int kt, const f32x16& s, float (&lg)[16]) {
        int dist[16]; float bv[16];
#pragma unroll
        for (int i = 0; i < 16; ++i) dist[i] = t - ((kt * 32 + crow(i, h)) * dil + rg);
        bias16(blut, tblh, dist, bv);
#pragma unroll
        for (int i = 0; i < 16; ++i) lg[i] = (dist[i] >= 0 && dist[i] <= window) ? s[i] + bv[i] : NEGINF;
      });
  }
  float l = st.l + shx32(st.l);
  const float sc = (l > 0.f) ? 1.f / l : 0.f;
#pragma unroll
  for (int i = 0; i < 16; ++i) { st.o0[i] *= sc; st.o1[i] *= sc; }
  store_o((bf16_t*)(p.ws + OFF_Y) + (size_t)(b * 4096 + t) * 768 + 640 + j * 64, st.o0, st.o1, h);
}

DI void phaseX(const Params& p, int layer, char* lds, int rep = 0) {
  unsigned char* blut = (unsigned char*)lds; float* tbl = (float*)(lds + 4096);
  build_lut(blut, tbl, p.in[I_RELB]);
  unsigned* ctr = (unsigned*)(p.ws + OFF_MISC) + layer * 2 + rep * 8;
  for (;;) {
    const int item = wave_fetch(ctr);
    if (item >= 2048 + 128 * 48) break;
    if (item < 2048) nsa_cmp_item(p, item, blut, tbl, (float*)(lds + 8192) + (TIDX >> 6) * (32 * 65));
    else {
      const int it2 = item - 2048, qb = 127 - it2 / 48, sub = it2 % 48;
      if (sub < 32) moba_item(p, sub >> 2, sub & 3, qb, blut, tbl);
      else dil_item(p, (sub - 32) >> 1, (sub - 32) & 1, qb, blut, tbl);
    }
  }
  __syncthreads();
}
DI void phaseY(const Params& p, int layer, char* lds, int rep = 0) {
  unsigned char* blut = (unsigned char*)lds; float* tbl = (float*)(lds + 4096);
  build_lut(blut, tbl, p.in[I_RELB]);
  unsigned* ctr = (unsigned*)(p.ws + OFF_MISC) + layer * 2 + 1 + rep * 8;
  for (;;) {
    const int item = wave_fetch(ctr);
    if (item >= 128 * 48) break;
    const int qb = 127 - item / 48, sub = item % 48;
    nsa_main_item(p, sub / 6, sub % 6, qb, blut, tbl);
  }
  __syncthreads();
}

DI void kmean_phase(const Params& p) {
  const int lane = TIDX & 63;
  const int gw = blockIdx.x * 8 + (TIDX >> 6), nw = gridDim.x * 8;
  const bf16_t* KM = (const bf16_t*)(p.ws + OFF_KM);
  bf16_t* o = (bf16_t*)(p.ws + OFF_KMEAN);
  for (int it = gw; it < 512; it += nw) {
    const bf16_t* src = KM + (size_t)it * 256 * 64;
    float s = 0.f;
    for (int k = 0; k < 256; ++k) s += bf2f(KM[(size_t)(it >> 4) * 262144 + kfrag_idx((it & 15) * 256 + k, lane)]);
    o[it * 64 + lane] = f2bf(s * (1.f / 256.f));
  }
}

DI void merge_phase(const Params& p, int layer, char* lds) {
  const bf16_t* wl = (const bf16_t*)(p.ws + OFF_W) + (size_t)layer * W_LAYER;
  const bf16_t* hn = (const bf16_t*)(p.ws + OFF_HN);
  const bf16_t* y = (const bf16_t*)(p.ws + OFF_Y);
  bf16_t* mg = (bf16_t*)(p.ws + OFF_MERGED);
  const int lmax = tile_lmax(128, 8, 4);
  for (int L = blockIdx.x; L < lmax; L += gridDim.x) {
    int mt, nt;
    if (!tile_map(L, 128, 8, 4, mt, nt)) continue;
    f32x16 macc[2][2];
    zero_acc(macc);
#pragma unroll 1
    for (int br = 0; br < 3; ++br) {
      const int kw = (br == 0) ? 384 : (br == 1 ? 256 : 128);
      const int yo = (br == 0) ? 0 : (br == 1 ? 384 : 640);
      const bf16_t* wu = wl + ((br == 0) ? OW_UA : (br == 1 ? OW_UB : OW_UC));
      unsigned sg[2][2][8];
      {
        f32x16 ag[2][2];
        zero_acc(ag);
        gemm_core(hn + (size_t)mt * 256 * 1024, 1024, wl + OW_ING + (size_t)(br * 1024 + nt * 128) * 1024, 1024, 1024, ag, lds);
#pragma unroll
        for (int a = 0; a < 2; ++a)
#pragma unroll
          for (int c = 0; c < 2; ++c)
#pragma unroll
            for (int i = 0; i < 8; ++i) sg[a][c][i] = pack2(sigmoidf_(ag[a][c][2 * i]), sigmoidf_(ag[a][c][2 * i + 1]));
      }
      f32x16 au[2][2];
      zero_acc(au);
      gemm_core(y + (size_t)mt * 256 * 768 + yo, 768, wu + (size_t)nt * 128 * kw, kw, kw, au, lds);
#pragma unroll
      for (int a = 0; a < 2; ++a)
#pragma unroll
        for (int c = 0; c < 2; ++c)
#pragma unroll
          for (int i = 0; i < 8; ++i) {
            macc[a][c][2 * i] += __uint_as_float(sg[a][c][i] << 16) * au[a][c][2 * i];
            macc[a][c][2 * i + 1] += __uint_as_float(sg[a][c][i] & 0xffff0000u) * au[a][c][2 * i + 1];
          }
    }
    const int tid = TIDX, lane = tid & 63, wid = tid >> 6, wr = wid >> 1, wc = wid & 1, r = lane & 31, h = lane >> 5;
#pragma unroll
    for (int a = 0; a < 2; ++a)
#pragma unroll
      for (int c = 0; c < 2; ++c)
#pragma unroll
        for (int i = 0; i < 16; ++i)
          mg[(size_t)(mt * 256 + wr * 64 + a * 32 + crow(i, h)) * 1024 + nt * 128 + wc * 64 + c * 32 + r] = f2bf(macc[a][c][i]);
  }
}

constexpr int NPHASE = 1 + 2 * 14 + 1;

DI void run_phase(const Params& p, int ph, char* lds, int rep = 0) {
#ifdef TESTQ
  if (ph == 0) { if (TESTQ == 100) phase0(p, lds); return; }
  if ((ph - 1) % 14 != TESTQ) return;
#endif
  if (ph == 0) { phase0(p, lds); return; }
  if (ph == NPHASE - 1) { final_norm_phase(p.out, p.in[I_FINN]); return; }
  const int layer = (ph - 1) / 14, q = (ph - 1) % 14;
  const bf16_t* wl = (const bf16_t*)(p.ws + OFF_W) + (size_t)layer * W_LAYER;
  bf16_t* hn = (bf16_t*)(p.ws + OFF_HN);
  switch (q) {
    case 0: { EpiSwiglu e{(bf16_t*)(p.ws + OFF_FFH)}; gemm_phase(hn, 1024, wl + OW_GU1, 1024, 1024, 128, 44, 4, e, lds); } break;
    case 1: { EpiResid e{layer == 0 ? p.in[I_X] : p.out, p.out, 0.5f}; gemm_phase((const bf16_t*)(p.ws + OFF_FFH), DFF, wl + OW_DN1, DFF, DFF, 128, 8, 4, e, lds, true); } break;
    case 2: rms_phase(p.out, p.in[I_MIXN] + layer * 1024, hn); break;
    case 3: { EpiWin e{p.ws}; gemm_phase(hn, 1024, wl + OW_INM, 1024, 1024, 128, 25, 5, e, lds); } break;
    case 4: {
      { EpiGelu e{(bf16_t*)(p.ws + OFF_H1K), (const float*)(p.ws + OFF_MISC + 256) + (layer * 2 + 0) * 256}; gemm_phase((const bf16_t*)(p.ws + OFF_KCMP), 1024, wl + OW_PK1, 2048, 2048, 16, 2, 2, e, lds); }
      { EpiGelu e{(bf16_t*)(p.ws + OFF_H1V), (const float*)(p.ws + OFF_MISC + 256) + (layer * 2 + 1) * 256}; gemm_phase((const bf16_t*)(p.ws + OFF_VCMP), 1024, wl + OW_PV1, 2048, 2048, 16, 2, 2, e, lds); }
      kmean_phase(p);
    } break;
    case 5: {
      { EpiCmpOut<0> e{(bf16_t*)(p.ws + OFF_KC)}; gemm_phase((const bf16_t*)(p.ws + OFF_H1K), 256, wl + OW_PK2, 256, 256, 16, 1, 1, e, lds); }
      { EpiCmpOut<1> e{(bf16_t*)(p.ws + OFF_VCT)}; gemm_phase((const bf16_t*)(p.ws + OFF_H1V), 256, wl + OW_PV2, 256, 256, 16, 1, 1, e, lds); }
    } break;
    case 6: phaseX(p, layer, lds, rep); break;
    case 7: phaseY(p, layer, lds, rep); break;
    case 8: merge_phase(p, layer, lds); break;
    case 9: { EpiResid e{p.out, p.out, 1.0f}; gemm_phase((const bf16_t*)(p.ws + OFF_MERGED), 1024, wl + OW_WO, 1024, 1024, 128, 8, 4, e, lds); } break;
    case 10: rms_phase(p.out, p.in[I_F2N] + layer * 1024, hn); break;
    case 11: { EpiSwiglu e{(bf16_t*)(p.ws + OFF_FFH)}; gemm_phase(hn, 1024, wl + OW_GU2, 1024, 1024, 128, 44, 4, e, lds); } break;
    case 12: { EpiResid e{p.out, p.out, 0.5f}; gemm_phase((const bf16_t*)(p.ws + OFF_FFH), DFF, wl + OW_DN2, DFF, DFF, 128, 8, 4, e, lds, true); } break;
    default: if (layer == 0) rms_phase(p.out, p.in[I_F1N] + 1024, hn); break;
  }
}


DI void grid_barrier(unsigned* ctr, unsigned target) {
  __syncthreads();
  if (threadIdx.x == 0) {
    __threadfence();
    __hip_atomic_fetch_add(ctr, 1u, __ATOMIC_RELAXED, __HIP_MEMORY_SCOPE_AGENT);
    unsigned spins = 0;
    while (__hip_atomic_load(ctr, __ATOMIC_RELAXED, __HIP_MEMORY_SCOPE_AGENT) < target && spins < (1u << 26)) { __builtin_amdgcn_s_sleep(2); ++spins; }
    __threadfence();
  }
  __syncthreads();
}
#if MEGA
__global__ void __launch_bounds__(NTHREADS) mega_kernel(Params p) {
  extern __shared__ __attribute__((aligned(16))) char lds[];
  cg::grid_group grid = cg::this_grid();
  unsigned bar_gen = 0;
  for (int ph = 0; ph < NPHASE; ++ph) {
#ifdef REPQ
    const int nrep = (REPQ >= 100) ? ((ph == REPQ - 100) ? 2 : 1) : ((ph > 0 && ph < NPHASE - 1 && (ph - 1) % 14 == REPQ) ? 2 : 1);
#else
    const int nrep = 1;
#endif
    if (ph == NPHASE - 2) continue;
    for (int rep = 0; rep < nrep; ++rep) {
      run_phase(p, ph, lds, rep);
      if (ph + 1 < NPHASE) {
        if (ph == 0) grid.sync();
        else { ++bar_gen; grid_barrier((unsigned*)(p.ws + OFF_MISC + 6144), bar_gen * gridDim.x); }
      }
    }
  }
}
#else
__global__ void __launch_bounds__(NTHREADS) phase_kernel(Params p, int ph) {
  extern __shared__ __attribute__((aligned(16))) char lds[];
  run_phase(p, ph, lds);
}
#endif

extern "C" void kernel_launch(void* const* d_in, const int* in_sizes, int n_in, void* d_out, int out_size, void* d_ws, size_t ws_size, hipStream_t stream) {
  Params p;
  memset(&p, 0, sizeof(p));
  for (int i = 0; i < 23; ++i) p.in[i] = (const float*)d_in[i];
  p.out = (float*)d_out;
  p.ws = (char*)d_ws;
  if (ws_size < OFF_END) fprintf(stderr, "workspace too small: %zu < %zu\n", ws_size, (size_t)OFF_END);
  static int grid_blocks = 0;
  if (!grid_blocks) {
    int dev = 0, cus = 0, per_cu = 0;
    (void)hipGetDevice(&dev);
    (void)hipDeviceGetAttribute(&cus, hipDeviceAttributeMultiprocessorCount, dev);
#if MEGA
    if (hipFuncSetAttribute((const void*)mega_kernel, hipFuncAttributeMaxDynamicSharedMemorySize, LDS_BYTES) != hipSuccess) fprintf(stderr, "hipFuncSetAttribute failed\n");
    (void)hipOccupancyMaxActiveBlocksPerMultiprocessor(&per_cu, mega_kernel, NTHREADS, LDS_BYTES);
#else
    per_cu = 1;
#endif
    if (per_cu < 1) per_cu = 1;
    if (per_cu > 2) per_cu = 2;
    grid_blocks = cus * per_cu;
  }
#if MEGA
  void* args[] = {&p};
  hipError_t e = hipLaunchCooperativeKernel((void*)mega_kernel, dim3(grid_blocks), dim3(NTHREADS), args, LDS_BYTES, stream);
  if (e != hipSuccess) fprintf(stderr, "cooperative launch failed: %s (grid %d)\n", hipGetErrorString(e), grid_blocks);
#else
  for (int ph = 0; ph < NPHASE; ++ph) phase_kernel<<<grid_blocks, NTHREADS, LDS_BYTES, stream>>>(p, ph);
#endif
}
```

```cpp
#include <hip/hip_runtime.h>
#include <hip/hip_cooperative_groups.h>
#include <stdint.h>
#include <stdio.h>
#include <string.h>
namespace cg = cooperative_groups;

#ifndef MEGA
#define MEGA 1
#endif

typedef unsigned short bf16_t;
typedef short bf16x8 __attribute__((ext_vector_type(8)));
typedef short s16x4 __attribute__((ext_vector_type(4)));
typedef float f32x16 __attribute__((ext_vector_type(16)));
typedef float f32x4 __attribute__((ext_vector_type(4)));
typedef unsigned u32x4 __attribute__((ext_vector_type(4)));
typedef unsigned u32x2 __attribute__((ext_vector_type(2)));

#define DI __device__ __forceinline__
#define MFMA32(a, b, c) __builtin_amdgcn_mfma_f32_32x32x16_bf16((a), (b), (c), 0, 0, 0)
#define NEGINF (-__builtin_inff())

constexpr int NB = 8, SEQ = 4096, DM = 1024, NT = NB * SEQ, DFF = 2816;
constexpr int NTHREADS = 512;

constexpr size_t W_GU = 5632ull * 1024, W_DN = 1024ull * 2816, W_INM = 3200ull * 1024, W_ING = 3072ull * 1024,
                 W_P1 = 256ull * 2048, W_P2 = 128ull * 256, W_UA = 1024ull * 384, W_UB = 1024ull * 256, W_UC = 1024ull * 128, W_WO = 1024ull * 1024;
constexpr size_t OW_GU1 = 0, OW_DN1 = OW_GU1 + W_GU, OW_GU2 = OW_DN1 + W_DN, OW_DN2 = OW_GU2 + W_GU, OW_INM = OW_DN2 + W_DN,
                 OW_ING = OW_INM + W_INM, OW_PK1 = OW_ING + W_ING, OW_PV1 = OW_PK1 + W_P1, OW_PK2 = OW_PV1 + W_P1, OW_PV2 = OW_PK2 + W_P2,
                 OW_UA = OW_PV2 + W_P2, OW_UB = OW_UA + W_UA, OW_UC = OW_UB + W_UB, OW_WO = OW_UC + W_UC, W_LAYER = OW_WO + W_WO;
constexpr size_t OFF_W = 0;
constexpr size_t OFF_MISC = OFF_W + 2 * W_LAYER * 2;
constexpr size_t OFF_HN = OFF_MISC + 8192;
constexpr size_t OFF_C = OFF_HN + (size_t)NT * DM * 2;
constexpr size_t OFF_FFH = OFF_C;
constexpr size_t OFF_QN = OFF_C;
constexpr size_t OFF_QM = OFF_QN + (size_t)NT * 384 * 2;
constexpr size_t OFF_QD = OFF_QM + (size_t)NT * 256 * 2;
constexpr size_t OFF_MERGED = OFF_C;
constexpr size_t SZ_G2 = 16ull * 4096 * 64 * 2;
constexpr size_t OFF_KCMP = OFF_QD + (size_t)NT * 384 * 2;
constexpr size_t OFF_VCMP = OFF_KCMP + SZ_G2 + 4096;
constexpr size_t OFF_KSEL = OFF_VCMP + SZ_G2 + 4096;
constexpr size_t OFF_VSELT = OFF_KSEL + SZ_G2;
constexpr size_t OFF_KWIN = OFF_VSELT + SZ_G2;
constexpr size_t OFF_VWINT = OFF_KWIN + SZ_G2;
constexpr size_t OFF_KM = OFF_VWINT + SZ_G2;
constexpr size_t OFF_VMT = OFF_KM + 2 * SZ_G2;
constexpr size_t OFF_KD = OFF_VMT + 2 * SZ_G2;
constexpr size_t OFF_VDT = OFF_KD + 3 * SZ_G2;
constexpr size_t OFF_GATES = OFF_VDT + 3 * SZ_G2;
constexpr size_t OFF_H1K = OFF_GATES + (size_t)NT * 18 * 4;
constexpr size_t OFF_H1V = OFF_H1K + 4096ull * 256 * 2;
constexpr size_t OFF_KC = OFF_H1V + 4096ull * 256 * 2;
constexpr size_t OFF_VCT = OFF_KC + 16ull * 256 * 64 * 2;
constexpr size_t OFF_KMEAN = OFF_VCT + 16ull * 256 * 64 * 2;
constexpr size_t OFF_SELM = OFF_KMEAN + 32ull * 16 * 64 * 2;
constexpr size_t OFF_OC = OFF_SELM + 16ull * 4096 * 8;
constexpr size_t OFF_Y = OFF_OC + (size_t)NT * 384 * 2;
constexpr size_t OFF_END = OFF_Y + (size_t)NT * 768 * 2;
static_assert(OFF_FFH + (size_t)NT * DFF * 2 <= OFF_END, "ffh fits");

struct Params {
  const float* in[23];
  float* out;
  char* ws;
};

enum { I_X = 0, I_RELB, I_F1N, I_F1G, I_F1U, I_F1D, I_MIXN, I_WIN, I_PEK, I_PEV, I_PK1, I_PK2, I_PV1, I_PV2, I_UA, I_UB, I_UC, I_WO, I_F2N, I_F2G, I_F2U, I_F2D, I_FINN };

DI int get_tid_() { int t = threadIdx.x; asm volatile("" : "+v"(t)); return t; }
#define TIDX get_tid_()
DI float shx32(float v) { const auto r = __builtin_amdgcn_permlane32_swap(__float_as_uint(v), __float_as_uint(v), false, false); return __uint_as_float((threadIdx.x & 32) ? r[0] : r[1]); }
DI int shx32i(int v) { const auto r = __builtin_amdgcn_permlane32_swap((unsigned)v, (unsigned)v, false, false); return (int)((threadIdx.x & 32) ? r[0] : r[1]); }
DI float ex2(float x) { return __builtin_amdgcn_exp2f(x); }
DI size_t kfrag_idx(int pos, int d) { return ((size_t)((pos >> 5) * 4 + (d >> 4)) * 64 + ((d >> 3) & 1) * 32 + (pos & 31)) * 8 + (d & 7); }
DI size_t vfrag_idx(int pos, int d) { return ((size_t)((pos >> 5) * 8 + ((pos >> 4) & 1) * 4 + (d >> 5) * 2 + ((pos >> 3) & 1)) * 64 + ((pos >> 2) & 1) * 32 + (d & 31)) * 4 + (pos & 3); }
DI bf16_t f2bf(float x) { unsigned r; asm("v_cvt_pk_bf16_f32 %0, %1, %1" : "=v"(r) : "v"(x)); return (bf16_t)(r & 0xffffu); }
DI float bf2f(bf16_t b) { return __uint_as_float(((unsigned)b) << 16); }
DI unsigned pack2(float a, float b) { unsigned r; asm("v_cvt_pk_bf16_f32 %0, %1, %2" : "=v"(r) : "v"(a), "v"(b)); return r; }
DI int crow(int i, int h) { return (i & 3) + 8 * (i >> 2) + 4 * h; }
DI float sigmoidf_(float x) { return 1.f / (1.f + __expf(-x)); }

DI int lds_off(int row, int chunk) { return row * 128 + ((chunk ^ ((row >> 1) & 7)) << 4); }

#define LAS __attribute__((address_space(3)))
constexpr int NSTAGE = 3;
constexpr int STAGE_B = 49152;
constexpr int LDS_BYTES = NSTAGE * STAGE_B;
DI void glds16(const void* g, char* l) { __builtin_amdgcn_global_load_lds((const unsigned*)g, (LAS unsigned*)l, 16, 0, 0); }

template <int PART = 0>
DI void gemm_core(const bf16_t* __restrict__ A, int lda, const bf16_t* __restrict__ Bt, int ldb, int K,
                  f32x16 (&acc)[2][2], char* lds) {
  const int tid = TIDX, lane = tid & 63, wid = tid >> 6, wr = wid >> 1, wc = wid & 1, r = lane & 31, h = lane >> 5;
  const int ch = (tid & 7) ^ ((tid >> 4) & 7);
  unsigned avo[4], bvo[2];
#pragma unroll
  for (int i = 0; i < 4; ++i) avo[i] = (unsigned)(((tid >> 3) + 64 * i) * lda * 2 + ch * 16);
#pragma unroll
  for (int i = 0; i < 2; ++i) bvo[i] = (unsigned)(((tid >> 3) + 64 * i) * ldb * 2 + ch * 16);
  const char* Ab = (const char*)A; const char* Bb = (const char*)Bt;
  char* lw = lds + tid * 16;
  const int nk = K >> 6;
  const unsigned swz = (unsigned)((r >> 1) & 7);
  const unsigned arow_u = (unsigned)((wr * 64 + r) * 128), brow_u = (unsigned)((wc * 64 + r) * 128);
  const unsigned co0 = ((0u + h) ^ swz) << 4, co1 = ((2u + h) ^ swz) << 4, co2 = ((4u + h) ^ swz) << 4, co3 = ((6u + h) ^ swz) << 4;
#define GEMM_ISSUE(kt_, st_) do { char* sb_ = lw + (st_) * STAGE_B; const char* ak_ = Ab + (size_t)(kt_) * 128; const char* bk_ = Bb + (size_t)(kt_) * 128; \
    _Pragma("unroll") for (int i_ = 0; i_ < 4; ++i_) glds16(ak_ + avo[i_], sb_ + i_ * 8192); \
    _Pragma("unroll") for (int i_ = 0; i_ < 2; ++i_) glds16(bk_ + bvo[i_], sb_ + 32768 + i_ * 8192); } while (0)
  if (PART != 2) {
    GEMM_ISSUE(0, 0);
    if (nk > 1) GEMM_ISSUE(1, 1);
  }
  if (PART == 1) return;
  int st = 0;
  for (int kt = 0; kt < nk; ++kt) {
    if (kt + 1 < nk) asm volatile("s_waitcnt vmcnt(6)" ::: "memory");
    else asm volatile("s_waitcnt vmcnt(0)" ::: "memory");
    __builtin_amdgcn_s_barrier();
    asm volatile("" ::: "memory");
    if (kt + 2 < nk) { const int st2 = (st >= 1) ? st - 1 : 2; GEMM_ISSUE(kt + 2, st2); }
    const char* la = lds + st * STAGE_B;
    const char* lb = la + 32768;
    const unsigned sa_u = (unsigned)(size_t)la + arow_u, sb_u = (unsigned)(size_t)lb + brow_u;
    const unsigned a0 = sa_u + co0, a1 = sa_u + co1, a2 = sa_u + co2, a3 = sa_u + co3;
    const unsigned b0 = sb_u + co0, b1 = sb_u + co1, b2 = sb_u + co2, b3 = sb_u + co3;
    {
      bf16x8 p0, p1, q0, q1, u0, u1, w0, w1;
      asm volatile(
        "ds_read_b128 %4, %12\n\tds_read_b128 %5, %12 offset:4096\n\tds_read_b128 %6, %16\n\tds_read_b128 %7, %16 offset:4096\n\t"
        "ds_read_b128 %8, %13\n\tds_read_b128 %9, %13 offset:4096\n\tds_read_b128 %10, %17\n\tds_read_b128 %11, %17 offset:4096\n\t"
        "s_waitcnt lgkmcnt(4)\n\t"
        "v_mfma_f32_32x32x16_bf16 %0, %4, %6, %0\n\tv_mfma_f32_32x32x16_bf16 %1, %4, %7, %1\n\tv_mfma_f32_32x32x16_bf16 %2, %5, %6, %2\n\tv_mfma_f32_32x32x16_bf16 %3, %5, %7, %3\n\t"
        "ds_read_b128 %4, %14\n\tds_read_b128 %5, %14 offset:4096\n\tds_read_b128 %6, %18\n\tds_read_b128 %7, %18 offset:4096\n\t"
        "s_waitcnt lgkmcnt(4)\n\t"
        "v_mfma_f32_32x32x16_bf16 %0, %8, %10, %0\n\tv_mfma_f32_32x32x16_bf16 %1, %8, %11, %1\n\tv_mfma_f32_32x32x16_bf16 %2, %9, %10, %2\n\tv_mfma_f32_32x32x16_bf16 %3, %9, %11, %3\n\t"
        "ds_read_b128 %8, %15\n\tds_read_b128 %9, %15 offset:4096\n\tds_read_b128 %10, %19\n\tds_read_b128 %11, %19 offset:4096\n\t"
        "s_waitcnt lgkmcnt(4)\n\t"
        "v_mfma_f32_32x32x16_bf16 %0, %4, %6, %0\n\tv_mfma_f32_32x32x16_bf16 %1, %4, %7, %1\n\tv_mfma_f32_32x32x16_bf16 %2, %5, %6, %2\n\tv_mfma_f32_32x32x16_bf16 %3, %5, %7, %3\n\t"
        "s_waitcnt lgkmcnt(0)\n\t"
        "v_mfma_f32_32x32x16_bf16 %0, %8, %10, %0\n\tv_mfma_f32_32x32x16_bf16 %1, %8, %11, %1\n\tv_mfma_f32_32x32x16_bf16 %2, %9, %10, %2\n\tv_mfma_f32_32x32x16_bf16 %3, %9, %11, %3"
        : "+v"(acc[0][0]), "+v"(acc[0][1]), "+v"(acc[1][0]), "+v"(acc[1][1]),
          "=&v"(p0), "=&v"(p1), "=&v"(q0), "=&v"(q1), "=&v"(u0), "=&v"(u1), "=&v"(w0), "=&v"(w1)
        : "v"(a0), "v"(a1), "v"(a2), "v"(a3), "v"(b0), "v"(b1), "v"(b2), "v"(b3));
    }
    st = (st == 2) ? 0 : st + 1;
  }
  asm volatile("s_nop 15\n\ts_nop 15\n\ts_nop 7" ::: "memory");
  __builtin_amdgcn_s_barrier();
  asm volatile("" ::: "memory");
}

DI void zero_acc(f32x16 (&acc)[2][2]) {
#pragma unroll
  for (int a = 0; a < 2; ++a)
#pragma unroll
    for (int b = 0; b < 2; ++b)
#pragma unroll
      for (int i = 0; i < 16; ++i) acc[a][b][i] = 0.f;
}

DI bool tile_map(int L, int MT, int NTl, int SN, int& mt, int& nt) {
  const int xcd = L & 7, ix = L >> 3, per = 8 * SN, st = ix / per, w = ix % per;
  const int gst = st * 8 + xcd, SNT = NTl / SN, total = (MT >> 3) * SNT;
  if (gst >= total) return false;
  const int smt = gst / SNT, snt = gst % SNT;
  mt = smt * 8 + (w & 7); nt = snt * SN + (w >> 3);
  return true;
}
DI int tile_lmax(int MT, int NTl, int SN) { const int total = (MT >> 3) * (NTl / SN); return ((total + 7) >> 3) * 8 * SN * 8; }

struct EpiSwiglu {
  static constexpr bool PRE = false;
  bf16_t* ffh;
  DI void operator()(const f32x16 (&acc)[2][2], int m0, int n0) const {
    const int tid = TIDX, lane = tid & 63, wid = tid >> 6, wr = wid >> 1, wc = wid & 1, r = lane & 31, h = lane >> 5;
    const int hid = (n0 >> 7) * 64 + wc * 32 + r;
#pragma unroll
    for (int mi = 0; mi < 2; ++mi)
#pragma unroll
      for (int i = 0; i < 16; ++i) {
        const int row = m0 + wr * 64 + mi * 32 + crow(i, h);
        const float g = acc[mi][0][i], u = acc[mi][1][i];
        ffh[(size_t)row * DFF + hid] = f2bf(g * sigmoidf_(g) * u);
      }
  }
};
struct EpiResid {
  const float* res; float* out; float scale;
  static constexpr bool PRE = true;
  DI void pre(float (&rv)[2][2][16], int m0, int n0) const {
    const int tid = TIDX, lane = tid & 63, wid = tid >> 6, wr = wid >> 1, wc = wid & 1, r = lane & 31, h = lane >> 5;
#pragma unroll
    for (int mi = 0; mi < 2; ++mi)
#pragma unroll
      for (int ni = 0; ni < 2; ++ni)
#pragma unroll
        for (int i = 0; i < 16; ++i)
          rv[mi][ni][i] = res[(size_t)(m0 + wr * 64 + mi * 32 + crow(i, h)) * DM + n0 + wc * 64 + ni * 32 + r];
  }
  DI void operator()(const f32x16 (&acc)[2][2], int m0, int n0, const float (&rv)[2][2][16]) const {
    const int tid = TIDX, lane = tid & 63, wid = tid >> 6, wr = wid >> 1, wc = wid & 1, r = lane & 31, h = lane >> 5;
#pragma unroll
    for (int mi = 0; mi < 2; ++mi)
#pragma unroll
      for (int ni = 0; ni < 2; ++ni)
#pragma unroll
        for (int i = 0; i < 16; ++i)
          out[(size_t)(m0 + wr * 64 + mi * 32 + crow(i, h)) * DM + n0 + wc * 64 + ni * 32 + r] = rv[mi][ni][i] + scale * acc[mi][ni][i];
  }
};
struct EpiGelu {
  static constexpr bool PRE = false;
  bf16_t* o; const float* bias;
  DI void operator()(const f32x16 (&acc)[2][2], int m0, int n0) const {
    const int tid = TIDX, lane = tid & 63, wid = tid >> 6, wr = wid >> 1, wc = wid & 1, r = lane & 31, h = lane >> 5;
#pragma unroll
    for (int mi = 0; mi < 2; ++mi)
#pragma unroll
      for (int ni = 0; ni < 2; ++ni) {
        const int col = n0 + wc * 64 + ni * 32 + r;
        const float bv = bias[col];
#pragma unroll
        for (int i = 0; i < 16; ++i) {
          const int row = m0 + wr * 64 + mi * 32 + crow(i, h);
          const float x = acc[mi][ni][i] + bv;
          o[(size_t)row * 256 + col] = f2bf(x * sigmoidf_(1.5957691216057308f * (x + 0.044715f * x * x * x)));
        }
      }
  }
};
template <int transposed> struct EpiCmpOut {
  static constexpr bool PRE = false;
  bf16_t* o;
  DI void operator()(const f32x16 (&acc)[2][2], int m0, int n0) const {
    const int tid = TIDX, lane = tid & 63, wid = tid >> 6, wr = wid >> 1, wc = wid & 1, r = lane & 31, h = lane >> 5;
    if (wc != 0) return;
#pragma unroll
    for (int mi = 0; mi < 2; ++mi)
#pragma unroll
      for (int ni = 0; ni < 2; ++ni) {
        const int col = ni * 32 + r;
#pragma unroll
        for (int i = 0; i < 16; ++i) {
          const int row = m0 + wr * 64 + mi * 32 + crow(i, h);
          const bf16_t v = f2bf(acc[mi][ni][i]);
          if (transposed) o[(size_t)(row >> 8) * 16384 + vfrag_idx(row & 255, col)] = v;
          else o[(size_t)(row >> 8) * 16384 + kfrag_idx(row & 255, col)] = v;
        }
      }
  }
};
struct EpiWin {
  static constexpr bool PRE = false;
  char* ws;
  DI void operator()(const f32x16 (&acc)[2][2], int m0, int n0) const {
    const int tid = TIDX, lane = tid & 63, wid = tid >> 6, wr = wid >> 1, wc = wid & 1, r = lane & 31, h = lane >> 5;
    const int cidx = (n0 >> 6) + wc;
    if (cidx >= 49) return;
    const int rowbase = m0 + wr * 64;
    const int b = rowbase >> 12;
    int kind;
    bf16_t* base; int ld = 0, colb = 0, hb = 0, dil = 1; bool kfrag = false;
    if (cidx < 6) { kind = 0; base = (bf16_t*)(ws + OFF_QN); ld = 384; colb = cidx * 64; }
    else if (cidx < 18) { const int t = (cidx - 6) >> 1, g = (cidx - 6) & 1; hb = b * 2 + g;
      const size_t off = (t == 0) ? OFF_KCMP : (t == 1) ? OFF_VCMP : (t == 2) ? OFF_KSEL : (t == 3) ? OFF_VSELT : (t == 4) ? OFF_KWIN : OFF_VWINT;
      base = (bf16_t*)(ws + off); kind = (t == 3 || t == 5) ? 2 : 1; kfrag = (t == 2 || t == 4); }
    else if (cidx < 22) { kind = 0; base = (bf16_t*)(ws + OFF_QM); ld = 256; colb = (cidx - 18) * 64; }
    else if (cidx < 26) { kind = 1; kfrag = true; base = (bf16_t*)(ws + OFF_KM); hb = b * 4 + (cidx - 22); }
    else if (cidx < 30) { kind = 2; base = (bf16_t*)(ws + OFF_VMT); hb = b * 4 + (cidx - 26); }
    else if (cidx < 36) { kind = 0; base = (bf16_t*)(ws + OFF_QD); ld = 384; colb = (cidx - 30) * 64; }
    else if (cidx < 42) { kind = 1; kfrag = true; base = (bf16_t*)(ws + OFF_KD); hb = b * 6 + (cidx - 36); const int g = (cidx - 36) >> 1; dil = (g == 0) ? 1 : (g == 1 ? 4 : 16); }
    else if (cidx < 48) { kind = 2; base = (bf16_t*)(ws + OFF_VDT); hb = b * 6 + (cidx - 42); const int g = (cidx - 42) >> 1; dil = (g == 0) ? 1 : (g == 1 ? 4 : 16); }
    else { kind = 3; base = nullptr; }
    if (kind == 0) {
#pragma unroll
      for (int mi = 0; mi < 2; ++mi)
#pragma unroll
        for (int ni = 0; ni < 2; ++ni)
#pragma unroll
          for (int i = 0; i < 16; ++i) {
            const int row = rowbase + mi * 32 + crow(i, h);
            base[(size_t)row * ld + colb + ni * 32 + r] = f2bf(acc[mi][ni][i] * 0.18033688011112042f);
          }
    } else if (kind == 1) {
#pragma unroll
      for (int mi = 0; mi < 2; ++mi)
#pragma unroll
        for (int ni = 0; ni < 2; ++ni)
#pragma unroll
          for (int i = 0; i < 16; ++i) {
            const int s = (rowbase & 4095) + mi * 32 + crow(i, h);
            if (kfrag) { const int pos = (dil == 1) ? s : (s % dil) * (4096 / dil) + s / dil; base[(size_t)hb * 262144 + kfrag_idx(pos, ni * 32 + r)] = f2bf(acc[mi][ni][i]); }
            else base[((size_t)hb * 4096 + s) * 64 + ni * 32 + r] = f2bf(acc[mi][ni][i]);
          }
    } else if (kind == 2) {
      if (dil == 1) {
#pragma unroll
        for (int mi = 0; mi < 2; ++mi)
#pragma unroll
          for (int ni = 0; ni < 2; ++ni)
#pragma unroll
            for (int q = 0; q < 4; ++q) {
              const int s = (rowbase & 4095) + mi * 32 + 8 * q + 4 * h;
              u32x2 v; v.x = pack2(acc[mi][ni][4 * q], acc[mi][ni][4 * q + 1]); v.y = pack2(acc[mi][ni][4 * q + 2], acc[mi][ni][4 * q + 3]);
              *(u32x2*)(base + (size_t)hb * 262144 + vfrag_idx(s, ni * 32 + r)) = v;
            }
      } else {
        const int L = 4096 / dil;
#pragma unroll
        for (int mi = 0; mi < 2; ++mi)
#pragma unroll
          for (int ni = 0; ni < 2; ++ni)
#pragma unroll
            for (int i = 0; i < 16; ++i) {
              const int s = (rowbase & 4095) + mi * 32 + crow(i, h);
              const int pos = (s % dil) * L + s / dil;
              base[(size_t)hb * 262144 + vfrag_idx(pos, ni * 32 + r)] = f2bf(acc[mi][ni][i]);
            }
      }
    } else {
      float* gt = (float*)(ws + OFF_GATES);
      if (r < 18) {
#pragma unroll
        for (int mi = 0; mi < 2; ++mi)
#pragma unroll
          for (int i = 0; i < 16; ++i) {
            const int row = rowbase + mi * 32 + crow(i, h);
            gt[(size_t)row * 18 + r] = sigmoidf_(acc[mi][0][i]);
          }
      }
    }
  }
};

template <class Epi>
DI void gemm_phase(const bf16_t* A, int lda, const bf16_t* Bt, int ldb, int K, int MT, int NTl, int SN, const Epi& epi, char* lds, bool rev = false) {
  const int lmax = tile_lmax(MT, NTl, SN);
  int L = blockIdx.x, mt = 0, nt = 0;
  bool have = false;
  for (; L < lmax; L += gridDim.x) if (tile_map(L, MT, NTl, SN, mt, nt)) { have = true; if (rev) mt = MT - 1 - mt; break; }
  f32x16 dummy[2][2];
  if (have) gemm_core<1>(A + (size_t)mt * 256 * lda, lda, Bt + (size_t)nt * 128 * ldb, ldb, K, dummy, lds);
  while (have) {
    f32x16 acc[2][2];
    zero_acc(acc);
    const int cmt = mt, cnt = nt;
    float rv[Epi::PRE ? 2 : 1][2][16];
    if constexpr (Epi::PRE) epi.pre(rv, cmt * 256, cnt * 128);
    gemm_core<2>(A + (size_t)cmt * 256 * lda, lda, Bt + (size_t)cnt * 128 * ldb, ldb, K, acc, lds);
    have = false;
    for (L += gridDim.x; L < lmax; L += gridDim.x) if (tile_map(L, MT, NTl, SN, mt, nt)) { have = true; if (rev) mt = MT - 1 - mt; break; }
    if (have) gemm_core<1>(A + (size_t)mt * 256 * lda, lda, Bt + (size_t)nt * 128 * ldb, ldb, K, dummy, lds);
    if constexpr (Epi::PRE) epi(acc, cmt * 256, cnt * 128, rv); else epi(acc, cmt * 256, cnt * 128);
  }
}

struct ConvD { const float* src; const float* src2; bf16_t* dst; int K, Nsrc, Nout, mode, coloff, nvalid; };
constexpr int CONV_NT[14] = {1408, 704, 1408, 704, 800, 768, 128, 128, 8, 8, 96, 64, 32, 256};
constexpr int CONV_PER_LAYER = 6512;

DI ConvD get_conv(const Params& p, int l, int id) {
  ConvD c; c.src2 = nullptr; c.mode = 0; c.coloff = 0;
  bf16_t* wl = (bf16_t*)(p.ws + OFF_W) + (size_t)l * W_LAYER;
  switch (id) {
    case 0: c.src = p.in[I_F1G] + (size_t)l * 1024 * DFF; c.src2 = p.in[I_F1U] + (size_t)l * 1024 * DFF; c.dst = wl + OW_GU1; c.K = 1024; c.Nsrc = DFF; c.Nout = 5632; c.mode = 1; c.nvalid = 5632; break;
    case 1: c.src = p.in[I_F1D] + (size_t)l * DFF * 1024; c.dst = wl + OW_DN1; c.K = DFF; c.Nsrc = 1024; c.Nout = 1024; c.nvalid = 1024; break;
    case 2: c.src = p.in[I_F2G] + (size_t)l * 1024 * DFF; c.src2 = p.in[I_F2U] + (size_t)l * 1024 * DFF; c.dst = wl + OW_GU2; c.K = 1024; c.Nsrc = DFF; c.Nout = 5632; c.mode = 1; c.nvalid = 5632; break;
    case 3: c.src = p.in[I_F2D] + (size_t)l * DFF * 1024; c.dst = wl + OW_DN2; c.K = DFF; c.Nsrc = 1024; c.Nout = 1024; c.nvalid = 1024; break;
    case 4: c.src = p.in[I_WIN] + (size_t)l * 1024 * 6162; c.dst = wl + OW_INM; c.K = 1024; c.Nsrc = 6162; c.Nout = 3200; c.mode = 2; c.nvalid = 3090; break;
    case 5: c.src = p.in[I_WIN] + (size_t)l * 1024 * 6162; c.dst = wl + OW_ING; c.K = 1024; c.Nsrc = 6162; c.Nout = 3072; c.coloff = 3090; c.nvalid = 3072; break;
    case 6: c.src = p.in[I_PK1] + (size_t)l * 2048 * 256; c.dst = wl + OW_PK1; c.K = 2048; c.Nsrc = 256; c.Nout = 256; c.nvalid = 256; break;
    case 7: c.src = p.in[I_PV1] + (size_t)l * 2048 * 256; c.dst = wl + OW_PV1; c.K = 2048; c.Nsrc = 256; c.Nout = 256; c.nvalid = 256; break;
    case 8: c.src = p.in[I_PK2] + (size_t)l * 256 * 64; c.dst = wl + OW_PK2; c.K = 256; c.Nsrc = 64; c.Nout = 128; c.nvalid = 64; break;
    case 9: c.src = p.in[I_PV2] + (size_t)l * 256 * 64; c.dst = wl + OW_PV2; c.K = 256; c.Nsrc = 64; c.Nout = 128; c.nvalid = 64; break;
    case 10: c.src = p.in[I_UA] + (size_t)l * 384 * 1024; c.dst = wl + OW_UA; c.K = 384; c.Nsrc = 1024; c.Nout = 1024; c.nvalid = 1024; break;
    case 11: c.src = p.in[I_UB] + (size_t)l * 256 * 1024; c.dst = wl + OW_UB; c.K = 256; c.Nsrc = 1024; c.Nout = 1024; c.nvalid = 1024; break;
    case 12: c.src = p.in[I_UC] + (size_t)l * 128 * 1024; c.dst = wl + OW_UC; c.K = 128; c.Nsrc = 1024; c.Nout = 1024; c.nvalid = 1024; break;
    default: c.src = p.in[I_WO] + (size_t)l * 1024 * 1024; c.dst = wl + OW_WO; c.K = 1024; c.Nsrc = 1024; c.Nout = 1024; c.nvalid = 1024; break;
  }
  return c;
}

DI void conv_tile(const ConvD& c, int tn, int tk, float* lds) {
  const int tid = TIDX;
  const int n0 = tn * 64, k0 = tk * 64;
  {
    const int j = tid & 63, np = n0 + j;
    const float* sp = c.src; int col = -1;
    if (c.mode == 0) { if (np < c.nvalid) col = c.coloff + np; }
    else if (c.mode == 1) { const int tile = np >> 7, within = np & 127, wc = within >> 6, part = (within & 63) >> 5, jj = within & 31;
      col = tile * 64 + wc * 32 + jj; if (part) sp = c.src2; }
    else { if (np < 1152) col = np; else if (np < 3072) col = 1170 + (np - 1152); else if (np < 3090) col = 1152 + (np - 3072); }
    float tv[8];
#pragma unroll
    for (int i = 0; i < 8; ++i) {
      const int kk = (tid >> 6) + 8 * i;
      tv[i] = (col >= 0) ? sp[(size_t)(k0 + kk) * c.Nsrc + col] : 0.f;
    }
#pragma unroll
    for (int i = 0; i < 8; ++i) lds[((tid >> 6) + 8 * i) * 65 + j] = tv[i];
  }
  __syncthreads();
  {
    const int kk = tid & 63;
#pragma unroll
    for (int i = 0; i < 8; ++i) {
      const int j = (tid >> 6) + 8 * i;
      c.dst[(size_t)(n0 + j) * c.K + k0 + kk] = f2bf(lds[kk * 65 + j]);
    }
  }
  __syncthreads();
}

DI void rms_phase(const float* x, const float* gain, bf16_t* hn) {
  const int lane = TIDX & 63;
  const int gw = blockIdx.x * 8 + (TIDX >> 6), nw = gridDim.x * 8;
  f32x4 g[4];
#pragma unroll
  for (int i = 0; i < 4; ++i) g[i] = *(const f32x4*)(gain + i * 256 + lane * 4);
  for (int row = gw; row < NT; row += 2 * nw) {
    const int row2 = (row + nw < NT) ? row + nw : row;
    f32x4 v[4], w2[4]; float ss = 0.f, ss2 = 0.f;
#pragma unroll
    for (int i = 0; i < 4; ++i) { v[i] = *(const f32x4*)(x + (size_t)row * DM + i * 256 + lane * 4); w2[i] = *(const f32x4*)(x + (size_t)row2 * DM + i * 256 + lane * 4); }
#pragma unroll
    for (int i = 0; i < 4; ++i) { ss += v[i][0] * v[i][0] + v[i][1] * v[i][1] + v[i][2] * v[i][2] + v[i][3] * v[i][3]; ss2 += w2[i][0] * w2[i][0] + w2[i][1] * w2[i][1] + w2[i][2] * w2[i][2] + w2[i][3] * w2[i][3]; }
#pragma unroll
    for (int o = 32; o >= 1; o >>= 1) { ss += __shfl_xor(ss, o); ss2 += __shfl_xor(ss2, o); }
    const float rs = rsqrtf(ss * (1.f / 1024.f) + 1e-6f), rs2 = rsqrtf(ss2 * (1.f / 1024.f) + 1e-6f);
#pragma unroll
    for (int i = 0; i < 4; ++i) {
      u32x2 w; w.x = pack2(v[i][0] * rs * g[i][0], v[i][1] * rs * g[i][1]); w.y = pack2(v[i][2] * rs * g[i][2], v[i][3] * rs * g[i][3]);
      *(u32x2*)(hn + (size_t)row * DM + i * 256 + lane * 4) = w;
      u32x2 w3; w3.x = pack2(w2[i][0] * rs2 * g[i][0], w2[i][1] * rs2 * g[i][1]); w3.y = pack2(w2[i][2] * rs2 * g[i][2], w2[i][3] * rs2 * g[i][3]);
      *(u32x2*)(hn + (size_t)row2 * DM + i * 256 + lane * 4) = w3;
    }
  }
}
DI void final_norm_phase(float* x, const float* gain) {
  const int lane = TIDX & 63;
  const int gw = blockIdx.x * 8 + (TIDX >> 6), nw = gridDim.x * 8;
  f32x4 g[4];
#pragma unroll
  for (int i = 0; i < 4; ++i) g[i] = *(const f32x4*)(gain + i * 256 + lane * 4);
  for (int row = gw; row < NT; row += nw) {
    f32x4 v[4]; float ss = 0.f;
#pragma unroll
    for (int i = 0; i < 4; ++i) { v[i] = *(const f32x4*)(x + (size_t)row * DM + i * 256 + lane * 4); ss += v[i][0] * v[i][0] + v[i][1] * v[i][1] + v[i][2] * v[i][2] + v[i][3] * v[i][3]; }
#pragma unroll
    for (int o = 32; o >= 1; o >>= 1) ss += __shfl_xor(ss, o);
    const float rs = rsqrtf(ss * (1.f / 1024.f) + 1e-6f);
#pragma unroll
    for (int i = 0; i < 4; ++i) {
      f32x4 w; w[0] = v[i][0] * rs * g[i][0]; w[1] = v[i][1] * rs * g[i][1]; w[2] = v[i][2] * rs * g[i][2]; w[3] = v[i][3] * rs * g[i][3];
      *(f32x4*)(x + (size_t)row * DM + i * 256 + lane * 4) = w;
    }
  }
}

DI void phase0(const Params& p, char* lds) {
  if (blockIdx.x == 0 && TIDX < 64) { ((unsigned*)(p.ws + OFF_MISC))[TIDX] = 0u; ((unsigned*)(p.ws + OFF_MISC + 6144))[TIDX] = 0u; }
  for (int it = blockIdx.x; it < 4; it += gridDim.x) {
    const int l = it >> 1, kv = it & 1;
    const float* pe = p.in[kv ? I_PEV : I_PEK] + (size_t)l * 2048;
    const float* w = p.in[kv ? I_PV1 : I_PK1] + (size_t)l * 2048 * 256;
    const int n = TIDX;
    if (n < 256) {
      float s = 0.f;
      for (int k = 0; k < 2048; ++k) s += pe[k] * w[(size_t)k * 256 + n];
      ((float*)(p.ws + OFF_MISC + 256))[it * 256 + n] = s;
    }
  }
  for (int w = blockIdx.x; w < 2 * CONV_PER_LAYER; w += gridDim.x) {
    const int l = w / CONV_PER_LAYER; int ww = w % CONV_PER_LAYER; int id = 0;
#pragma unroll
    for (int i = 0; i < 14; ++i) { if (id == i && ww >= CONV_NT[i]) { ww -= CONV_NT[i]; id = i + 1; } }
    const ConvD c = get_conv(p, l, id);
    const int ntn = c.Nout >> 6;
    conv_tile(c, ww % ntn, ww / ntn, (float*)lds);
  }
  rms_phase(p.in[I_X], p.in[I_F1N], (bf16_t*)(p.ws + OFF_HN));
}

constexpr int BK_THR[15] = {22, 30, 40, 54, 73, 99, 134, 182, 246, 332, 450, 609, 825, 1117, 1513};
struct AttnSt { float m, l; f32x16 o0, o1; };
DI void attn_init(AttnSt& st) { st.m = NEGINF; st.l = 0.f;
#pragma unroll
  for (int i = 0; i < 16; ++i) { st.o0[i] = 0.f; st.o1[i] = 0.f; } }

DI void load_q(bf16x8 (&qf)[4], const bf16_t* qrow) {
#pragma unroll
  for (int s = 0; s < 4; ++s) qf[s] = *(const bf16x8*)(qrow + 16 * s);
}
DI f32x16 qk_tile(const bf16x8 (&qf)[4], const bf16_t* krow) {
  f32x16 s;
#pragma unroll
  for (int i = 0; i < 16; ++i) s[i] = 0.f;
#pragma unroll
  for (int ss = 0; ss < 4; ++ss) { const bf16x8 kf = *(const bf16x8*)(krow + 512 * ss); s = MFMA32(kf, qf[ss], s); }
  return s;
}
DI void pv_tile(AttnSt& st, const float (&pr)[16], const bf16_t* v0, size_t rowstride) {
#pragma unroll
  for (int s2 = 0; s2 < 2; ++s2) {
    u32x4 pk; pk.x = pack2(pr[8 * s2], pr[8 * s2 + 1]); pk.y = pack2(pr[8 * s2 + 2], pr[8 * s2 + 3]); pk.z = pack2(pr[8 * s2 + 4], pr[8 * s2 + 5]); pk.w = pack2(pr[8 * s2 + 6], pr[8 * s2 + 7]);
    const bf16x8 pb = __builtin_bit_cast(bf16x8, pk);
    {
      const s16x4 lo = *(const s16x4*)(v0 + 256 * (s2 * 4 + 0)), hi = *(const s16x4*)(v0 + 256 * (s2 * 4 + 1));
      const bf16x8 va = __builtin_shufflevector(lo, hi, 0, 1, 2, 3, 4, 5, 6, 7);
      st.o0 = MFMA32(va, pb, st.o0);
    }
    {
      const s16x4 lo = *(const s16x4*)(v0 + 256 * (s2 * 4 + 2)), hi = *(const s16x4*)(v0 + 256 * (s2 * 4 + 3));
      const bf16x8 va = __builtin_shufflevector(lo, hi, 0, 1, 2, 3, 4, 5, 6, 7);
      st.o1 = MFMA32(va, pb, st.o1);
    }
  }
}
DI void softmax_step(AttnSt& st, const float (&lg)[16], const bf16_t* v0, size_t rowstride) {
  float mx = NEGINF;
#pragma unroll
  for (int i = 0; i < 16; ++i) mx = fmaxf(mx, lg[i]);
  mx = fmaxf(mx, shx32(mx));
  if (__ballot(mx > NEGINF) == 0ull) return;
  const float mnew = fmaxf(st.m, mx);
  const float muse = (mnew == NEGINF) ? 0.f : mnew;
  const float alpha = ex2(st.m - muse);
  float pr[16]; float rs = 0.f;
#pragma unroll
  for (int i = 0; i < 16; ++i) { pr[i] = ex2(lg[i] - muse); rs += pr[i]; }
  st.l = st.l * alpha + rs; st.m = mnew;
#pragma unroll
  for (int i = 0; i < 16; ++i) { st.o0[i] *= alpha; st.o1[i] *= alpha; }
  pv_tile(st, pr, v0, rowstride);
}

struct KVT { bf16x8 k[4]; s16x4 v[8]; };
DI void load_kv(KVT& t, const bf16_t* krow, const bf16_t* v0, size_t rowstride) {
#pragma unroll
  for (int ss = 0; ss < 4; ++ss) t.k[ss] = *(const bf16x8*)(krow + 512 * ss);
#pragma unroll
  for (int j = 0; j < 8; ++j) t.v[j] = *(const s16x4*)(v0 + 256 * j);
}
DI void softmax_step_r(AttnSt& st, const float (&lg)[16], const KVT& t) {
  float mx = NEGINF;
#pragma unroll
  for (int i = 0; i < 16; ++i) mx = fmaxf(mx, lg[i]);
  mx = fmaxf(mx, shx32(mx));
  if (__ballot(mx > NEGINF) == 0ull) return;
  const float mnew = fmaxf(st.m, mx);
  const float muse = (mnew == NEGINF) ? 0.f : mnew;
  const float alpha = ex2(st.m - muse);
  float pr[16]; float rs = 0.f;
#pragma unroll
  for (int i = 0; i < 16; ++i) { pr[i] = ex2(lg[i] - muse); rs += pr[i]; }
  st.l = st.l * alpha + rs;
  if (__ballot(mnew != st.m) != 0ull) {
#pragma unroll
    for (int i = 0; i < 16; ++i) { st.o0[i] *= alpha; st.o1[i] *= alpha; }
  }
  st.m = mnew;
#pragma unroll
  for (int s2 = 0; s2 < 2; ++s2) {
    u32x4 pk; pk.x = pack2(pr[8 * s2], pr[8 * s2 + 1]); pk.y = pack2(pr[8 * s2 + 2], pr[8 * s2 + 3]); pk.z = pack2(pr[8 * s2 + 4], pr[8 * s2 + 5]); pk.w = pack2(pr[8 * s2 + 6], pr[8 * s2 + 7]);
    const bf16x8 pb = __builtin_bit_cast(bf16x8, pk);
    const bf16x8 va0 = __builtin_shufflevector(t.v[s2 * 4 + 0], t.v[s2 * 4 + 1], 0, 1, 2, 3, 4, 5, 6, 7);
    st.o0 = MFMA32(va0, pb, st.o0);
    const bf16x8 va1 = __builtin_shufflevector(t.v[s2 * 4 + 2], t.v[s2 * 4 + 3], 0, 1, 2, 3, 4, 5, 6, 7);
    st.o1 = MFMA32(va1, pb, st.o1);
  }
}
template <class KP, class VP, class ACT, class FILL>
DI void attn_loop(AttnSt& st, const bf16x8 (&qf)[4], int k0, int k1, size_t vstride, KP kp, VP vp, ACT act, FILL fill) {
  KVT cur, nxt;
  {
    KVT t0; load_kv(t0, kp(k0), vp(k0), vstride);
#pragma unroll
    for (int i = 0; i < 8; ++i) cur.v[i] = t0.v[i];
#pragma unroll
    for (int i = 0; i < 4; ++i) cur.k[i] = t0.k[i];
  }
  f32x16 s_cur;
  { const float z = 0.f;
#pragma unroll
    for (int i = 0; i < 16; ++i) s_cur[i] = z; }
#pragma unroll
  for (int ss = 0; ss < 4; ++ss) s_cur = MFMA32(cur.k[ss], qf[ss], s_cur);
  {
    const int kn = (k0 < k1) ? k0 + 1 : k1;
    const bf16_t* krow = kp(kn);
#pragma unroll
    for (int ss = 0; ss < 4; ++ss) nxt.k[ss] = *(const bf16x8*)(krow + 512 * ss);
  }
  for (int kt = k0; kt <= k1; ++kt) {
    const int kn = (kt < k1) ? kt + 1 : k1;
    const int kn2 = (kt + 2 <= k1) ? kt + 2 : k1;
    {
      const bf16_t* v0 = vp(kn);
#pragma unroll
      for (int j = 0; j < 8; ++j) nxt.v[j] = *(const s16x4*)(v0 + 256 * j);
    }
    bf16x8 k2[4];
    {
      const bf16_t* krow = kp(kn2);
#pragma unroll
      for (int ss = 0; ss < 4; ++ss) k2[ss] = *(const bf16x8*)(krow + 512 * ss);
    }
    f32x16 s_next;
#pragma unroll
    for (int i = 0; i < 16; ++i) s_next[i] = 0.f;
#pragma unroll
    for (int ss = 0; ss < 4; ++ss) s_next = MFMA32(nxt.k[ss], qf[ss], s_next);
    if (act(kt)) {
      float lg[16];
      fill(kt, s_cur, lg);
      softmax_step_r(st, lg, cur);
    }
    s_cur = s_next;
#pragma unroll
    for (int i = 0; i < 8; ++i) cur.v[i] = nxt.v[i];
#pragma unroll
    for (int ss = 0; ss < 4; ++ss) nxt.k[ss] = k2[ss];
  }
}

DI float lut_bias(const unsigned char* blut, const float* tblh, int dist) {
  const int d = dist < 0 ? 0 : (dist > 2048 ? 2048 : dist);
  return tblh[blut[d]];
}
DI void bias16(const unsigned char* blut, const float* tblh, const int (&dist)[16], float (&bv)[16]) {
  int bk[16];
#pragma unroll
  for (int i = 0; i < 16; ++i) { const int d = dist[i] < 0 ? 0 : (dist[i] > 2048 ? 2048 : dist[i]); bk[i] = blut[d]; }
#pragma unroll
  for (int i = 0; i < 16; ++i) asm volatile("" : "+v"(bk[i]));
#pragma unroll
  for (int i = 0; i < 16; ++i) bv[i] = tblh[bk[i]];
#pragma unroll
  for (int i = 0; i < 16; ++i) asm volatile("" : "+v"(bv[i]));
}
DI void store_o(bf16_t* dst, const f32x16& o0, const f32x16& o1, int h) {
#pragma unroll
  for (int g = 0; g < 4; ++g) {
    u32x2 a; a.x = pack2(o0[4 * g], o0[4 * g + 1]); a.y = pack2(o0[4 * g + 2], o0[4 * g + 3]);
    *(u32x2*)(dst + 8 * g + 4 * h) = a;
    u32x2 b; b.x = pack2(o1[4 * g], o1[4 * g + 1]); b.y = pack2(o1[4 * g + 2], o1[4 * g + 3]);
    *(u32x2*)(dst + 32 + 8 * g + 4 * h) = b;
  }
}

DI void build_lut(unsigned char* blut, float* tbl, const float* rel_bias) {
  for (int n = TIDX; n < 2049; n += NTHREADS) {
    int bk = n;
    if (n >= 16) { bk = 16;
#pragma unroll
      for (int k = 0; k < 15; ++k) bk += (n >= BK_THR[k]) ? 1 : 0; }
    blut[n] = (unsigned char)bk;
  }
  for (int i = TIDX; i < 512; i += NTHREADS) { const int hd = i >> 5, bk = i & 31; tbl[i] = rel_bias[bk * 16 + hd] * 1.4426950408889634f; }
  __syncthreads();
}

DI int wave_fetch(unsigned* ctr) {
  int v = 0;
  if ((TIDX & 63) == 0) v = (int)atomicAdd(ctr, 1u);
  return __shfl(v, 0);
}

DI void nsa_cmp_item(const Params& p, int item, const unsigned char* blut, const float* tbl, float* impw) {
  const int lane = TIDX & 63, r = lane & 31, h = lane >> 5;
  const int qb = 127 - (item >> 4), bg = item & 15, b = bg >> 1, g = bg & 1;
  const int t = qb * 32 + r;
  const int ntile = (qb >> 4) + 1;
  const bf16_t* KC = (const bf16_t*)(p.ws + OFF_KC) + (size_t)bg * 256 * 64;
  const bf16_t* VCT = (const bf16_t*)(p.ws + OFF_VCT) + (size_t)bg * 64 * 256;
  const float* gates = (const float*)(p.ws + OFF_GATES) + (size_t)(b * 4096 + t) * 18;
#pragma unroll 4
  for (int j = 0; j < 32; ++j) impw[r * 65 + 2 * j + h] = 0.f;
  for (int rr = 0; rr < 3; ++rr) {
    const int head = g * 3 + rr;
    const float* tblh = tbl + head * 32;
    bf16x8 qf[4];
    load_q(qf, (const bf16_t*)(p.ws + OFF_QN) + (size_t)(b * 4096 + t) * 384 + head * 64 + 8 * h);
    float m = NEGINF, l = 0.f;
    for (int kt = 0; kt < ntile; ++kt) {
      const f32x16 s = qk_tile(qf, KC + (size_t)kt * 2048 + (h * 32 + r) * 8);
      float lg[16]; float mx = NEGINF;
      int dist[16]; float bv[16];
#pragma unroll
      for (int i = 0; i < 16; ++i) dist[i] = t - (16 * (kt * 32 + crow(i, h)) + 31);
      bias16(blut, tblh, dist, bv);
#pragma unroll
      for (int i = 0; i < 16; ++i) { lg[i] = (dist[i] >= 0) ? s[i] + bv[i] : NEGINF; mx = fmaxf(mx, lg[i]); }
      mx = fmaxf(mx, shx32(mx));
      const float mnew = fmaxf(m, mx), muse = (mnew == NEGINF) ? 0.f : mnew;
      float rs = 0.f;
#pragma unroll
      for (int i = 0; i < 16; ++i) rs += ex2(lg[i] - muse);
      l = l * ex2(m - muse) + rs; m = mnew;
    }
    l += shx32(l);
    const float muse = (m == NEGINF) ? 0.f : m;
    const float inv = (l > 0.f) ? 1.f / l : 0.f;
    AttnSt st; attn_init(st);
    float prev3 = 0.f;
#pragma unroll 1
    for (int kt = 0; kt < ntile; ++kt) {
      {
        const f32x16 s = qk_tile(qf, KC + (size_t)kt * 2048 + (h * 32 + r) * 8);
        float pr[16];
        int dist[16]; float bv[16];
#pragma unroll
        for (int i = 0; i < 16; ++i) dist[i] = t - (16 * (kt * 32 + crow(i, h)) + 31);
        bias16(blut, tblh, dist, bv);
#pragma unroll
        for (int i = 0; i < 16; ++i) pr[i] = (dist[i] >= 0) ? ex2(s[i] + bv[i] - muse) * inv : 0.f;
        float recv[4];
#pragma unroll
        for (int q = 0; q < 4; ++q) recv[q] = shx32(pr[4 * q + 3]);
#pragma unroll
        for (int q = 0; q < 4; ++q) {
          const float qs = (pr[4 * q] + pr[4 * q + 1]) + (pr[4 * q + 2] + pr[4 * q + 3]);
          const float cin = h ? recv[q] : (q ? recv[q > 0 ? q - 1 : 0] : prev3);
          impw[r * 65 + 8 * kt + 2 * q + h] += qs + cin;
        }
        prev3 = recv[3];
        pv_tile(st, pr, VCT + (size_t)kt * 2048 + (h * 32 + r) * 4, 256);
      }
    }
    const float g0 = gates[head * 3 + 0];
#pragma unroll
    for (int i = 0; i < 16; ++i) { st.o0[i] *= g0; st.o1[i] *= g0; }
    store_o((bf16_t*)(p.ws + OFF_OC) + (size_t)(b * 4096 + t) * 384 + head * 64, st.o0, st.o1, h);
  }
  const int cur = t >> 6;
  unsigned long long mask;
  if (cur < 16) {
    mask = (2ull << cur) - 1ull;
  } else {
    float own[32], oth[32];
#pragma unroll
    for (int j = 0; j < 32; ++j) {
      const int u = 2 * j + h, uo = 2 * j + 1 - h;
      const float a = impw[r * 65 + u], bb = impw[r * 65 + uo];
      own[j] = ((u >= 1) && (u <= cur - 2)) ? a : -1.f;
      oth[j] = ((uo >= 1) && (uo <= cur - 2)) ? bb : -1.f;
    }
    float prev = __builtin_inff();
#pragma unroll 1
    for (int round = 0; round < 13; ++round) {
      float m = -2.f;
#pragma unroll
      for (int j = 0; j < 32; ++j) { m = fmaxf(m, own[j] < prev ? own[j] : -2.f); m = fmaxf(m, oth[j] < prev ? oth[j] : -2.f); }
      prev = m;
    }
    unsigned mlo = 0u, mhi = 0u;
#pragma unroll
    for (int j = 0; j < 32; ++j) {
      const int u = 2 * j + h;
      const bool forced = (u == 0) || (u == cur) || (u == cur - 1);
      const bool cand = (u >= 1) && (u <= cur - 2);
      const bool sel = forced || (cand && own[j] >= prev);
      if (j < 16) mlo |= sel ? (1u << u) : 0u; else mhi |= sel ? (1u << (u - 32)) : 0u;
    }
    mlo |= (unsigned)shx32i((int)mlo);
    mhi |= (unsigned)shx32i((int)mhi);
    mask = ((unsigned long long)mhi << 32) | mlo;
  }
  if (h == 0) ((unsigned long long*)(p.ws + OFF_SELM))[(size_t)bg * 4096 + t] = mask;
}

DI void nsa_main_item(const Params& p, int b, int head, int qb, const unsigned char* blut, const float* tbl) {
  const int lane = TIDX & 63, r = lane & 31, h = lane >> 5;
  const int g = head / 3, bg = b * 2 + g;
  const int t = qb * 32 + r;
  const float* tblh = tbl + head * 32;
  bf16x8 qf[4];
  load_q(qf, (const bf16_t*)(p.ws + OFF_QN) + (size_t)(b * 4096 + t) * 384 + head * 64 + 8 * h);
  const unsigned long long selm = ((const unsigned long long*)(p.ws + OFF_SELM))[(size_t)bg * 4096 + t];
  const float* gates = (const float*)(p.ws + OFF_GATES) + (size_t)(b * 4096 + t) * 18 + head * 3;
  const float g1 = gates[1], g2 = gates[2];
  f32x16 y0, y1;
  {
    const bf16_t* oc = (const bf16_t*)(p.ws + OFF_OC) + (size_t)(b * 4096 + t) * 384 + head * 64;
#pragma unroll
    for (int i = 0; i < 16; ++i) { y0[i] = bf2f(oc[crow(i, h)]); y1[i] = bf2f(oc[32 + crow(i, h)]); }
  }
  {
    const bf16_t* K = (const bf16_t*)(p.ws + OFF_KSEL) + (size_t)bg * 4096 * 64;
    const bf16_t* Vt = (const bf16_t*)(p.ws + OFF_VSELT) + (size_t)bg * 64 * 4096;
    AttnSt st; attn_init(st);
    attn_loop(st, qf, 0, qb, 32,
      [&](int kt) { return K + (size_t)kt * 2048 + (h * 32 + r) * 8; },
      [&](int kt) { return Vt + (size_t)kt * 2048 + (h * 32 + r) * 4; },
      [&](int kt) { return __ballot((selm >> (kt >> 1)) & 1ull) != 0ull; },
      [&](int kt, const f32x16& s, float (&lg)[16]) {
        const bool bs = (selm >> (kt >> 1)) & 1ull;
        if (qb * 32 - (kt * 32 + 31) >= 1513) {
          const float b31 = tblh[31];
#pragma unroll
          for (int i = 0; i < 16; ++i) lg[i] = bs ? s[i] + b31 : NEGINF;
        } else {
          int dist[16]; float bv[16];
#pragma unroll
          for (int i = 0; i < 16; ++i) dist[i] = t - (kt * 32 + crow(i, h));
          bias16(blut, tblh, dist, bv);
#pragma unroll
          for (int i = 0; i < 16; ++i) lg[i] = (bs && dist[i] >= 0) ? s[i] + bv[i] : NEGINF;
        }
      });
    float l = st.l + shx32(st.l);
    const float sc = (l > 0.f) ? g1 / l : 0.f;
#pragma unroll
    for (int i = 0; i < 16; ++i) { y0[i] += sc * st.o0[i]; y1[i] += sc * st.o1[i]; }
  }
  {
    const bf16_t* K = (const bf16_t*)(p.ws + OFF_KWIN) + (size_t)bg * 4096 * 64;
    const bf16_t* Vt = (const bf16_t*)(p.ws + OFF_VWINT) + (size_t)bg * 64 * 4096;
    AttnSt st; attn_init(st);
    const int k0 = qb >= 16 ? qb - 16 : 0;
    attn_loop(st, qf, k0, qb, 32,
      [&](int kt) { return K + (size_t)kt * 2048 + (h * 32 + r) * 8; },
      [&](int kt) { return Vt + (size_t)kt * 2048 + (h * 32 + r) * 4; },
      [&](int kt) { return true; },
      [&](int kt, const f32x16& s, float (&lg)[16]) {
        int dist[16]; float bv[16];
#pragma unroll
        for (int i = 0; i < 16; ++i) dist[i] = t - (kt * 32 + crow(i, h));
        bias16(blut, tblh, dist, bv);
#pragma unroll
        for (int i = 0; i < 16; ++i) lg[i] = (dist[i] >= 0 && dist[i] < 512) ? s[i] + bv[i] : NEGINF;
      });
    float l = st.l + shx32(st.l);
    const float sc = (l > 0.f) ? g2 / l : 0.f;
#pragma unroll
    for (int i = 0; i < 16; ++i) { y0[i] += sc * st.o0[i]; y1[i] += sc * st.o1[i]; }
  }
  store_o((bf16_t*)(p.ws + OFF_Y) + (size_t)(b * 4096 + t) * 768 + head * 64, y0, y1, h);
}

DI void moba_item(const Params& p, int b, int hd, int qb, const unsigned char* blut, const float* tbl) {
  const int lane = TIDX & 63, r = lane & 31, h = lane >> 5;
  const int bh = b * 4 + hd;
  const int t = qb * 32 + r;
  const int c = qb >> 3;
  const float* tblh = tbl + (6 + hd) * 32;
  bf16x8 qf[4];
  load_q(qf, (const bf16_t*)(p.ws + OFF_QM) + (size_t)(b * 4096 + t) * 256 + hd * 64 + 8 * h);
  unsigned mmask = 0u;
  if (c > 0) {
    const bf16_t* km = (const bf16_t*)(p.ws + OFF_KMEAN) + (size_t)bh * 16 * 64 + (size_t)(r & 15) * 64 + 8 * h;
    f32x16 s;
#pragma unroll
    for (int i = 0; i < 16; ++i) s[i] = 0.f;
#pragma unroll
    for (int ss = 0; ss < 4; ++ss) {
      bf16x8 kf = *(const bf16x8*)(km + 16 * ss);
      if (r >= 16) {
#pragma unroll
        for (int j = 0; j < 8; ++j) kf[j] = 0;
      }
      s = MFMA32(kf, qf[ss], s);
    }
    float g16[16];
#pragma unroll
    for (int i = 0; i < 8; ++i) {
      const float own = s[i], oth = shx32(own);
      const int base = (i & 3) + 8 * (i >> 2);
      g16[base] = h ? oth : own;
      g16[base + 4] = h ? own : oth;
    }
#pragma unroll
    for (int n = 0; n < 16; ++n) g16[n] = (n < c) ? g16[n] : NEGINF;
#pragma unroll
    for (int round = 0; round < 3; ++round) {
      float best = NEGINF; int bi = -1;
#pragma unroll
      for (int n = 0; n < 16; ++n) if (g16[n] > best) { best = g16[n]; bi = n; }
      if (bi >= 0) mmask |= 1u << bi;
#pragma unroll
      for (int n = 0; n < 16; ++n) if (n == bi) g16[n] = NEGINF;
    }
  }
  mmask |= 1u << c;
  const bf16_t* K = (const bf16_t*)(p.ws + OFF_KM) + (size_t)bh * 4096 * 64;
  const bf16_t* Vt = (const bf16_t*)(p.ws + OFF_VMT) + (size_t)bh * 64 * 4096;
  AttnSt st; attn_init(st);
  attn_loop(st, qf, 0, qb, 32,
    [&](int kt) { return K + (size_t)kt * 2048 + (h * 32 + r) * 8; },
    [&](int kt) { return Vt + (size_t)kt * 2048 + (h * 32 + r) * 4; },
    [&](int kt) { return __ballot((mmask >> (kt >> 3)) & 1u) != 0ull; },
    [&](int kt, const f32x16& s, float (&lg)[16]) {
      const bool bs = (mmask >> (kt >> 3)) & 1u;
      if (qb * 32 - (kt * 32 + 31) >= 1513) {
        const float b31 = tblh[31];
#pragma unroll
        for (int i = 0; i < 16; ++i) lg[i] = bs ? s[i] + b31 : NEGINF;
      } else {
        int dist[16]; float bv[16];
#pragma unroll
        for (int i = 0; i < 16; ++i) dist[i] = t - (kt * 32 + crow(i, h));
        bias16(blut, tblh, dist, bv);
#pragma unroll
        for (int i = 0; i < 16; ++i) lg[i] = (bs && dist[i] >= 0) ? s[i] + bv[i] : NEGINF;
      }
    });
  float l = st.l + shx32(st.l);
  const float sc = (l > 0.f) ? 1.f / l : 0.f;
#pragma unroll
  for (int i = 0; i < 16; ++i) { st.o0[i] *= sc; st.o1[i] *= sc; }
  store_o((bf16_t*)(p.ws + OFF_Y) + (size_t)(b * 4096 + t) * 768 + 384 + hd * 64, st.o0, st.o1, h);
}

DI void dil_item(const Params& p, int b, int j, int qi, const unsigned char* blut, const float* tbl) {
  const int lane = TIDX & 63, r = lane & 31, h = lane >> 5;
  const int rho = qi & 15, ub = qi >> 4;
  const int t = rho + 16 * (ub * 32 + r);
  const int tmin = rho + 16 * (ub * 32), tmax = rho + 16 * (ub * 32 + 31);
  AttnSt st; attn_init(st);
#pragma unroll
  for (int g = 0; g < 3; ++g) {
    const int dil = (g == 0) ? 1 : (g == 1 ? 4 : 16), window = 128 * dil, L = 4096 / dil;
    const int hd = 2 * g + j;
    const float* tblh = tbl + (10 + hd) * 32;
    const int rg = rho % dil;
    bf16x8 qf[4];
    load_q(qf, (const bf16_t*)(p.ws + OFF_QD) + (size_t)(b * 4096 + t) * 384 + hd * 64 + 8 * h);
    const bf16_t* K = (const bf16_t*)(p.ws + OFF_KD) + (size_t)(b * 6 + hd) * 4096 * 64;
    const bf16_t* Vt = (const bf16_t*)(p.ws + OFF_VDT) + (size_t)(b * 6 + hd) * 64 * 4096 + (size_t)(rg * L >> 5) * 2048;
    int vlo = tmin / dil - 128; if (vlo < 0) vlo = 0;
    const int vhi = tmax / dil;
    attn_loop(st, qf, vlo >> 5, vhi >> 5, 32,
      [&](int kt) { return K + (size_t)((rg * L >> 5) + kt) * 2048 + (h * 32 + r) * 8; },
      [&](int kt) { return Vt + (size_t)kt * 2048 + (h * 32 + r) * 4; },
      [&](int kt) { return true; },
      [&](int kt, const f32x16& s, float (&lg)[16]) {
        int dist[16]; float bv[16];
#pragma unroll
        for (int i = 0; i < 16; ++i) dist[i] = t - ((kt * 32 + crow(i, h)) * dil + rg);
        bias16(blut, tblh, dist, bv);
#pragma unroll
        for (int i = 0; i < 16; ++i) lg[i] = (dist[i] >= 0 && dist[i] <= window) ? s[i] + bv[i] : NEGINF;
      });
  }
  float l = st.l + shx32(st.l);
  const float sc = (l > 0.f) ? 1.f / l : 0.f;
#pragma unroll
  for (int i = 0; i < 16; ++i) { st.o0[i] *= sc; st.o1[i] *= sc; }
  store_o((bf16_t*)(p.ws + OFF_Y) + (size_t)(b * 4096 + t) * 768 + 640 + j * 64, st.o0, st.o1, h);
}

DI void phaseX(const Params& p, int layer, char* lds, int rep = 0) {
  unsigned char* blut = (unsigned char*)lds; float* tbl = (float*)(lds + 4096);
  build_lut(blut, tbl, p.in[I_RELB]);
  unsigned* ctr = (unsigned*)(p.ws + OFF_MISC) + layer * 2 + rep * 8;
  for (;;) {
    const int item = wave_fetch(ctr);
    if (item >= 2048) break;
    nsa_cmp_item(p, item, blut, tbl, (float*)(lds + 8192) + (TIDX >> 6) * (32 * 65));
  }
  __syncthreads();
}
DI void filler_items(const Params& p, int layer, char* lds, int which) {
  __syncthreads();
  unsigned char* blut = (unsigned char*)lds; float* tbl = (float*)(lds + 4096);
  build_lut(blut, tbl, p.in[I_RELB]);
  unsigned* ctr = (unsigned*)(p.ws + OFF_MISC) + 16 + layer * 2 + which;
  for (;;) {
    const int item = wave_fetch(ctr);
    if (which == 0) { if (item >= 128 * 16) break; const int qb = 127 - item / 16, sub = item % 16; dil_item(p, sub >> 1, sub & 1, qb, blut, tbl); }
    else { if (item >= 128 * 32) break; const int qb = 127 - item / 32, sub = item % 32; moba_item(p, sub >> 2, sub & 3, qb, blut, tbl); }
  }
  __syncthreads();
}
DI void phaseY(const Params& p, int layer, char* lds, int rep = 0) {
  unsigned char* blut = (unsigned char*)lds; float* tbl = (float*)(lds + 4096);
  build_lut(blut, tbl, p.in[I_RELB]);
  unsigned* ctr = (unsigned*)(p.ws + OFF_MISC) + layer * 2 + 1 + rep * 8;
  for (;;) {
    const int item = wave_fetch(ctr);
    if (item >= 128 * 48) break;
    const int qb = 127 - item / 48, sub = item % 48;
    nsa_main_item(p, sub / 6, sub % 6, qb, blut, tbl);
  }
  __syncthreads();
}

DI void kmean_phase(const Params& p) {
  const int lane = TIDX & 63;
  const int gw = blockIdx.x * 8 + (TIDX >> 6), nw = gridDim.x * 8;
  const bf16_t* KM = (const bf16_t*)(p.ws + OFF_KM);
  bf16_t* o = (bf16_t*)(p.ws + OFF_KMEAN);
  for (int it = gw; it < 512; it += nw) {
    const bf16_t* src = KM + (size_t)it * 256 * 64;
    float s = 0.f;
    for (int k = 0; k < 256; ++k) s += bf2f(KM[(size_t)(it >> 4) * 262144 + kfrag_idx((it & 15) * 256 + k, lane)]);
    o[it * 64 + lane] = f2bf(s * (1.f / 256.f));
  }
}

DI void merge_phase(const Params& p, int layer, char* lds) {
  const bf16_t* wl = (const bf16_t*)(p.ws + OFF_W) + (size_t)layer * W_LAYER;
  const bf16_t* hn = (const bf16_t*)(p.ws + OFF_HN);
  const bf16_t* y = (const bf16_t*)(p.ws + OFF_Y);
  bf16_t* mg = (bf16_t*)(p.ws + OFF_MERGED);
  const int lmax = tile_lmax(128, 8, 4);
  for (int L = blockIdx.x; L < lmax; L += gridDim.x) {
    int mt, nt;
    if (!tile_map(L, 128, 8, 4, mt, nt)) continue;
    f32x16 macc[2][2];
    zero_acc(macc);
#pragma unroll 1
    for (int br = 0; br < 3; ++br) {
      const int kw = (br == 0) ? 384 : (br == 1 ? 256 : 128);
      const int yo = (br == 0) ? 0 : (br == 1 ? 384 : 640);
      const bf16_t* wu = wl + ((br == 0) ? OW_UA : (br == 1 ? OW_UB : OW_UC));
      unsigned sg[2][2][8];
      {
        f32x16 ag[2][2];
        zero_acc(ag);
        gemm_core(hn + (size_t)mt * 256 * 1024, 1024, wl + OW_ING + (size_t)(br * 1024 + nt * 128) * 1024, 1024, 1024, ag, lds);
#pragma unroll
        for (int a = 0; a < 2; ++a)
#pragma unroll
          for (int c = 0; c < 2; ++c)
#pragma unroll
            for (int i = 0; i < 8; ++i) sg[a][c][i] = pack2(sigmoidf_(ag[a][c][2 * i]), sigmoidf_(ag[a][c][2 * i + 1]));
      }
      f32x16 au[2][2];
      zero_acc(au);
      gemm_core(y + (size_t)mt * 256 * 768 + yo, 768, wu + (size_t)nt * 128 * kw, kw, kw, au, lds);
#pragma unroll
      for (int a = 0; a < 2; ++a)
#pragma unroll
        for (int c = 0; c < 2; ++c)
#pragma unroll
          for (int i = 0; i < 8; ++i) {
            macc[a][c][2 * i] += __uint_as_float(sg[a][c][i] << 16) * au[a][c][2 * i];
            macc[a][c][2 * i + 1] += __uint_as_float(sg[a][c][i] & 0xffff0000u) * au[a][c][2 * i + 1];
          }
    }
    const int tid = TIDX, lane = tid & 63, wid = tid >> 6, wr = wid >> 1, wc = wid & 1, r = lane & 31, h = lane >> 5;
#pragma unroll
    for (int a = 0; a < 2; ++a)
#pragma unroll
      for (int c = 0; c < 2; ++c)
#pragma unroll
        for (int i = 0; i < 16; ++i)
          mg[(size_t)(mt * 256 + wr * 64 + a * 32 + crow(i, h)) * 1024 + nt * 128 + wc * 64 + c * 32 + r] = f2bf(macc[a][c][i]);
  }
}

constexpr int NPHASE = 1 + 2 * 14 + 1;

DI void run_phase(const Params& p, int ph, char* lds, int rep = 0) {
#ifdef TESTQ
  if (ph == 0) { if (TESTQ == 100) phase0(p, lds); return; }
  if ((ph - 1) % 14 != TESTQ) return;
#endif
  if (ph == 0) { phase0(p, lds); return; }
  if (ph == NPHASE - 1) { final_norm_phase(p.out, p.in[I_FINN]); return; }
  const int layer = (ph - 1) / 14, q = (ph - 1) % 14;
  const bf16_t* wl = (const bf16_t*)(p.ws + OFF_W) + (size_t)layer * W_LAYER;
  bf16_t* hn = (bf16_t*)(p.ws + OFF_HN);
  switch (q) {
    case 0: { EpiSwiglu e{(bf16_t*)(p.ws + OFF_FFH)}; gemm_phase(hn, 1024, wl + OW_GU1, 1024, 1024, 128, 44, 4, e, lds); } break;
    case 1: { EpiResid e{layer == 0 ? p.in[I_X] : p.out, p.out, 0.5f}; gemm_phase((const bf16_t*)(p.ws + OFF_FFH), DFF, wl + OW_DN1, DFF, DFF, 128, 8, 4, e, lds, true); } break;
    case 2: rms_phase(p.out, p.in[I_MIXN] + layer * 1024, hn); break;
    case 3: { EpiWin e{p.ws}; gemm_phase(hn, 1024, wl + OW_INM, 1024, 1024, 128, 25, 5, e, lds); } break;
    case 4: {
      { EpiGelu e{(bf16_t*)(p.ws + OFF_H1K), (const float*)(p.ws + OFF_MISC + 256) + (layer * 2 + 0) * 256}; gemm_phase((const bf16_t*)(p.ws + OFF_KCMP), 1024, wl + OW_PK1, 2048, 2048, 16, 2, 2, e, lds); }
      { EpiGelu e{(bf16_t*)(p.ws + OFF_H1V), (const float*)(p.ws + OFF_MISC + 256) + (layer * 2 + 1) * 256}; gemm_phase((const bf16_t*)(p.ws + OFF_VCMP), 1024, wl + OW_PV1, 2048, 2048, 16, 2, 2, e, lds); }
      kmean_phase(p);
      filler_items(p, layer, lds, 0);
    } break;
    case 5: {
      { EpiCmpOut<0> e{(bf16_t*)(p.ws + OFF_KC)}; gemm_phase((const bf16_t*)(p.ws + OFF_H1K), 256, wl + OW_PK2, 256, 256, 16, 1, 1, e, lds); }
      { EpiCmpOut<1> e{(bf16_t*)(p.ws + OFF_VCT)}; gemm_phase((const bf16_t*)(p.ws + OFF_H1V), 256, wl + OW_PV2, 256, 256, 16, 1, 1, e, lds); }
      filler_items(p, layer, lds, 1);
    } break;
    case 6: phaseX(p, layer, lds, rep); break;
    case 7: phaseY(p, layer, lds, rep); break;
    case 8: merge_phase(p, layer, lds); break;
    case 9: { EpiResid e{p.out, p.out, 1.0f}; gemm_phase((const bf16_t*)(p.ws + OFF_MERGED), 1024, wl + OW_WO, 1024, 1024, 128, 8, 4, e, lds); } break;
    case 10: rms_phase(p.out, p.in[I_F2N] + layer * 1024, hn); break;
    case 11: { EpiSwiglu e{(bf16_t*)(p.ws + OFF_FFH)}; gemm_phase(hn, 1024, wl + OW_GU2, 1024, 1024, 128, 44, 4, e, lds); } break;
    case 12: { EpiResid e{p.out, p.out, 0.5f}; gemm_phase((const bf16_t*)(p.ws + OFF_FFH), DFF, wl + OW_DN2, DFF, DFF, 128, 8, 4, e, lds, true); } break;
    default: if (layer == 0) rms_phase(p.out, p.in[I_F1N] + 1024, hn); break;
  }
}


DI void grid_barrier(unsigned* ctr, unsigned target) {
  __syncthreads();
  if (threadIdx.x == 0) {
    __threadfence();
    __hip_atomic_fetch_add(ctr, 1u, __ATOMIC_RELAXED, __HIP_MEMORY_SCOPE_AGENT);
    unsigned spins = 0;
    while (__hip_atomic_load(ctr, __ATOMIC_RELAXED, __HIP_MEMORY_SCOPE_AGENT) < target && spins < (1u << 26)) { __builtin_amdgcn_s_sleep(2); ++spins; }
    __threadfence();
  }
  __syncthreads();
}
#if MEGA
__global__ void __launch_bounds__(NTHREADS) mega_kernel(Params p) {
  extern __shared__ __attribute__((aligned(16))) char lds[];
  cg::grid_group grid = cg::this_grid();
  unsigned bar_gen = 0;
  for (int ph = 0; ph < NPHASE; ++ph) {
#ifdef REPQ
    const int nrep = (REPQ >= 100) ? ((ph == REPQ - 100) ? 2 : 1) : ((ph > 0 && ph < NPHASE - 1 && (ph - 1) % 14 == REPQ) ? 2 : 1);
#else
    const int nrep = 1;
#endif
    if (ph == NPHASE - 2) continue;
    for (int rep = 0; rep < nrep; ++rep) {
      run_phase(p, ph, lds, rep);
      if (ph + 1 < NPHASE) {
        if (ph == 0) grid.sync();
        else { ++bar_gen; grid_barrier((unsigned*)(p.ws + OFF_MISC + 6144), bar_gen * gridDim.x); }
      }
    }
  }
}
#else
__global__ void __launch_bounds__(NTHREADS) phase_kernel(Params p, int ph) {
  extern __shared__ __attribute__((aligned(16))) char lds[];
  run_phase(p, ph, lds);
}
#endif

extern "C" void kernel_launch(void* const* d_in, const int* in_sizes, int n_in, void* d_out, int out_size, void* d_ws, size_t ws_size, hipStream_t stream) {
  Params p;
  memset(&p, 0, sizeof(p));
  for (int i = 0; i < 23; ++i) p.in[i] = (const float*)d_in[i];
  p.out = (float*)d_out;
  p.ws = (char*)d_ws;
  if (ws_size < OFF_END) fprintf(stderr, "workspace too small: %zu < %zu\n", ws_size, (size_t)OFF_END);
  static int grid_blocks = 0;
  if (!grid_blocks) {
    int dev = 0, cus = 0, per_cu = 0;
    (void)hipGetDevice(&dev);
    (void)hipDeviceGetAttribute(&cus, hipDeviceAttributeMultiprocessorCount, dev);
#if MEGA
    if (hipFuncSetAttribute((const void*)mega_kernel, hipFuncAttributeMaxDynamicSharedMemorySize, LDS_BYTES) != hipSuccess) fprintf(stderr, "hipFuncSetAttribute failed\n");
    (void)hipOccupancyMaxActiveBlocksPerMultiprocessor(&per_cu, mega_kernel, NTHREADS, LDS_BYTES);
#else
    per_cu = 1;
#endif
    if (per_cu < 1) per_cu = 1;
    if (per_cu > 2) per_cu = 2;
    grid_blocks = cus * per_cu;
  }
#if MEGA
  void* args[] = {&p};
  hipError_t e = hipLaunchCooperativeKernel((void*)mega_kernel, dim3(grid_blocks), dim3(NTHREADS), args, LDS_BYTES, stream);
  if (e != hipSuccess) fprintf(stderr, "cooperative launch failed: %s (grid %d)\n", hipGetErrorString(e), grid_blocks);
#else
  for (int ph = 0; ph < NPHASE; ++ph) phase_kernel<<<grid_blocks, NTHREADS, LDS_BYTES, stream>>>(p, ph);
#endif
}
```

```cpp
#include <hip/hip_runtime.h>
#include <hip/hip_cooperative_groups.h>
#include <stdint.h>
#include <stdio.h>
#include <string.h>
namespace cg = cooperative_groups;

#ifndef MEGA
#define MEGA 1
#endif

typedef unsigned short bf16_t;
typedef short bf16x8 __attribute__((ext_vector_type(8)));
typedef short s16x4 __attribute__((ext_vector_type(4)));
typedef float f32x16 __attribute__((ext_vector_type(16)));
typedef float f32x4 __attribute__((ext_vector_type(4)));
typedef unsigned u32x4 __attribute__((ext_vector_type(4)));
typedef unsigned u32x2 __attribute__((ext_vector_type(2)));

#define DI __device__ __forceinline__
#define MFMA32(a, b, c) __builtin_amdgcn_mfma_f32_32x32x16_bf16((a), (b), (c), 0, 0, 0)
#define NEGINF (-__builtin_inff())

constexpr int NB = 8, SEQ = 4096, DM = 1024, NT = NB * SEQ, DFF = 2816;
constexpr int NTHREADS = 512;

constexpr size_t W_GU = 5632ull * 1024, W_DN = 1024ull * 2816, W_INM = 3200ull * 1024, W_ING = 3072ull * 1024,
                 W_P1 = 256ull * 2048, W_P2 = 128ull * 256, W_UA = 1024ull * 384, W_UB = 1024ull * 256, W_UC = 1024ull * 128, W_WO = 1024ull * 1024;
constexpr size_t OW_GU1 = 0, OW_DN1 = OW_GU1 + W_GU, OW_GU2 = OW_DN1 + W_DN, OW_DN2 = OW_GU2 + W_GU, OW_INM = OW_DN2 + W_DN,
                 OW_ING = OW_INM + W_INM, OW_PK1 = OW_ING + W_ING, OW_PV1 = OW_PK1 + W_P1, OW_PK2 = OW_PV1 + W_P1, OW_PV2 = OW_PK2 + W_P2,
                 OW_UA = OW_PV2 + W_P2, OW_UB = OW_UA + W_UA, OW_UC = OW_UB + W_UB, OW_WO = OW_UC + W_UC, W_LAYER = OW_WO + W_WO;
constexpr size_t OFF_W = 0;
constexpr size_t OFF_MISC = OFF_W + 2 * W_LAYER * 2;
constexpr size_t OFF_HN = OFF_MISC + 8192;
constexpr size_t OFF_C = OFF_HN + (size_t)NT * DM * 2;
constexpr size_t OFF_FFH = OFF_C;
constexpr size_t OFF_QN = OFF_C;
constexpr size_t OFF_QM = OFF_QN + (size_t)NT * 384 * 2;
constexpr size_t OFF_QD = OFF_QM + (size_t)NT * 256 * 2;
constexpr size_t OFF_MERGED = OFF_C;
constexpr size_t SZ_G2 = 16ull * 4096 * 64 * 2;
constexpr size_t OFF_KCMP = OFF_QD + (size_t)NT * 384 * 2;
constexpr size_t OFF_VCMP = OFF_KCMP + SZ_G2 + 4096;
constexpr size_t OFF_KSEL = OFF_VCMP + SZ_G2 + 4096;
constexpr size_t OFF_VSELT = OFF_KSEL + SZ_G2;
constexpr size_t OFF_KWIN = OFF_VSELT + SZ_G2;
constexpr size_t OFF_VWINT = OFF_KWIN + SZ_G2;
constexpr size_t OFF_KM = OFF_VWINT + SZ_G2;
constexpr size_t OFF_VMT = OFF_KM + 2 * SZ_G2;
constexpr size_t OFF_KD = OFF_VMT + 2 * SZ_G2;
constexpr size_t OFF_VDT = OFF_KD + 3 * SZ_G2;
constexpr size_t OFF_GATES = OFF_VDT + 3 * SZ_G2;
constexpr size_t OFF_H1K = OFF_GATES + (size_t)NT * 18 * 4;
constexpr size_t OFF_H1V = OFF_H1K + 4096ull * 256 * 2;
constexpr size_t OFF_KC = OFF_H1V + 4096ull * 256 * 2;
constexpr size_t OFF_VCT = OFF_KC + 16ull * 256 * 64 * 2;
constexpr size_t OFF_KMEAN = OFF_VCT + 16ull * 256 * 64 * 2;
constexpr size_t OFF_SELM = OFF_KMEAN + 32ull * 16 * 64 * 2;
constexpr size_t OFF_OC = OFF_SELM + 16ull * 4096 * 8;
constexpr size_t OFF_Y = OFF_OC + (size_t)NT * 384 * 2;
constexpr size_t OFF_END = OFF_Y + (size_t)NT * 768 * 2;
static_assert(OFF_FFH + (size_t)NT * DFF * 2 <= OFF_END, "ffh fits");

struct Params {
  const float* in[23];
  float* out;
  char* ws;
};

enum { I_X = 0, I_RELB, I_F1N, I_F1G, I_F1U, I_F1D, I_MIXN, I_WIN, I_PEK, I_PEV, I_PK1, I_PK2, I_PV1, I_PV2, I_UA, I_UB, I_UC, I_WO, I_F2N, I_F2G, I_F2U, I_F2D, I_FINN };

DI int get_tid_() { int t = threadIdx.x; asm volatile("" : "+v"(t)); return t; }
#define TIDX get_tid_()
DI float shx32(float v) { const auto r = __builtin_amdgcn_permlane32_swap(__float_as_uint(v), __float_as_uint(v), false, false); return __uint_as_float((threadIdx.x & 32) ? r[0] : r[1]); }
DI int shx32i(int v) { const auto r = __builtin_amdgcn_permlane32_swap((unsigned)v, (unsigned)v, false, false); return (int)((threadIdx.x & 32) ? r[0] : r[1]); }
DI float ex2(float x) { return __builtin_amdgcn_exp2f(x); }
DI size_t kfrag_idx(int pos, int d) { return ((size_t)((pos >> 5) * 4 + (d >> 4)) * 64 + ((d >> 3) & 1) * 32 + (pos & 31)) * 8 + (d & 7); }
DI size_t vfrag_idx(int pos, int d) { return ((size_t)((pos >> 5) * 8 + ((pos >> 4) & 1) * 4 + (d >> 5) * 2 + ((pos >> 3) & 1)) * 64 + ((pos >> 2) & 1) * 32 + (d & 31)) * 4 + (pos & 3); }
DI bf16_t f2bf(float x) { unsigned r; asm("v_cvt_pk_bf16_f32 %0, %1, %1" : "=v"(r) : "v"(x)); return (bf16_t)(r & 0xffffu); }
DI float bf2f(bf16_t b) { return __uint_as_float(((unsigned)b) << 16); }
DI unsigned pack2(float a, float b) { unsigned r; asm("v_cvt_pk_bf16_f32 %0, %1, %2" : "=v"(r) : "v"(a), "v"(b)); return r; }
DI int crow(int i, int h) { return (i & 3) + 8 * (i >> 2) + 4 * h; }
DI float sigmoidf_(float x) { return 1.f / (1.f + __expf(-x)); }

DI int lds_off(int row, int chunk) { return row * 128 + ((chunk ^ ((row >> 1) & 7)) << 4); }

#define LAS __attribute__((address_space(3)))
constexpr int NSTAGE = 3;
constexpr int STAGE_B = 49152;
constexpr int LDS_BYTES = NSTAGE * STAGE_B;
DI void glds16(const void* g, char* l) { __builtin_amdgcn_global_load_lds((const unsigned*)g, (LAS unsigned*)l, 16, 0, 0); }

template <int PART = 0>
DI void gemm_core(const bf16_t* __restrict__ A, int lda, const bf16_t* __restrict__ Bt, int ldb, int K,
                  f32x16 (&acc)[2][2], char* lds) {
  const int tid = TIDX, lane = tid & 63, wid = tid >> 6, wr = wid >> 1, wc = wid & 1, r = lane & 31, h = lane >> 5;
  const int ch = (tid & 7) ^ ((tid >> 4) & 7);
  unsigned avo[4], bvo[2];
#pragma unroll
  for (int i = 0; i < 4; ++i) avo[i] = (unsigned)(((tid >> 3) + 64 * i) * lda * 2 + ch * 16);
#pragma unroll
  for (int i = 0; i < 2; ++i) bvo[i] = (unsigned)(((tid >> 3) + 64 * i) * ldb * 2 + ch * 16);
  const char* Ab = (const char*)A; const char* Bb = (const char*)Bt;
  char* lw = lds + tid * 16;
  const int nk = K >> 6;
  const unsigned swz = (unsigned)((r >> 1) & 7);
  const unsigned arow_u = (unsigned)((wr * 64 + r) * 128), brow_u = (unsigned)((wc * 64 + r) * 128);
  const unsigned co0 = ((0u + h) ^ swz) << 4, co1 = ((2u + h) ^ swz) << 4, co2 = ((4u + h) ^ swz) << 4, co3 = ((6u + h) ^ swz) << 4;
#define GEMM_ISSUE(kt_, st_) do { char* sb_ = lw + (st_) * STAGE_B; const char* ak_ = Ab + (size_t)(kt_) * 128; const char* bk_ = Bb + (size_t)(kt_) * 128; \
    _Pragma("unroll") for (int i_ = 0; i_ < 4; ++i_) glds16(ak_ + avo[i_], sb_ + i_ * 8192); \
    _Pragma("unroll") for (int i_ = 0; i_ < 2; ++i_) glds16(bk_ + bvo[i_], sb_ + 32768 + i_ * 8192); } while (0)
  if (PART != 2) {
    GEMM_ISSUE(0, 0);
    if (nk > 1) GEMM_ISSUE(1, 1);
  }
  if (PART == 1) return;
  int st = 0;
  for (int kt = 0; kt < nk; ++kt) {
    if (kt + 1 < nk) asm volatile("s_waitcnt vmcnt(6)" ::: "memory");
    else asm volatile("s_waitcnt vmcnt(0)" ::: "memory");
    __builtin_amdgcn_s_barrier();
    asm volatile("" ::: "memory");
    if (kt + 2 < nk) { const int st2 = (st >= 1) ? st - 1 : 2; GEMM_ISSUE(kt + 2, st2); }
    const char* la = lds + st * STAGE_B;
    const char* lb = la + 32768;
    const unsigned sa_u = (unsigned)(size_t)la + arow_u, sb_u = (unsigned)(size_t)lb + brow_u;
    const unsigned a0 = sa_u + co0, a1 = sa_u + co1, a2 = sa_u + co2, a3 = sa_u + co3;
    const unsigned b0 = sb_u + co0, b1 = sb_u + co1, b2 = sb_u + co2, b3 = sb_u + co3;
    {
      bf16x8 p0, p1, q0, q1, u0, u1, w0, w1;
      asm volatile(
        "ds_read_b128 %4, %12\n\tds_read_b128 %5, %12 offset:4096\n\tds_read_b128 %6, %16\n\tds_read_b128 %7, %16 offset:4096\n\t"
        "ds_read_b128 %8, %13\n\tds_read_b128 %9, %13 offset:4096\n\tds_read_b128 %10, %17\n\tds_read_b128 %11, %17 offset:4096\n\t"
        "s_waitcnt lgkmcnt(4)\n\t"
        "v_mfma_f32_32x32x16_bf16 %0, %4, %6, %0\n\tv_mfma_f32_32x32x16_bf16 %1, %4, %7, %1\n\tv_mfma_f32_32x32x16_bf16 %2, %5, %6, %2\n\tv_mfma_f32_32x32x16_bf16 %3, %5, %7, %3\n\t"
        "ds_read_b128 %4, %14\n\tds_read_b128 %5, %14 offset:4096\n\tds_read_b128 %6, %18\n\tds_read_b128 %7, %18 offset:4096\n\t"
        "s_waitcnt lgkmcnt(4)\n\t"
        "v_mfma_f32_32x32x16_bf16 %0, %8, %10, %0\n\tv_mfma_f32_32x32x16_bf16 %1, %8, %11, %1\n\tv_mfma_f32_32x32x16_bf16 %2, %9, %10, %2\n\tv_mfma_f32_32x32x16_bf16 %3, %9, %11, %3\n\t"
        "ds_read_b128 %8, %15\n\tds_read_b128 %9, %15 offset:4096\n\tds_read_b128 %10, %19\n\tds_read_b128 %11, %19 offset:4096\n\t"
        "s_waitcnt lgkmcnt(4)\n\t"
        "v_mfma_f32_32x32x16_bf16 %0, %4, %6, %0\n\tv_mfma_f32_32x32x16_bf16 %1, %4, %7, %1\n\tv_mfma_f32_32x32x16_bf16 %2, %5, %6, %2\n\tv_mfma_f32_32x32x16_bf16 %3, %5, %7, %3\n\t"
        "s_waitcnt lgkmcnt(0)\n\t"
        "v_mfma_f32_32x32x16_bf16 %0, %8, %10, %0\n\tv_mfma_f32_32x32x16_bf16 %1, %8, %11, %1\n\tv_mfma_f32_32x32x16_bf16 %2, %9, %10, %2\n\tv_mfma_f32_32x32x16_bf16 %3, %9, %11, %3"
        : "+v"(acc[0][0]), "+v"(acc[0][1]), "+v"(acc[1][0]), "+v"(acc[1][1]),
          "=&v"(p0), "=&v"(p1), "=&v"(q0), "=&v"(q1), "=&v"(u0), "=&v"(u1), "=&v"(w0), "=&v"(w1)
        : "v"(a0), "v"(a1), "v"(a2), "v"(a3), "v"(b0), "v"(b1), "v"(b2), "v"(b3));
    }
    st = (st == 2) ? 0 : st + 1;
  }
  asm volatile("s_nop 15\n\ts_nop 15\n\ts_nop 7" ::: "memory");
  __builtin_amdgcn_s_barrier();
  asm volatile("" ::: "memory");
}

DI void zero_acc(f32x16 (&acc)[2][2]) {
#pragma unroll
  for (int a = 0; a < 2; ++a)
#pragma unroll
    for (int b = 0; b < 2; ++b)
#pragma unroll
      for (int i = 0; i < 16; ++i) acc[a][b][i] = 0.f;
}

DI bool tile_map(int L, int MT, int NTl, int SN, int& mt, int& nt) {
  const int xcd = L & 7, ix = L >> 3, per = 8 * SN, st = ix / per, w = ix % per;
  const int gst = st * 8 + xcd, SNT = NTl / SN, total = (MT >> 3) * SNT;
  if (gst >= total) return false;
  const int smt = gst / SNT, snt = gst % SNT;
  mt = smt * 8 + (w & 7); nt = snt * SN + (w >> 3);
  return true;
}
DI int tile_lmax(int MT, int NTl, int SN) { const int total = (MT >> 3) * (NTl / SN); return ((total + 7) >> 3) * 8 * SN * 8; }

struct EpiSwiglu {
  static constexpr bool PRE = false;
  bf16_t* ffh;
  DI void operator()(const f32x16 (&acc)[2][2], int m0, int n0) const {
    const int tid = TIDX, lane = tid & 63, wid = tid >> 6, wr = wid >> 1, wc = wid & 1, r = lane & 31, h = lane >> 5;
    const int hid = (n0 >> 7) * 64 + wc * 32 + r;
#pragma unroll
    for (int mi = 0; mi < 2; ++mi)
#pragma unroll
      for (int i = 0; i < 16; ++i) {
        const int row = m0 + wr * 64 + mi * 32 + crow(i, h);
        const float g = acc[mi][0][i], u = acc[mi][1][i];
        ffh[(size_t)row * DFF + hid] = f2bf(g * sigmoidf_(g) * u);
      }
  }
};
struct EpiResid {
  const float* res; float* out; float scale;
  static constexpr bool PRE = true;
  DI void pre(float (&rv)[2][2][16], int m0, int n0) const {
    const int tid = TIDX, lane = tid & 63, wid = tid >> 6, wr = wid >> 1, wc = wid & 1, r = lane & 31, h = lane >> 5;
#pragma unroll
    for (int mi = 0; mi < 2; ++mi)
#pragma unroll
      for (int ni = 0; ni < 2; ++ni)
#pragma unroll
        for (int i = 0; i < 16; ++i)
          rv[mi][ni][i] = res[(size_t)(m0 + wr * 64 + mi * 32 + crow(i, h)) * DM + n0 + wc * 64 + ni * 32 + r];
  }
  DI void operator()(const f32x16 (&acc)[2][2], int m0, int n0, const float (&rv)[2][2][16]) const {
    const int tid = TIDX, lane = tid & 63, wid = tid >> 6, wr = wid >> 1, wc = wid & 1, r = lane & 31, h = lane >> 5;
#pragma unroll
    for (int mi = 0; mi < 2; ++mi)
#pragma unroll
      for (int ni = 0; ni < 2; ++ni)
#pragma unroll
        for (int i = 0; i < 16; ++i)
          out[(size_t)(m0 + wr * 64 + mi * 32 + crow(i, h)) * DM + n0 + wc * 64 + ni * 32 + r] = rv[mi][ni][i] + scale * acc[mi][ni][i];
  }
};
struct EpiGelu {
  static constexpr bool PRE = false;
  bf16_t* o; const float* bias;
  DI void operator()(const f32x16 (&acc)[2][2], int m0, int n0) const {
    const int tid = TIDX, lane = tid & 63, wid = tid >> 6, wr = wid >> 1, wc = wid & 1, r = lane & 31, h = lane >> 5;
#pragma unroll
    for (int mi = 0; mi < 2; ++mi)
#pragma unroll
      for (int ni = 0; ni < 2; ++ni) {
        const int col = n0 + wc * 64 + ni * 32 + r;
        const float bv = bias[col];
#pragma unroll
        for (int i = 0; i < 16; ++i) {
          const int row = m0 + wr * 64 + mi * 32 + crow(i, h);
          const float x = acc[mi][ni][i] + bv;
          o[(size_t)row * 256 + col] = f2bf(x * sigmoidf_(1.5957691216057308f * (x + 0.044715f * x * x * x)));
        }
      }
  }
};
template <int transposed> struct EpiCmpOut {
  static constexpr bool PRE = false;
  bf16_t* o;
  DI void operator()(const f32x16 (&acc)[2][2], int m0, int n0) const {
    const int tid = TIDX, lane = tid & 63, wid = tid >> 6, wr = wid >> 1, wc = wid & 1, r = lane & 31, h = lane >> 5;
    if (wc != 0) return;
#pragma unroll
    for (int mi = 0; mi < 2; ++mi)
#pragma unroll
      for (int ni = 0; ni < 2; ++ni) {
        const int col = ni * 32 + r;
#pragma unroll
        for (int i = 0; i < 16; ++i) {
          const int row = m0 + wr * 64 + mi * 32 + crow(i, h);
          const bf16_t v = f2bf(acc[mi][ni][i]);
          if (transposed) o[(size_t)(row >> 8) * 16384 + vfrag_idx(row & 255, col)] = v;
          else o[(size_t)(row >> 8) * 16384 + kfrag_idx(row & 255, col)] = v;
        }
      }
  }
};
struct EpiWin {
  static constexpr bool PRE = false;
  char* ws;
  DI void operator()(const f32x16 (&acc)[2][2], int m0, int n0) const {
    const int tid = TIDX, lane = tid & 63, wid = tid >> 6, wr = wid >> 1, wc = wid & 1, r = lane & 31, h = lane >> 5;
    const int cidx = (n0 >> 6) + wc;
    if (cidx >= 49) return;
    const int rowbase = m0 + wr * 64;
    const int b = rowbase >> 12;
    int kind;
    bf16_t* base; int ld = 0, colb = 0, hb = 0, dil = 1; bool kfrag = false;
    if (cidx < 6) { kind = 0; base = (bf16_t*)(ws + OFF_QN); ld = 384; colb = cidx * 64; }
    else if (cidx < 18) { const int t = (cidx - 6) >> 1, g = (cidx - 6) & 1; hb = b * 2 + g;
      const size_t off = (t == 0) ? OFF_KCMP : (t == 1) ? OFF_VCMP : (t == 2) ? OFF_KSEL : (t == 3) ? OFF_VSELT : (t == 4) ? OFF_KWIN : OFF_VWINT;
      base = (bf16_t*)(ws + off); kind = (t == 3 || t == 5) ? 2 : 1; kfrag = (t == 2 || t == 4); }
    else if (cidx < 22) { kind = 0; base = (bf16_t*)(ws + OFF_QM); ld = 256; colb = (cidx - 18) * 64; }
    else if (cidx < 26) { kind = 1; kfrag = true; base = (bf16_t*)(ws + OFF_KM); hb = b * 4 + (cidx - 22); }
    else if (cidx < 30) { kind = 2; base = (bf16_t*)(ws + OFF_VMT); hb = b * 4 + (cidx - 26); }
    else if (cidx < 36) { kind = 0; base = (bf16_t*)(ws + OFF_QD); ld = 384; colb = (cidx - 30) * 64; }
    else if (cidx < 42) { kind = 1; kfrag = true; base = (bf16_t*)(ws + OFF_KD); hb = b * 6 + (cidx - 36); const int g = (cidx - 36) >> 1; dil = (g == 0) ? 1 : (g == 1 ? 4 : 16); }
    else if (cidx < 48) { kind = 2; base = (bf16_t*)(ws + OFF_VDT); hb = b * 6 + (cidx - 42); const int g = (cidx - 42) >> 1; dil = (g == 0) ? 1 : (g == 1 ? 4 : 16); }
    else { kind = 3; base = nullptr; }
    if (kind == 0) {
#pragma unroll
      for (int mi = 0; mi < 2; ++mi)
#pragma unroll
        for (int ni = 0; ni < 2; ++ni)
#pragma unroll
          for (int i = 0; i < 16; ++i) {
            const int row = rowbase + mi * 32 + crow(i, h);
            base[(size_t)row * ld + colb + ni * 32 + r] = f2bf(acc[mi][ni][i] * 0.18033688011112042f);
          }
    } else if (kind == 1) {
#pragma unroll
      for (int mi = 0; mi < 2; ++mi)
#pragma unroll
        for (int ni = 0; ni < 2; ++ni)
#pragma unroll
          for (int i = 0; i < 16; ++i) {
            const int s = (rowbase & 4095) + mi * 32 + crow(i, h);
            if (kfrag) { const int pos = (dil == 1) ? s : (s % dil) * (4096 / dil) + s / dil; base[(size_t)hb * 262144 + kfrag_idx(pos, ni * 32 + r)] = f2bf(acc[mi][ni][i]); }
            else base[((size_t)hb * 4096 + s) * 64 + ni * 32 + r] = f2bf(acc[mi][ni][i]);
          }
    } else if (kind == 2) {
      if (dil == 1) {
#pragma unroll
        for (int mi = 0; mi < 2; ++mi)
#pragma unroll
          for (int ni = 0; ni < 2; ++ni)
#pragma unroll
            for (int q = 0; q < 4; ++q) {
              const int s = (rowbase & 4095) + mi * 32 + 8 * q + 4 * h;
              u32x2 v; v.x = pack2(acc[mi][ni][4 * q], acc[mi][ni][4 * q + 1]); v.y = pack2(acc[mi][ni][4 * q + 2], acc[mi][ni][4 * q + 3]);
              *(u32x2*)(base + (size_t)hb * 262144 + vfrag_idx(s, ni * 32 + r)) = v;
            }
      } else {
        const int L = 4096 / dil;
#pragma unroll
        for (int mi = 0; mi < 2; ++mi)
#pragma unroll
          for (int ni = 0; ni < 2; ++ni)
#pragma unroll
            for (int i = 0; i < 16; ++i) {
              const int s = (rowbase & 4095) + mi * 32 + crow(i, h);
              const int pos = (s % dil) * L + s / dil;
              base[(size_t)hb * 262144 + vfrag_idx(pos, ni * 32 + r)] = f2bf(acc[mi][ni][i]);
            }
      }
    } else {
      float* gt = (float*)(ws + OFF_GATES);
      if (r < 18) {
#pragma unroll
        for (int mi = 0; mi < 2; ++mi)
#pragma unroll
          for (int i = 0; i < 16; ++i) {
            const int row = rowbase + mi * 32 + crow(i, h);
            gt[(size_t)row * 18 + r] = sigmoidf_(acc[mi][0][i]);
          }
      }
    }
  }
};

template <class Epi>
DI void gemm_phase(const bf16_t* A, int lda, const bf16_t* Bt, int ldb, int K, int MT, int NTl, int SN, const Epi& epi, char* lds, bool rev = false) {
  const int lmax = tile_lmax(MT, NTl, SN);
  int L = blockIdx.x, mt = 0, nt = 0;
  bool have = false;
  for (; L < lmax; L += gridDim.x) if (tile_map(L, MT, NTl, SN, mt, nt)) { have = true; if (rev) mt = MT - 1 - mt; break; }
  f32x16 dummy[2][2];
  if (have) gemm_core<1>(A + (size_t)mt * 256 * lda, lda, Bt + (size_t)nt * 128 * ldb, ldb, K, dummy, lds);
  while (have) {
    f32x16 acc[2][2];
    zero_acc(acc);
    const int cmt = mt, cnt = nt;
    float rv[Epi::PRE ? 2 : 1][2][16];
    if constexpr (Epi::PRE) epi.pre(rv, cmt * 256, cnt * 128);
    gemm_core<2>(A + (size_t)cmt * 256 * lda, lda, Bt + (size_t)cnt * 128 * ldb, ldb, K, acc, lds);
    have = false;
    for (L += gridDim.x; L < lmax; L += gridDim.x) if (tile_map(L, MT, NTl, SN, mt, nt)) { have = true; if (rev) mt = MT - 1 - mt; break; }
    if (have) gemm_core<1>(A + (size_t)mt * 256 * lda, lda, Bt + (size_t)nt * 128 * ldb, ldb, K, dummy, lds);
    if constexpr (Epi::PRE) epi(acc, cmt * 256, cnt * 128, rv); else epi(acc, cmt * 256, cnt * 128);
  }
}

struct ConvD { const float* src; const float* src2; bf16_t* dst; int K, Nsrc, Nout, mode, coloff, nvalid; };
constexpr int CONV_NT[14] = {1408, 704, 1408, 704, 800, 768, 128, 128, 8, 8, 96, 64, 32, 256};
constexpr int CONV_PER_LAYER = 6512;

DI ConvD get_conv(const Params& p, int l, int id) {
  ConvD c; c.src2 = nullptr; c.mode = 0; c.coloff = 0;
  bf16_t* wl = (bf16_t*)(p.ws + OFF_W) + (size_t)l * W_LAYER;
  switch (id) {
    case 0: c.src = p.in[I_F1G] + (size_t)l * 1024 * DFF; c.src2 = p.in[I_F1U] + (size_t)l * 1024 * DFF; c.dst = wl + OW_GU1; c.K = 1024; c.Nsrc = DFF; c.Nout = 5632; c.mode = 1; c.nvalid = 5632; break;
    case 1: c.src = p.in[I_F1D] + (size_t)l * DFF * 1024; c.dst = wl + OW_DN1; c.K = DFF; c.Nsrc = 1024; c.Nout = 1024; c.nvalid = 1024; break;
    case 2: c.src = p.in[I_F2G] + (size_t)l * 1024 * DFF; c.src2 = p.in[I_F2U] + (size_t)l * 1024 * DFF; c.dst = wl + OW_GU2; c.K = 1024; c.Nsrc = DFF; c.Nout = 5632; c.mode = 1; c.nvalid = 5632; break;
    case 3: c.src = p.in[I_F2D] + (size_t)l * DFF * 1024; c.dst = wl + OW_DN2; c.K = DFF; c.Nsrc = 1024; c.Nout = 1024; c.nvalid = 1024; break;
    case 4: c.src = p.in[I_WIN] + (size_t)l * 1024 * 6162; c.dst = wl + OW_INM; c.K = 1024; c.Nsrc = 6162; c.Nout = 3200; c.mode = 2; c.nvalid = 3090; break;
    case 5: c.src = p.in[I_WIN] + (size_t)l * 1024 * 6162; c.dst = wl + OW_ING; c.K = 1024; c.Nsrc = 6162; c.Nout = 3072; c.coloff = 3090; c.nvalid = 3072; break;
    case 6: c.src = p.in[I_PK1] + (size_t)l * 2048 * 256; c.dst = wl + OW_PK1; c.K = 2048; c.Nsrc = 256; c.Nout = 256; c.nvalid = 256; break;
    case 7: c.src = p.in[I_PV1] + (size_t)l * 2048 * 256; c.dst = wl + OW_PV1; c.K = 2048; c.Nsrc = 256; c.Nout = 256; c.nvalid = 256; break;
    case 8: c.src = p.in[I_PK2] + (size_t)l * 256 * 64; c.dst = wl + OW_PK2; c.K = 256; c.Nsrc = 64; c.Nout = 128; c.nvalid = 64; break;
    case 9: c.src = p.in[I_PV2] + (size_t)l * 256 * 64; c.dst = wl + OW_PV2; c.K = 256; c.Nsrc = 64; c.Nout = 128; c.nvalid = 64; break;
    case 10: c.src = p.in[I_UA] + (size_t)l * 384 * 1024; c.dst = wl + OW_UA; c.K = 384; c.Nsrc = 1024; c.Nout = 1024; c.nvalid = 1024; break;
    case 11: c.src = p.in[I_UB] + (size_t)l * 256 * 1024; c.dst = wl + OW_UB; c.K = 256; c.Nsrc = 1024; c.Nout = 1024; c.nvalid = 1024; break;
    case 12: c.src = p.in[I_UC] + (size_t)l * 128 * 1024; c.dst = wl + OW_UC; c.K = 128; c.Nsrc = 1024; c.Nout = 1024; c.nvalid = 1024; break;
    default: c.src = p.in[I_WO] + (size_t)l * 1024 * 1024; c.dst = wl + OW_WO; c.K = 1024; c.Nsrc = 1024; c.Nout = 1024; c.nvalid = 1024; break;
  }
  return c;
}

DI void conv_tile(const ConvD& c, int tn, int tk, float* lds) {
  const int tid = TIDX;
  const int n0 = tn * 64, k0 = tk * 64;
  {
    const int j = tid & 63, np = n0 + j;
    const float* sp = c.src; int col = -1;
    if (c.mode == 0) { if (np < c.nvalid) col = c.coloff + np; }
    else if (c.mode == 1) { const int tile = np >> 7, within = np & 127, wc = within >> 6, part = (within & 63) >> 5, jj = within & 31;
      col = tile * 64 + wc * 32 + jj; if (part) sp = c.src2; }
    else { if (np < 1152) col = np; else if (np < 3072) col = 1170 + (np - 1152); else if (np < 3090) col = 1152 + (np - 3072); }
    float tv[8];
#pragma unroll
    for (int i = 0; i < 8; ++i) {
      const int kk = (tid >> 6) + 8 * i;
      tv[i] = (col >= 0) ? sp[(size_t)(k0 + kk) * c.Nsrc + col] : 0.f;
    }
#pragma unroll
    for (int i = 0; i < 8; ++i) lds[((tid >> 6) + 8 * i) * 65 + j] = tv[i];
  }
  __syncthreads();
  {
    const int kk = tid & 63;
#pragma unroll
    for (int i = 0; i < 8; ++i) {
      const int j = (tid >> 6) + 8 * i;
      c.dst[(size_t)(n0 + j) * c.K + k0 + kk] = f2bf(lds[kk * 65 + j]);
    }
  }
  __syncthreads();
}

DI void rms_phase(const float* x, const float* gain, bf16_t* hn) {
  const int lane = TIDX & 63;
  const int gw = blockIdx.x * 8 + (TIDX >> 6), nw = gridDim.x * 8;
  f32x4 g[4];
#pragma unroll
  for (int i = 0; i < 4; ++i) g[i] = *(const f32x4*)(gain + i * 256 + lane * 4);
  for (int row = gw; row < NT; row += 2 * nw) {
    const int row2 = (row + nw < NT) ? row + nw : row;
    f32x4 v[4], w2[4]; float ss = 0.f, ss2 = 0.f;
#pragma unroll
    for (int i = 0; i < 4; ++i) { v[i] = *(const f32x4*)(x + (size_t)row * DM + i * 256 + lane * 4); w2[i] = *(const f32x4*)(x + (size_t)row2 * DM + i * 256 + lane * 4); }
#pragma unroll
    for (int i = 0; i < 4; ++i) { ss += v[i][0] * v[i][0] + v[i][1] * v[i][1] + v[i][2] * v[i][2] + v[i][3] * v[i][3]; ss2 += w2[i][0] * w2[i][0] + w2[i][1] * w2[i][1] + w2[i][2] * w2[i][2] + w2[i][3] * w2[i][3]; }
#pragma unroll
    for (int o = 32; o >= 1; o >>= 1) { ss += __shfl_xor(ss, o); ss2 += __shfl_xor(ss2, o); }
    const float rs = rsqrtf(ss * (1.f / 1024.f) + 1e-6f), rs2 = rsqrtf(ss2 * (1.f / 1024.f) + 1e-6f);
#pragma unroll
    for (int i = 0; i < 4; ++i) {
      u32x2 w; w.x = pack2(v[i][0] * rs * g[i][0], v[i][1] * rs * g[i][1]); w.y = pack2(v[i][2] * rs * g[i][2], v[i][3] * rs * g[i][3]);
      *(u32x2*)(hn + (size_t)row * DM + i * 256 + lane * 4) = w;
      u32x2 w3; w3.x = pack2(w2[i][0] * rs2 * g[i][0], w2[i][1] * rs2 * g[i][1]); w3.y = pack2(w2[i][2] * rs2 * g[i][2], w2[i][3] * rs2 * g[i][3]);
      *(u32x2*)(hn + (size_t)row2 * DM + i * 256 + lane * 4) = w3;
    }
  }
}
DI void final_norm_phase(float* x, const float* gain) {
  const int lane = TIDX & 63;
  const int gw = blockIdx.x * 8 + (TIDX >> 6), nw = gridDim.x * 8;
  f32x4 g[4];
#pragma unroll
  for (int i = 0; i < 4; ++i) g[i] = *(const f32x4*)(gain + i * 256 + lane * 4);
  for (int row = gw; row < NT; row += nw) {
    f32x4 v[4]; float ss = 0.f;
#pragma unroll
    for (int i = 0; i < 4; ++i) { v[i] = *(const f32x4*)(x + (size_t)row * DM + i * 256 + lane * 4); ss += v[i][0] * v[i][0] + v[i][1] * v[i][1] + v[i][2] * v[i][2] + v[i][3] * v[i][3]; }
#pragma unroll
    for (int o = 32; o >= 1; o >>= 1) ss += __shfl_xor(ss, o);
    const float rs = rsqrtf(ss * (1.f / 1024.f) + 1e-6f);
#pragma unroll
    for (int i = 0; i < 4; ++i) {
      f32x4 w; w[0] = v[i][0] * rs * g[i][0]; w[1] = v[i][1] * rs * g[i][1]; w[2] = v[i][2] * rs * g[i][2]; w[3] = v[i][3] * rs * g[i][3];
      *(f32x4*)(x + (size_t)row * DM + i * 256 + lane * 4) = w;
    }
  }
}

DI void phase0(const Params& p, char* lds) {
  if (blockIdx.x == 0 && TIDX < 64) { ((unsigned*)(p.ws + OFF_MISC))[TIDX] = 0u; ((unsigned*)(p.ws + OFF_MISC + 6144))[TIDX] = 0u; }
  for (int it = blockIdx.x; it < 4; it += gridDim.x) {
    const int l = it >> 1, kv = it & 1;
    const float* pe = p.in[kv ? I_PEV : I_PEK] + (size_t)l * 2048;
    const float* w = p.in[kv ? I_PV1 : I_PK1] + (size_t)l * 2048 * 256;
    const int n = TIDX;
    if (n < 256) {
      float s = 0.f;
      for (int k = 0; k < 2048; ++k) s += pe[k] * w[(size_t)k * 256 + n];
      ((float*)(p.ws + OFF_MISC + 256))[it * 256 + n] = s;
    }
  }
  for (int w = blockIdx.x; w < 2 * CONV_PER_LAYER; w += gridDim.x) {
    const int l = w / CONV_PER_LAYER; int ww = w % CONV_PER_LAYER; int id = 0;
#pragma unroll
    for (int i = 0; i < 14; ++i) { if (id == i && ww >= CONV_NT[i]) { ww -= CONV_NT[i]; id = i + 1; } }
    const ConvD c = get_conv(p, l, id);
    const int ntn = c.Nout >> 6;
    conv_tile(c, ww % ntn, ww / ntn, (float*)lds);
  }
  rms_phase(p.in[I_X], p.in[I_F1N], (bf16_t*)(p.ws + OFF_HN));
}

constexpr int BK_THR[15] = {22, 30, 40, 54, 73, 99, 134, 182, 246, 332, 450, 609, 825, 1117, 1513};
struct AttnSt { float m, l; f32x16 o0, o1; };
DI void attn_init(AttnSt& st) { st.m = NEGINF; st.l = 0.f;
#pragma unroll
  for (int i = 0; i < 16; ++i) { st.o0[i] = 0.f; st.o1[i] = 0.f; } }

DI void load_q(bf16x8 (&qf)[4], const bf16_t* qrow) {
#pragma unroll
  for (int s = 0; s < 4; ++s) qf[s] = *(const bf16x8*)(qrow + 16 * s);
}
DI f32x16 qk_tile(const bf16x8 (&qf)[4], const bf16_t* krow) {
  f32x16 s;
#pragma unroll
  for (int i = 0; i < 16; ++i) s[i] = 0.f;
#pragma unroll
  for (int ss = 0; ss < 4; ++ss) { const bf16x8 kf = *(const bf16x8*)(krow + 512 * ss); s = MFMA32(kf, qf[ss], s); }
  return s;
}
DI void pv_tile(AttnSt& st, const float (&pr)[16], const bf16_t* v0, size_t rowstride) {
#pragma unroll
  for (int s2 = 0; s2 < 2; ++s2) {
    u32x4 pk; pk.x = pack2(pr[8 * s2], pr[8 * s2 + 1]); pk.y = pack2(pr[8 * s2 + 2], pr[8 * s2 + 3]); pk.z = pack2(pr[8 * s2 + 4], pr[8 * s2 + 5]); pk.w = pack2(pr[8 * s2 + 6], pr[8 * s2 + 7]);
    const bf16x8 pb = __builtin_bit_cast(bf16x8, pk);
    {
      const s16x4 lo = *(const s16x4*)(v0 + 256 * (s2 * 4 + 0)), hi = *(const s16x4*)(v0 + 256 * (s2 * 4 + 1));
      const bf16x8 va = __builtin_shufflevector(lo, hi, 0, 1, 2, 3, 4, 5, 6, 7);
      st.o0 = MFMA32(va, pb, st.o0);
    }
    {
      const s16x4 lo = *(const s16x4*)(v0 + 256 * (s2 * 4 + 2)), hi = *(const s16x4*)(v0 + 256 * (s2 * 4 + 3));
      const bf16x8 va = __builtin_shufflevector(lo, hi, 0, 1, 2, 3, 4, 5, 6, 7);
      st.o1 = MFMA32(va, pb, st.o1);
    }
  }
}
DI void softmax_step(AttnSt& st, const float (&lg)[16], const bf16_t* v0, size_t rowstride) {
  float mx = NEGINF;
#pragma unroll
  for (int i = 0; i < 16; ++i) mx = fmaxf(mx, lg[i]);
  mx = fmaxf(mx, shx32(mx));
  if (__ballot(mx > NEGINF) == 0ull) return;
  const float mnew = fmaxf(st.m, mx);
  const float muse = (mnew == NEGINF) ? 0.f : mnew;
  const float alpha = ex2(st.m - muse);
  float pr[16]; float rs = 0.f;
#pragma unroll
  for (int i = 0; i < 16; ++i) { pr[i] = ex2(lg[i] - muse); rs += pr[i]; }
  st.l = st.l * alpha + rs; st.m = mnew;
#pragma unroll
  for (int i = 0; i < 16; ++i) { st.o0[i] *= alpha; st.o1[i] *= alpha; }
  pv_tile(st, pr, v0, rowstride);
}

struct KVT { bf16x8 k[4]; s16x4 v[8]; };
DI void load_kv(KVT& t, const bf16_t* krow, const bf16_t* v0, size_t rowstride) {
#pragma unroll
  for (int ss = 0; ss < 4; ++ss) t.k[ss] = *(const bf16x8*)(krow + 512 * ss);
#pragma unroll
  for (int j = 0; j < 8; ++j) t.v[j] = *(const s16x4*)(v0 + 256 * j);
}
DI void softmax_step_r(AttnSt& st, const float (&lg)[16], const KVT& t) {
  float mx = NEGINF;
#pragma unroll
  for (int i = 0; i < 16; ++i) mx = fmaxf(mx, lg[i]);
  mx = fmaxf(mx, shx32(mx));
  if (__ballot(mx > NEGINF) == 0ull) return;
  const float mnew = fmaxf(st.m, mx);
  const float muse = (mnew == NEGINF) ? 0.f : mnew;
  const float alpha = ex2(st.m - muse);
  float pr[16]; float rs = 0.f;
#pragma unroll
  for (int i = 0; i < 16; ++i) { pr[i] = ex2(lg[i] - muse); rs += pr[i]; }
  st.l = st.l * alpha + rs;
  if (__ballot(mnew != st.m) != 0ull) {
#pragma unroll
    for (int i = 0; i < 16; ++i) { st.o0[i] *= alpha; st.o1[i] *= alpha; }
  }
  st.m = mnew;
#pragma unroll
  for (int s2 = 0; s2 < 2; ++s2) {
    u32x4 pk; pk.x = pack2(pr[8 * s2], pr[8 * s2 + 1]); pk.y = pack2(pr[8 * s2 + 2], pr[8 * s2 + 3]); pk.z = pack2(pr[8 * s2 + 4], pr[8 * s2 + 5]); pk.w = pack2(pr[8 * s2 + 6], pr[8 * s2 + 7]);
    const bf16x8 pb = __builtin_bit_cast(bf16x8, pk);
    const bf16x8 va0 = __builtin_shufflevector(t.v[s2 * 4 + 0], t.v[s2 * 4 + 1], 0, 1, 2, 3, 4, 5, 6, 7);
    st.o0 = MFMA32(va0, pb, st.o0);
    const bf16x8 va1 = __builtin_shufflevector(t.v[s2 * 4 + 2], t.v[s2 * 4 + 3], 0, 1, 2, 3, 4, 5, 6, 7);
    st.o1 = MFMA32(va1, pb, st.o1);
  }
}
template <class KP, class VP, class ACT, class FILL>
DI void attn_loop(AttnSt& st, const bf16x8 (&qf)[4], int k0, int k1, size_t vstride, KP kp, VP vp, ACT act, FILL fill) {
  KVT cur, nxt;
  {
    KVT t0; load_kv(t0, kp(k0), vp(k0), vstride);
#pragma unroll
    for (int i = 0; i < 8; ++i) cur.v[i] = t0.v[i];
#pragma unroll
    for (int i = 0; i < 4; ++i) cur.k[i] = t0.k[i];
  }
  f32x16 s_cur;
  { const float z = 0.f;
#pragma unroll
    for (int i = 0; i < 16; ++i) s_cur[i] = z; }
#pragma unroll
  for (int ss = 0; ss < 4; ++ss) s_cur = MFMA32(cur.k[ss], qf[ss], s_cur);
  {
    const int kn = (k0 < k1) ? k0 + 1 : k1;
    const bf16_t* krow = kp(kn);
#pragma unroll
    for (int ss = 0; ss < 4; ++ss) nxt.k[ss] = *(const bf16x8*)(krow + 512 * ss);
  }
  for (int kt = k0; kt <= k1; ++kt) {
    const int kn = (kt < k1) ? kt + 1 : k1;
    const int kn2 = (kt + 2 <= k1) ? kt + 2 : k1;
    {
      const bf16_t* v0 = vp(kn);
#pragma unroll
      for (int j = 0; j < 8; ++j) nxt.v[j] = *(const s16x4*)(v0 + 256 * j);
    }
    bf16x8 k2[4];
    {
      const bf16_t* krow = kp(kn2);
#pragma unroll
      for (int ss = 0; ss < 4; ++ss) k2[ss] = *(const bf16x8*)(krow + 512 * ss);
    }
    f32x16 s_next;
#pragma unroll
    for (int i = 0; i < 16; ++i) s_next[i] = 0.f;
#pragma unroll
    for (int ss = 0; ss < 4; ++ss) s_next = MFMA32(nxt.k[ss], qf[ss], s_next);
    if (act(kt)) {
      float lg[16];
      fill(kt, s_cur, lg);
      softmax_step_r(st, lg, cur);
    }
    s_cur = s_next;
#pragma unroll
    for (int i = 0; i < 8; ++i) cur.v[i] = nxt.v[i];
#pragma unroll
    for (int ss = 0; ss < 4; ++ss) nxt.k[ss] = k2[ss];
  }
}

DI float lut_bias(const unsigned char* blut, const float* tblh, int dist) {
  const int d = dist < 0 ? 0 : (dist > 2048 ? 2048 : dist);
  return tblh[blut[d]];
}
DI void bias16(const unsigned char* blut, const float* tblh, const int (&dist)[16], float (&bv)[16]) {
  int bk[16];
#pragma unroll
  for (int i = 0; i < 16; ++i) { const int d = dist[i] < 0 ? 0 : (dist[i] > 2048 ? 2048 : dist[i]); bk[i] = blut[d]; }
#pragma unroll
  for (int i = 0; i < 16; ++i) asm volatile("" : "+v"(bk[i]));
#pragma unroll
  for (int i = 0; i < 16; ++i) bv[i] = tblh[bk[i]];
#pragma unroll
  for (int i = 0; i < 16; ++i) asm volatile("" : "+v"(bv[i]));
}
DI void store_o(bf16_t* dst, const f32x16& o0, const f32x16& o1, int h) {
#pragma unroll
  for (int g = 0; g < 4; ++g) {
    u32x2 a; a.x = pack2(o0[4 * g], o0[4 * g + 1]); a.y = pack2(o0[4 * g + 2], o0[4 * g + 3]);
    *(u32x2*)(dst + 8 * g + 4 * h) = a;
    u32x2 b; b.x = pack2(o1[4 * g], o1[4 * g + 1]); b.y = pack2(o1[4 * g + 2], o1[4 * g + 3]);
    *(u32x2*)(dst + 32 + 8 * g + 4 * h) = b;
  }
}

DI void build_lut(unsigned char* blut, float* tbl, const float* rel_bias) {
  for (int n = TIDX; n < 2049; n += NTHREADS) {
    int bk = n;
    if (n >= 16) { bk = 16;
#pragma unroll
      for (int k = 0; k < 15; ++k) bk += (n >= BK_THR[k]) ? 1 : 0; }
    blut[n] = (unsigned char)bk;
  }
  for (int i = TIDX; i < 512; i += NTHREADS) { const int hd = i >> 5, bk = i & 31; tbl[i] = rel_bias[bk * 16 + hd] * 1.4426950408889634f; }
  __syncthreads();
}

DI int wave_fetch(unsigned* ctr) {
  int v = 0;
  if ((TIDX & 63) == 0) v = (int)atomicAdd(ctr, 1u);
  return __shfl(v, 0);
}

DI void nsa_cmp_item(const Params& p, int item, const unsigned char* blut, const float* tbl, float* impw) {
  const int lane = TIDX & 63, r = lane & 31, h = lane >> 5;
  const int qb = 127 - (item >> 4), bg = item & 15, b = bg >> 1, g = bg & 1;
  const int t = qb * 32 + r;
  const int ntile = (qb >> 4) + 1;
  const bf16_t* KC = (const bf16_t*)(p.ws + OFF_KC) + (size_t)bg * 256 * 64;
  const bf16_t* VCT = (const bf16_t*)(p.ws + OFF_VCT) + (size_t)bg * 64 * 256;
  const float* gates = (const float*)(p.ws + OFF_GATES) + (size_t)(b * 4096 + t) * 18;
#pragma unroll 4
  for (int j = 0; j < 32; ++j) impw[r * 65 + 2 * j + h] = 0.f;
  for (int rr = 0; rr < 3; ++rr) {
    const int head = g * 3 + rr;
    const float* tblh = tbl + head * 32;
    bf16x8 qf[4];
    load_q(qf, (const bf16_t*)(p.ws + OFF_QN) + (size_t)(b * 4096 + t) * 384 + head * 64 + 8 * h);
    float m = NEGINF, l = 0.f;
    for (int kt = 0; kt < ntile; ++kt) {
      const f32x16 s = qk_tile(qf, KC + (size_t)kt * 2048 + (h * 32 + r) * 8);
      float lg[16]; float mx = NEGINF;
      int dist[16]; float bv[16];
#pragma unroll
      for (int i = 0; i < 16; ++i) dist[i] = t - (16 * (kt * 32 + crow(i, h)) + 31);
      bias16(blut, tblh, dist, bv);
#pragma unroll
      for (int i = 0; i < 16; ++i) { lg[i] = (dist[i] >= 0) ? s[i] + bv[i] : NEGINF; mx = fmaxf(mx, lg[i]); }
      mx = fmaxf(mx, shx32(mx));
      const float mnew = fmaxf(m, mx), muse = (mnew == NEGINF) ? 0.f : mnew;
      float rs = 0.f;
#pragma unroll
      for (int i = 0; i < 16; ++i) rs += ex2(lg[i] - muse);
      l = l * ex2(m - muse) + rs; m = mnew;
    }
    l += shx32(l);
    const float muse = (m == NEGINF) ? 0.f : m;
    const float inv = (l > 0.f) ? 1.f / l : 0.f;
    AttnSt st; attn_init(st);
    float prev3 = 0.f;
#pragma unroll 1
    for (int kt = 0; kt < ntile; ++kt) {
      {
        const f32x16 s = qk_tile(qf, KC + (size_t)kt * 2048 + (h * 32 + r) * 8);
        float pr[16];
        int dist[16]; float bv[16];
#pragma unroll
        for (int i = 0; i < 16; ++i) dist[i] = t - (16 * (kt * 32 + crow(i, h)) + 31);
        bias16(blut, tblh, dist, bv);
#pragma unroll
        for (int i = 0; i < 16; ++i) pr[i] = (dist[i] >= 0) ? ex2(s[i] + bv[i] - muse) * inv : 0.f;
        float recv[4];
#pragma unroll
        for (int q = 0; q < 4; ++q) recv[q] = shx32(pr[4 * q + 3]);
#pragma unroll
        for (int q = 0; q < 4; ++q) {
          const float qs = (pr[4 * q] + pr[4 * q + 1]) + (pr[4 * q + 2] + pr[4 * q + 3]);
          const float cin = h ? recv[q] : (q ? recv[q > 0 ? q - 1 : 0] : prev3);
          impw[r * 65 + 8 * kt + 2 * q + h] += qs + cin;
        }
        prev3 = recv[3];
        pv_tile(st, pr, VCT + (size_t)kt * 2048 + (h * 32 + r) * 4, 256);
      }
    }
    const float g0 = gates[head * 3 + 0];
#pragma unroll
    for (int i = 0; i < 16; ++i) { st.o0[i] *= g0; st.o1[i] *= g0; }
    store_o((bf16_t*)(p.ws + OFF_OC) + (size_t)(b * 4096 + t) * 384 + head * 64, st.o0, st.o1, h);
  }
  const int cur = t >> 6;
  unsigned long long mask;
  if (cur < 16) {
    mask = (2ull << cur) - 1ull;
  } else {
    float own[32], oth[32];
#pragma unroll
    for (int j = 0; j < 32; ++j) {
      const int u = 2 * j + h, uo = 2 * j + 1 - h;
      const float a = impw[r * 65 + u], bb = impw[r * 65 + uo];
      own[j] = ((u >= 1) && (u <= cur - 2)) ? a : -1.f;
      oth[j] = ((uo >= 1) && (uo <= cur - 2)) ? bb : -1.f;
    }
    float prev = __builtin_inff();
#pragma unroll 1
    for (int round = 0; round < 13; ++round) {
      float m = -2.f;
#pragma unroll
      for (int j = 0; j < 32; ++j) { m = fmaxf(m, own[j] < prev ? own[j] : -2.f); m = fmaxf(m, oth[j] < prev ? oth[j] : -2.f); }
      prev = m;
    }
    unsigned mlo = 0u, mhi = 0u;
#pragma unroll
    for (int j = 0; j < 32; ++j) {
      const int u = 2 * j + h;
      const bool forced = (u == 0) || (u == cur) || (u == cur - 1);
      const bool cand = (u >= 1) && (u <= cur - 2);
      const bool sel = forced || (cand && own[j] >= prev);
      if (j < 16) mlo |= sel ? (1u << u) : 0u; else mhi |= sel ? (1u << (u - 32)) : 0u;
    }
    mlo |= (unsigned)shx32i((int)mlo);
    mhi |= (unsigned)shx32i((int)mhi);
    mask = ((unsigned long long)mhi << 32) | mlo;
  }
  if (h == 0) ((unsigned long long*)(p.ws + OFF_SELM))[(size_t)bg * 4096 + t] = mask;
}

DI void nsa_win_item(const Params& p, int b, int head, int qb, const unsigned char* blut, const float* tbl) {
  const int lane = TIDX & 63, r = lane & 31, h = lane >> 5;
  const int g = head / 3, bg = b * 2 + g;
  const int t = qb * 32 + r;
  const float* tblh = tbl + head * 32;
  bf16x8 qf[4];
  load_q(qf, (const bf16_t*)(p.ws + OFF_QN) + (size_t)(b * 4096 + t) * 384 + head * 64 + 8 * h);
  const float g2 = ((const float*)(p.ws + OFF_GATES))[(size_t)(b * 4096 + t) * 18 + head * 3 + 2];
  f32x16 y0, y1;
#pragma unroll
  for (int i = 0; i < 16; ++i) { y0[i] = 0.f; y1[i] = 0.f; }
  {
    const bf16_t* K = (const bf16_t*)(p.ws + OFF_KWIN) + (size_t)bg * 4096 * 64;
    const bf16_t* Vt = (const bf16_t*)(p.ws + OFF_VWINT) + (size_t)bg * 64 * 4096;
    AttnSt st; attn_init(st);
    const int k0 = qb >= 16 ? qb - 16 : 0;
    attn_loop(st, qf, k0, qb, 32,
      [&](int kt) { return K + (size_t)kt * 2048 + (h * 32 + r) * 8; },
      [&](int kt) { return Vt + (size_t)kt * 2048 + (h * 32 + r) * 4; },
      [&](int kt) { return true; },
      [&](int kt, const f32x16& s, float (&lg)[16]) {
        int dist[16]; float bv[16];
#pragma unroll
        for (int i = 0; i < 16; ++i) dist[i] = t - (kt * 32 + crow(i, h));
        bias16(blut, tblh, dist, bv);
#pragma unroll
        for (int i = 0; i < 16; ++i) lg[i] = (dist[i] >= 0 && dist[i] < 512) ? s[i] + bv[i] : NEGINF;
      });
    float l = st.l + shx32(st.l);
    const float sc = (l > 0.f) ? g2 / l : 0.f;
#pragma unroll
    for (int i = 0; i < 16; ++i) { y0[i] += sc * st.o0[i]; y1[i] += sc * st.o1[i]; }
  }
  store_o((bf16_t*)(p.ws + OFF_Y) + (size_t)(b * 4096 + t) * 768 + head * 64, y0, y1, h);
}

DI void nsa_main_item(const Params& p, int b, int head, int qb, const unsigned char* blut, const float* tbl) {
  const int lane = TIDX & 63, r = lane & 31, h = lane >> 5;
  const int g = head / 3, bg = b * 2 + g;
  const int t = qb * 32 + r;
  const float* tblh = tbl + head * 32;
  bf16x8 qf[4];
  load_q(qf, (const bf16_t*)(p.ws + OFF_QN) + (size_t)(b * 4096 + t) * 384 + head * 64 + 8 * h);
  const unsigned long long selm = ((const unsigned long long*)(p.ws + OFF_SELM))[(size_t)bg * 4096 + t];
  const float* gates = (const float*)(p.ws + OFF_GATES) + (size_t)(b * 4096 + t) * 18 + head * 3;
  const float g1 = gates[1];
  f32x16 y0, y1;
  {
    const bf16_t* oc = (const bf16_t*)(p.ws + OFF_OC) + (size_t)(b * 4096 + t) * 384 + head * 64;
    const bf16_t* yw = (const bf16_t*)(p.ws + OFF_Y) + (size_t)(b * 4096 + t) * 768 + head * 64;
#pragma unroll
    for (int i = 0; i < 16; ++i) { y0[i] = bf2f(oc[crow(i, h)]) + bf2f(yw[crow(i, h)]); y1[i] = bf2f(oc[32 + crow(i, h)]) + bf2f(yw[32 + crow(i, h)]); }
  }
  {
    const bf16_t* K = (const bf16_t*)(p.ws + OFF_KSEL) + (size_t)bg * 4096 * 64;
    const bf16_t* Vt = (const bf16_t*)(p.ws + OFF_VSELT) + (size_t)bg * 64 * 4096;
    AttnSt st; attn_init(st);
    attn_loop(st, qf, 0, qb, 32,
      [&](int kt) { return K + (size_t)kt * 2048 + (h * 32 + r) * 8; },
      [&](int kt) { return Vt + (size_t)kt * 2048 + (h * 32 + r) * 4; },
      [&](int kt) { return __ballot((selm >> (kt >> 1)) & 1ull) != 0ull; },
      [&](int kt, const f32x16& s, float (&lg)[16]) {
        const bool bs = (selm >> (kt >> 1)) & 1ull;
        if (qb * 32 - (kt * 32 + 31) >= 1513) {
          const float b31 = tblh[31];
#pragma unroll
          for (int i = 0; i < 16; ++i) lg[i] = bs ? s[i] + b31 : NEGINF;
        } else {
          int dist[16]; float bv[16];
#pragma unroll
          for (int i = 0; i < 16; ++i) dist[i] = t - (kt * 32 + crow(i, h));
          bias16(blut, tblh, dist, bv);
#pragma unroll
          for (int i = 0; i < 16; ++i) lg[i] = (bs && dist[i] >= 0) ? s[i] + bv[i] : NEGINF;
        }
      });
    float l = st.l + shx32(st.l);
    const float sc = (l > 0.f) ? g1 / l : 0.f;
#pragma unroll
    for (int i = 0; i < 16; ++i) { y0[i] += sc * st.o0[i]; y1[i] += sc * st.o1[i]; }
  }
  store_o((bf16_t*)(p.ws + OFF_Y) + (size_t)(b * 4096 + t) * 768 + head * 64, y0, y1, h);
}

DI void moba_item(const Params& p, int b, int hd, int qb, const unsigned char* blut, const float* tbl) {
  const int lane = TIDX & 63, r = lane & 31, h = lane >> 5;
  const int bh = b * 4 + hd;
  const int t = qb * 32 + r;
  const int c = qb >> 3;
  const float* tblh = tbl + (6 + hd) * 32;
  bf16x8 qf[4];
  load_q(qf, (const bf16_t*)(p.ws + OFF_QM) + (size_t)(b * 4096 + t) * 256 + hd * 64 + 8 * h);
  unsigned mmask = 0u;
  if (c > 0) {
    const bf16_t* km = (const bf16_t*)(p.ws + OFF_KMEAN) + (size_t)bh * 16 * 64 + (size_t)(r & 15) * 64 + 8 * h;
    f32x16 s;
#pragma unroll
    for (int i = 0; i < 16; ++i) s[i] = 0.f;
#pragma unroll
    for (int ss = 0; ss < 4; ++ss) {
      bf16x8 kf = *(const bf16x8*)(km + 16 * ss);
      if (r >= 16) {
#pragma unroll
        for (int j = 0; j < 8; ++j) kf[j] = 0;
      }
      s = MFMA32(kf, qf[ss], s);
    }
    float g16[16];
#pragma unroll
    for (int i = 0; i < 8; ++i) {
      const float own = s[i], oth = shx32(own);
      const int base = (i & 3) + 8 * (i >> 2);
      g16[base] = h ? oth : own;
      g16[base + 4] = h ? own : oth;
    }
#pragma unroll
    for (int n = 0; n < 16; ++n) g16[n] = (n < c) ? g16[n] : NEGINF;
#pragma unroll
    for (int round = 0; round < 3; ++round) {
      float best = NEGINF; int bi = -1;
#pragma unroll
      for (int n = 0; n < 16; ++n) if (g16[n] > best) { best = g16[n]; bi = n; }
      if (bi >= 0) mmask |= 1u << bi;
#pragma unroll
      for (int n = 0; n < 16; ++n) if (n == bi) g16[n] = NEGINF;
    }
  }
  mmask |= 1u << c;
  const bf16_t* K = (const bf16_t*)(p.ws + OFF_KM) + (size_t)bh * 4096 * 64;
  const bf16_t* Vt = (const bf16_t*)(p.ws + OFF_VMT) + (size_t)bh * 64 * 4096;
  AttnSt st; attn_init(st);
  attn_loop(st, qf, 0, qb, 32,
    [&](int kt) { return K + (size_t)kt * 2048 + (h * 32 + r) * 8; },
    [&](int kt) { return Vt + (size_t)kt * 2048 + (h * 32 + r) * 4; },
    [&](int kt) { return __ballot((mmask >> (kt >> 3)) & 1u) != 0ull; },
    [&](int kt, const f32x16& s, float (&lg)[16]) {
      const bool bs = (mmask >> (kt >> 3)) & 1u;
      if (qb * 32 - (kt * 32 + 31) >= 1513) {
        const float b31 = tblh[31];
#pragma unroll
        for (int i = 0; i < 16; ++i) lg[i] = bs ? s[i] + b31 : NEGINF;
      } else {
        int dist[16]; float bv[16];
#pragma unroll
        for (int i = 0; i < 16; ++i) dist[i] = t - (kt * 32 + crow(i, h));
        bias16(blut, tblh, dist, bv);
#pragma unroll
        for (int i = 0; i < 16; ++i) lg[i] = (bs && dist[i] >= 0) ? s[i] + bv[i] : NEGINF;
      }
    });
  float l = st.l + shx32(st.l);
  const float sc = (l > 0.f) ? 1.f / l : 0.f;
#pragma unroll
  for (int i = 0; i < 16; ++i) { st.o0[i] *= sc; st.o1[i] *= sc; }
  store_o((bf16_t*)(p.ws + OFF_Y) + (size_t)(b * 4096 + t) * 768 + 384 + hd * 64, st.o0, st.o1, h);
}

DI void dil_item(const Params& p, int b, int j, int qi, const unsigned char* blut, const float* tbl) {
  const int lane = TIDX & 63, r = lane & 31, h = lane >> 5;
  const int rho = qi & 15, ub = qi >> 4;
  const int t = rho + 16 * (ub * 32 + r);
  const int tmin = rho + 16 * (ub * 32), tmax = rho + 16 * (ub * 32 + 31);
  AttnSt st; attn_init(st);
#pragma unroll
  for (int g = 0; g < 3; ++g) {
    const int dil = (g == 0) ? 1 : (g == 1 ? 4 : 16), window = 128 * dil, L = 4096 / dil;
    const int hd = 2 * g + j;
    const float* tblh = tbl + (10 + hd) * 32;
    const int rg = rho % dil;
    bf16x8 qf[4];
    load_q(qf, (const bf16_t*)(p.ws + OFF_QD) + (size_t)(b * 4096 + t) * 384 + hd * 64 + 8 * h);
    const bf16_t* K = (const bf16_t*)(p.ws + OFF_KD) + (size_t)(b * 6 + hd) * 4096 * 64;
    const bf16_t* Vt = (const bf16_t*)(p.ws + OFF_VDT) + (size_t)(b * 6 + hd) * 64 * 4096 + (size_t)(rg * L >> 5) * 2048;
    int vlo = tmin / dil - 128; if (vlo < 0) vlo = 0;
    const int vhi = tmax / dil;
    attn_loop(st, qf, vlo >> 5, vhi >> 5, 32,
      [&](int kt) { return K + (size_t)((rg * L >> 5) + kt) * 2048 + (h * 32 + r) * 8; },
      [&](int kt) { return Vt + (size_t)kt * 2048 + (h * 32 + r) * 4; },
      [&](int kt) { return true; },
      [&](int kt, const f32x16& s, float (&lg)[16]) {
        int dist[16]; float bv[16];
#pragma unroll
        for (int i = 0; i < 16; ++i) dist[i] = t - ((kt * 32 + crow(i, h)) * dil + rg);
        bias16(blut, tblh, dist, bv);
#pragma unroll
        for (int i = 0; i < 16; ++i) lg[i] = (dist[i] >= 0 && dist[i] <= window) ? s[i] + bv[i] : NEGINF;
      });
  }
  float l = st.l + shx32(st.l);
  const float sc = (l > 0.f) ? 1.f / l : 0.f;
#pragma unroll
  for (int i = 0; i < 16; ++i) { st.o0[i] *= sc; st.o1[i] *= sc; }
  store_o((bf16_t*)(p.ws + OFF_Y) + (size_t)(b * 4096 + t) * 768 + 640 + j * 64, st.o0, st.o1, h);
}

DI void phaseX(const Params& p, int layer, char* lds, int rep = 0) {
  unsigned char* blut = (unsigned char*)lds; float* tbl = (float*)(lds + 4096);
  build_lut(blut, tbl, p.in[I_RELB]);
  unsigned* ctr = (unsigned*)(p.ws + OFF_MISC) + layer * 2 + rep * 8;
  for (;;) {
    const int item = wave_fetch(ctr);
    if (item >= 2048 + 128 * 48) break;
    if (item < 2048) nsa_cmp_item(p, item, blut, tbl, (float*)(lds + 8192) + (TIDX >> 6) * (32 * 65));
    else { const int it2 = item - 2048, qb = 127 - it2 / 48, sub = it2 % 48; nsa_win_item(p, sub / 6, sub % 6, qb, blut, tbl); }
  }
  __syncthreads();
}
DI void filler_items(const Params& p, int layer, char* lds, int which) {
  __syncthreads();
  unsigned char* blut = (unsigned char*)lds; float* tbl = (float*)(lds + 4096);
  build_lut(blut, tbl, p.in[I_RELB]);
  unsigned* ctr = (unsigned*)(p.ws + OFF_MISC) + 16 + layer * 2 + which;
  for (;;) {
    const int item = wave_fetch(ctr);
    if (which == 0) { if (item >= 128 * 16) break; const int qb = 127 - item / 16, sub = item % 16; dil_item(p, sub >> 1, sub & 1, qb, blut, tbl); }
    else { if (item >= 128 * 32) break; const int qb = 127 - item / 32, sub = item % 32; moba_item(p, sub >> 2, sub & 3, qb, blut, tbl); }
  }
  __syncthreads();
}
DI void phaseY(const Params& p, int layer, char* lds, int rep = 0) {
  unsigned char* blut = (unsigned char*)lds; float* tbl = (float*)(lds + 4096);
  build_lut(blut, tbl, p.in[I_RELB]);
  unsigned* ctr = (unsigned*)(p.ws + OFF_MISC) + layer * 2 + 1 + rep * 8;
  for (;;) {
    const int item = wave_fetch(ctr);
    if (item >= 128 * 48) break;
    const int qb = 127 - item / 48, sub = item % 48;
    nsa_main_item(p, sub / 6, sub % 6, qb, blut, tbl);
  }
  __syncthreads();
}

DI void kmean_phase(const Params& p) {
  const int lane = TIDX & 63;
  const int gw = blockIdx.x * 8 + (TIDX >> 6), nw = gridDim.x * 8;
  const bf16_t* KM = (const bf16_t*)(p.ws + OFF_KM);
  bf16_t* o = (bf16_t*)(p.ws + OFF_KMEAN);
  for (int it = gw; it < 512; it += nw) {
    const bf16_t* src = KM + (size_t)it * 256 * 64;
    float s = 0.f;
    for (int k = 0; k < 256; ++k) s += bf2f(KM[(size_t)(it >> 4) * 262144 + kfrag_idx((it & 15) * 256 + k, lane)]);
    o[it * 64 + lane] = f2bf(s * (1.f / 256.f));
  }
}

DI void merge_phase(const Params& p, int layer, char* lds) {
  const bf16_t* wl = (const bf16_t*)(p.ws + OFF_W) + (size_t)layer * W_LAYER;
  const bf16_t* hn = (const bf16_t*)(p.ws + OFF_HN);
  const bf16_t* y = (const bf16_t*)(p.ws + OFF_Y);
  bf16_t* mg = (bf16_t*)(p.ws + OFF_MERGED);
  const int lmax = tile_lmax(128, 8, 4);
  for (int L = blockIdx.x; L < lmax; L += gridDim.x) {
    int mt, nt;
    if (!tile_map(L, 128, 8, 4, mt, nt)) continue;
    f32x16 macc[2][2];
    zero_acc(macc);
#pragma unroll 1
    for (int br = 0; br < 3; ++br) {
      const int kw = (br == 0) ? 384 : (br == 1 ? 256 : 128);
      const int yo = (br == 0) ? 0 : (br == 1 ? 384 : 640);
      const bf16_t* wu = wl + ((br == 0) ? OW_UA : (br == 1 ? OW_UB : OW_UC));
      unsigned sg[2][2][8];
      {
        f32x16 ag[2][2];
        zero_acc(ag);
        gemm_core(hn + (size_t)mt * 256 * 1024, 1024, wl + OW_ING + (size_t)(br * 1024 + nt * 128) * 1024, 1024, 1024, ag, lds);
#pragma unroll
        for (int a = 0; a < 2; ++a)
#pragma unroll
          for (int c = 0; c < 2; ++c)
#pragma unroll
            for (int i = 0; i < 8; ++i) sg[a][c][i] = pack2(sigmoidf_(ag[a][c][2 * i]), sigmoidf_(ag[a][c][2 * i + 1]));
      }
      f32x16 au[2][2];
      zero_acc(au);
      gemm_core(y + (size_t)mt * 256 * 768 + yo, 768, wu + (size_t)nt * 128 * kw, kw, kw, au, lds);
#pragma unroll
      for (int a = 0; a < 2; ++a)
#pragma unroll
        for (int c = 0; c < 2; ++c)
#pragma unroll
          for (int i = 0; i < 8; ++i) {
            macc[a][c][2 * i] += __uint_as_float(sg[a][c][i] << 16) * au[a][c][2 * i];
            macc[a][c][2 * i + 1] += __uint_as_float(sg[a][c][i] & 0xffff0000u) * au[a][c][2 * i + 1];
          }
    }
    const int tid = TIDX, lane = tid & 63, wid = tid >> 6, wr = wid >> 1, wc = wid & 1, r = lane & 31, h = lane >> 5;
#pragma unroll
    for (int a = 0; a < 2; ++a)
#pragma unroll
      for (int c = 0; c < 2; ++c)
#pragma unroll
        for (int i = 0; i < 16; ++i)
          mg[(size_t)(mt * 256 + wr * 64 + a * 32 + crow(i, h)) * 1024 + nt * 128 + wc * 64 + c * 32 + r] = f2bf(macc[a][c][i]);
  }
}

constexpr int NPHASE = 1 + 2 * 14 + 1;

DI void run_phase(const Params& p, int ph, char* lds, int rep = 0) {
#ifdef TESTQ
  if (ph == 0) { if (TESTQ == 100) phase0(p, lds); return; }
  if ((ph - 1) % 14 != TESTQ) return;
#endif
  if (ph == 0) { phase0(p, lds); return; }
  if (ph == NPHASE - 1) { final_norm_phase(p.out, p.in[I_FINN]); return; }
  const int layer = (ph - 1) / 14, q = (ph - 1) % 14;
  const bf16_t* wl = (const bf16_t*)(p.ws + OFF_W) + (size_t)layer * W_LAYER;
  bf16_t* hn = (bf16_t*)(p.ws + OFF_HN);
  switch (q) {
    case 0: { EpiSwiglu e{(bf16_t*)(p.ws + OFF_FFH)}; gemm_phase(hn, 1024, wl + OW_GU1, 1024, 1024, 128, 44, 4, e, lds); } break;
    case 1: { EpiResid e{layer == 0 ? p.in[I_X] : p.out, p.out, 0.5f}; gemm_phase((const bf16_t*)(p.ws + OFF_FFH), DFF, wl + OW_DN1, DFF, DFF, 128, 8, 4, e, lds, true); } break;
    case 2: rms_phase(p.out, p.in[I_MIXN] + layer * 1024, hn); break;
    case 3: { EpiWin e{p.ws}; gemm_phase(hn, 1024, wl + OW_INM, 1024, 1024, 128, 25, 5, e, lds); } break;
    case 4: {
      { EpiGelu e{(bf16_t*)(p.ws + OFF_H1K), (const float*)(p.ws + OFF_MISC + 256) + (layer * 2 + 0) * 256}; gemm_phase((const bf16_t*)(p.ws + OFF_KCMP), 1024, wl + OW_PK1, 2048, 2048, 16, 2, 2, e, lds); }
      { EpiGelu e{(bf16_t*)(p.ws + OFF_H1V), (const float*)(p.ws + OFF_MISC + 256) + (layer * 2 + 1) * 256}; gemm_phase((const bf16_t*)(p.ws + OFF_VCMP), 1024, wl + OW_PV1, 2048, 2048, 16, 2, 2, e, lds); }
      kmean_phase(p);
      filler_items(p, layer, lds, 0);
    } break;
    case 5: {
      { EpiCmpOut<0> e{(bf16_t*)(p.ws + OFF_KC)}; gemm_phase((const bf16_t*)(p.ws + OFF_H1K), 256, wl + OW_PK2, 256, 256, 16, 1, 1, e, lds); }
      { EpiCmpOut<1> e{(bf16_t*)(p.ws + OFF_VCT)}; gemm_phase((const bf16_t*)(p.ws + OFF_H1V), 256, wl + OW_PV2, 256, 256, 16, 1, 1, e, lds); }
      filler_items(p, layer, lds, 1);
    } break;
    case 6: phaseX(p, layer, lds, rep); break;
    case 7: phaseY(p, layer, lds, rep); break;
    case 8: merge_phase(p, layer, lds); break;
    case 9: { EpiResid e{p.out, p.out, 1.0f}; gemm_phase((const bf16_t*)(p.ws + OFF_MERGED), 1024, wl + OW_WO, 1024, 1024, 128, 8, 4, e, lds); } break;
    case 10: rms_phase(p.out, p.in[I_F2N] + layer * 1024, hn); break;
    case 11: { EpiSwiglu e{(bf16_t*)(p.ws + OFF_FFH)}; gemm_phase(hn, 1024, wl + OW_GU2, 1024, 1024, 128, 44, 4, e, lds); } break;
    case 12: { EpiResid e{p.out, p.out, 0.5f}; gemm_phase((const bf16_t*)(p.ws + OFF_FFH), DFF, wl + OW_DN2, DFF, DFF, 128, 8, 4, e, lds, true); } break;
    default: if (layer == 0) rms_phase(p.out, p.in[I_F1N] + 1024, hn); break;
  }
}


DI void grid_barrier(unsigned* ctr, unsigned target) {
  __syncthreads();
  if (threadIdx.x == 0) {
    __threadfence();
    __hip_atomic_fetch_add(ctr, 1u, __ATOMIC_RELAXED, __HIP_MEMORY_SCOPE_AGENT);
    unsigned spins = 0;
    while (__hip_atomic_load(ctr, __ATOMIC_RELAXED, __HIP_MEMORY_SCOPE_AGENT) < target && spins < (1u << 26)) { __builtin_amdgcn_s_sleep(2); ++spins; }
    __threadfence();
  }
  __syncthreads();
}
#if MEGA
__global__ void __launch_bounds__(NTHREADS) mega_kernel(Params p) {
  extern __shared__ __attribute__((aligned(16))) char lds[];
  cg::grid_group grid = cg::this_grid();
  unsigned bar_gen = 0;
  for (int ph = 0; ph < NPHASE; ++ph) {
#ifdef REPQ
    const int nrep = (REPQ >= 100) ? ((ph == REPQ - 100) ? 2 : 1) : ((ph > 0 && ph < NPHASE - 1 && (ph - 1) % 14 == REPQ) ? 2 : 1);
#else
    const int nrep = 1;
#endif
    if (ph == NPHASE - 2) continue;
    for (int rep = 0; rep < nrep; ++rep) {
      run_phase(p, ph, lds, rep);
      if (ph + 1 < NPHASE) {
        if (ph == 0) grid.sync();
        else { ++bar_gen; grid_barrier((unsigned*)(p.ws + OFF_MISC + 6144), bar_gen * gridDim.x); }
      }
    }
  }
}
#else
__global__ void __launch_bounds__(NTHREADS) phase_kernel(Params p, int ph) {
  extern __shared__ __attribute__((aligned(16))) char lds[];
  run_phase(p, ph, lds);
}
#endif

extern "C" void kernel_launch(void* const* d_in, const int* in_sizes, int n_in, void* d_out, int out_size, void* d_ws, size_t ws_size, hipStream_t stream) {
  Params p;
  memset(&p, 0, sizeof(p));
  for (int i = 0; i < 23; ++i) p.in[i] = (const float*)d_in[i];
  p.out = (float*)d_out;
  p.ws = (char*)d_ws;
  if (ws_size < OFF_END) fprintf(stderr, "workspace too small: %zu < %zu\n", ws_size, (size_t)OFF_END);
  static int grid_blocks = 0;
  if (!grid_blocks) {
    int dev = 0, cus = 0, per_cu = 0;
    (void)hipGetDevice(&dev);
    (void)hipDeviceGetAttribute(&cus, hipDeviceAttributeMultiprocessorCount, dev);
#if MEGA
    if (hipFuncSetAttribute((const void*)mega_kernel, hipFuncAttributeMaxDynamicSharedMemorySize, LDS_BYTES) != hipSuccess) fprintf(stderr, "hipFuncSetAttribute failed\n");
    (void)hipOccupancyMaxActiveBlocksPerMultiprocessor(&per_cu, mega_kernel, NTHREADS, LDS_BYTES);
#else
    per_cu = 1;
#endif
    if (per_cu < 1) per_cu = 1;
    if (per_cu > 2) per_cu = 2;
    grid_blocks = cus * per_cu;
  }
#if MEGA
  void* args[] = {&p};
  hipError_t e = hipLaunchCooperativeKernel((void*)mega_kernel, dim3(grid_blocks), dim3(NTHREADS), args, LDS_BYTES, stream);
  if (e != hipSuccess) fprintf(stderr, "cooperative launch failed: %s (grid %d)\n", hipGetErrorString(e), grid_blocks);
#else
  for (int ph = 0; ph < NPHASE; ++ph) phase_kernel<<<grid_blocks, NTHREADS, LDS_BYTES, stream>>>(p, ph);
#endif
}
```

```cpp
#include <hip/hip_runtime.h>
#include <hip/hip_cooperative_groups.h>
#include <stdint.h>
#include <stdio.h>
#include <string.h>
namespace cg = cooperative_groups;

#ifndef MEGA
#define MEGA 1
#endif

typedef unsigned short bf16_t;
typedef short bf16x8 __attribute__((ext_vector_type(8)));
typedef short s16x4 __attribute__((ext_vector_type(4)));
typedef float f32x16 __attribute__((ext_vector_type(16)));
typedef float f32x4 __attribute__((ext_vector_type(4)));
typedef unsigned u32x4 __attribute__((ext_vector_type(4)));
typedef unsigned u32x2 __attribute__((ext_vector_type(2)));

#define DI __device__ __forceinline__
#define MFMA32(a, b, c) __builtin_amdgcn_mfma_f32_32x32x16_bf16((a), (b), (c), 0, 0, 0)
#define NEGINF (-__builtin_inff())

constexpr int NB = 8, SEQ = 4096, DM = 1024, NT = NB * SEQ, DFF = 2816;
constexpr int NTHREADS = 512;

constexpr size_t W_GU = 5632ull * 1024, W_DN = 1024ull * 2816, W_INM = 3200ull * 1024, W_ING = 3072ull * 1024,
                 W_P1 = 256ull * 2048, W_P2 = 128ull * 256, W_UA = 1024ull * 384, W_UB = 1024ull * 256, W_UC = 1024ull * 128, W_WO = 1024ull * 1024;
constexpr size_t OW_GU1 = 0, OW_DN1 = OW_GU1 + W_GU, OW_GU2 = OW_DN1 + W_DN, OW_DN2 = OW_GU2 + W_GU, OW_INM = OW_DN2 + W_DN,
                 OW_ING = OW_INM + W_INM, OW_PK1 = OW_ING + W_ING, OW_PV1 = OW_PK1 + W_P1, OW_PK2 = OW_PV1 + W_P1, OW_PV2 = OW_PK2 + W_P2,
                 OW_UA = OW_PV2 + W_P2, OW_UB = OW_UA + W_UA, OW_UC = OW_UB + W_UB, OW_WO = OW_UC + W_UC, W_LAYER = OW_WO + W_WO;
constexpr size_t OFF_W = 0;
constexpr size_t OFF_MISC = OFF_W + 2 * W_LAYER * 2;
constexpr size_t OFF_HN = OFF_MISC + 8192;
constexpr size_t OFF_C = OFF_HN + (size_t)NT * DM * 2;
constexpr size_t OFF_FFH = OFF_C;
constexpr size_t OFF_QN = OFF_C;
constexpr size_t OFF_QM = OFF_QN + (size_t)NT * 384 * 2;
constexpr size_t OFF_QD = OFF_QM + (size_t)NT * 256 * 2;
constexpr size_t OFF_MERGED = OFF_C;
constexpr size_t SZ_G2 = 16ull * 4096 * 64 * 2;
constexpr size_t OFF_KCMP = OFF_QD + (size_t)NT * 384 * 2;
constexpr size_t OFF_VCMP = OFF_KCMP + SZ_G2 + 4096;
constexpr size_t OFF_KSEL = OFF_VCMP + SZ_G2 + 4096;
constexpr size_t OFF_VSELT = OFF_KSEL + SZ_G2;
constexpr size_t OFF_KWIN = OFF_VSELT + SZ_G2;
constexpr size_t OFF_VWINT = OFF_KWIN + SZ_G2;
constexpr size_t OFF_KM = OFF_VWINT + SZ_G2;
constexpr size_t OFF_VMT = OFF_KM + 2 * SZ_G2;
constexpr size_t OFF_KD = OFF_VMT + 2 * SZ_G2;
constexpr size_t OFF_VDT = OFF_KD + 3 * SZ_G2;
constexpr size_t OFF_GATES = OFF_VDT + 3 * SZ_G2;
constexpr size_t OFF_H1K = OFF_GATES + (size_t)NT * 18 * 4;
constexpr size_t OFF_H1V = OFF_H1K + 4096ull * 256 * 2;
constexpr size_t OFF_KC = OFF_H1V + 4096ull * 256 * 2;
constexpr size_t OFF_VCT = OFF_KC + 16ull * 256 * 64 * 2;
constexpr size_t OFF_KMEAN = OFF_VCT + 16ull * 256 * 64 * 2;
constexpr size_t OFF_SELM = OFF_KMEAN + 32ull * 16 * 64 * 2;
constexpr size_t OFF_OC = OFF_SELM + 16ull * 4096 * 8;
constexpr size_t OFF_Y = OFF_OC + (size_t)NT * 384 * 2;
constexpr size_t OFF_END = OFF_Y + (size_t)NT * 768 * 2;
static_assert(OFF_FFH + (size_t)NT * DFF * 2 <= OFF_END, "ffh fits");

struct Params {
  const float* in[23];
  float* out;
  char* ws;
};

enum { I_X = 0, I_RELB, I_F1N, I_F1G, I_F1U, I_F1D, I_MIXN, I_WIN, I_PEK, I_PEV, I_PK1, I_PK2, I_PV1, I_PV2, I_UA, I_UB, I_UC, I_WO, I_F2N, I_F2G, I_F2U, I_F2D, I_FINN };

DI int get_tid_() { int t = threadIdx.x; asm volatile("" : "+v"(t)); return t; }
#define TIDX get_tid_()
DI float shx32(float v) { const auto r = __builtin_amdgcn_permlane32_swap(__float_as_uint(v), __float_as_uint(v), false, false); return __uint_as_float((threadIdx.x & 32) ? r[0] : r[1]); }
DI int shx32i(int v) { const auto r = __builtin_amdgcn_permlane32_swap((unsigned)v, (unsigned)v, false, false); return (int)((threadIdx.x & 32) ? r[0] : r[1]); }
DI float ex2(float x) { return __builtin_amdgcn_exp2f(x); }
DI size_t kfrag_idx(int pos, int d) { return ((size_t)((pos >> 5) * 4 + (d >> 4)) * 64 + ((d >> 3) & 1) * 32 + (pos & 31)) * 8 + (d & 7); }
DI size_t vfrag_idx(int pos, int d) { return ((size_t)((pos >> 5) * 8 + ((pos >> 4) & 1) * 4 + (d >> 5) * 2 + ((pos >> 3) & 1)) * 64 + ((pos >> 2) & 1) * 32 + (d & 31)) * 4 + (pos & 3); }
DI bf16_t f2bf(float x) { unsigned r; asm("v_cvt_pk_bf16_f32 %0, %1, %1" : "=v"(r) : "v"(x)); return (bf16_t)(r & 0xffffu); }
DI float bf2f(bf16_t b) { return __uint_as_float(((unsigned)b) << 16); }
DI unsigned pack2(float a, float b) { unsigned r; asm("v_cvt_pk_bf16_f32 %0, %1, %2" : "=v"(r) : "v"(a), "v"(b)); return r; }
DI int crow(int i, int h) { return (i & 3) + 8 * (i >> 2) + 4 * h; }
DI float sigmoidf_(float x) { return 1.f / (1.f + __expf(-x)); }

DI int lds_off(int row, int chunk) { return row * 128 + ((chunk ^ ((row >> 1) & 7)) << 4); }

#define LAS __attribute__((address_space(3)))
constexpr int NSTAGE = 3;
constexpr int STAGE_B = 49152;
constexpr int LDS_BYTES = NSTAGE * STAGE_B;
DI void glds16(const void* g, char* l) { __builtin_amdgcn_global_load_lds((const unsigned*)g, (LAS unsigned*)l, 16, 0, 0); }

template <int PART = 0>
DI void gemm_core(const bf16_t* __restrict__ A, int lda, const bf16_t* __restrict__ Bt, int ldb, int K,
                  f32x16 (&acc)[2][2], char* lds) {
  const int tid = TIDX, lane = tid & 63, wid = tid >> 6, wr = wid >> 1, wc = wid & 1, r = lane & 31, h = lane >> 5;
  const int ch = (tid & 7) ^ ((tid >> 4) & 7);
  unsigned avo[4], bvo[2];
#pragma unroll
  for (int i = 0; i < 4; ++i) avo[i] = (unsigned)(((tid >> 3) + 64 * i) * lda * 2 + ch * 16);
#pragma unroll
  for (int i = 0; i < 2; ++i) bvo[i] = (unsigned)(((tid >> 3) + 64 * i) * ldb * 2 + ch * 16);
  const char* Ab = (const char*)A; const char* Bb = (const char*)Bt;
  char* lw = lds + tid * 16;
  const int nk = K >> 6;
  const unsigned swz = (unsigned)((r >> 1) & 7);
  const unsigned arow_u = (unsigned)((wr * 64 + r) * 128), brow_u = (unsigned)((wc * 64 + r) * 128);
  const unsigned co0 = ((0u + h) ^ swz) << 4, co1 = ((2u + h) ^ swz) << 4, co2 = ((4u + h) ^ swz) << 4, co3 = ((6u + h) ^ swz) << 4;
#define GEMM_ISSUE(kt_, st_) do { char* sb_ = lw + (st_) * STAGE_B; const char* ak_ = Ab + (size_t)(kt_) * 128; const char* bk_ = Bb + (size_t)(kt_) * 128; \
    _Pragma("unroll") for (int i_ = 0; i_ < 4; ++i_) glds16(ak_ + avo[i_], sb_ + i_ * 8192); \
    _Pragma("unroll") for (int i_ = 0; i_ < 2; ++i_) glds16(bk_ + bvo[i_], sb_ + 32768 + i_ * 8192); } while (0)
  if (PART != 2) {
    GEMM_ISSUE(0, 0);
    if (nk > 1) GEMM_ISSUE(1, 1);
  }
  if (PART == 1) return;
  int st = 0;
  for (int kt = 0; kt < nk; ++kt) {
    if (kt + 1 < nk) asm volatile("s_waitcnt vmcnt(6)" ::: "memory");
    else asm volatile("s_waitcnt vmcnt(0)" ::: "memory");
    __builtin_amdgcn_s_barrier();
    asm volatile("" ::: "memory");
    if (kt + 2 < nk) { const int st2 = (st >= 1) ? st - 1 : 2; GEMM_ISSUE(kt + 2, st2); }
    const char* la = lds + st * STAGE_B;
    const char* lb = la + 32768;
    const unsigned sa_u = (unsigned)(size_t)la + arow_u, sb_u = (unsigned)(size_t)lb + brow_u;
    const unsigned a0 = sa_u + co0, a1 = sa_u + co1, a2 = sa_u + co2, a3 = sa_u + co3;
    const unsigned b0 = sb_u + co0, b1 = sb_u + co1, b2 = sb_u + co2, b3 = sb_u + co3;
    {
      bf16x8 p0, p1, q0, q1, u0, u1, w0, w1;
      asm volatile(
        "ds_read_b128 %4, %12\n\tds_read_b128 %5, %12 offset:4096\n\tds_read_b128 %6, %16\n\tds_read_b128 %7, %16 offset:4096\n\t"
        "ds_read_b128 %8, %13\n\tds_read_b128 %9, %13 offset:4096\n\tds_read_b128 %10, %17\n\tds_read_b128 %11, %17 offset:4096\n\t"
        "s_waitcnt lgkmcnt(4)\n\t"
        "v_mfma_f32_32x32x16_bf16 %0, %4, %6, %0\n\tv_mfma_f32_32x32x16_bf16 %1, %4, %7, %1\n\tv_mfma_f32_32x32x16_bf16 %2, %5, %6, %2\n\tv_mfma_f32_32x32x16_bf16 %3, %5, %7, %3\n\t"
        "ds_read_b128 %4, %14\n\tds_read_b128 %5, %14 offset:4096\n\tds_read_b128 %6, %18\n\tds_read_b128 %7, %18 offset:4096\n\t"
        "s_waitcnt lgkmcnt(4)\n\t"
        "v_mfma_f32_32x32x16_bf16 %0, %8, %10, %0\n\tv_mfma_f32_32x32x16_bf16 %1, %8, %11, %1\n\tv_mfma_f32_32x32x16_bf16 %2, %9, %10, %2\n\tv_mfma_f32_32x32x16_bf16 %3, %9, %11, %3\n\t"
        "ds_read_b128 %8, %15\n\tds_read_b128 %9, %15 offset:4096\n\tds_read_b128 %10, %19\n\tds_read_b128 %11, %19 offset:4096\n\t"
        "s_waitcnt lgkmcnt(4)\n\t"
        "v_mfma_f32_32x32x16_bf16 %0, %4, %6, %0\n\tv_mfma_f32_32x32x16_bf16 %1, %4, %7, %1\n\tv_mfma_f32_32x32x16_bf16 %2, %5, %6, %2\n\tv_mfma_f32_32x32x16_bf16 %3, %5, %7, %3\n\t"
        "s_waitcnt lgkmcnt(0)\n\t"
        "v_mfma_f32_32x32x16_bf16 %0, %8, %10, %0\n\tv_mfma_f32_32x32x16_bf16 %1, %8, %11, %1\n\tv_mfma_f32_32x32x16_bf16 %2, %9, %10, %2\n\tv_mfma_f32_32x32x16_bf16 %3, %9, %11, %3"
        : "+v"(acc[0][0]), "+v"(acc[0][1]), "+v"(acc[1][0]), "+v"(acc[1][1]),
          "=&v"(p0), "=&v"(p1), "=&v"(q0), "=&v"(q1), "=&v"(u0), "=&v"(u1), "=&v"(w0), "=&v"(w1)
        : "v"(a0), "v"(a1), "v"(a2), "v"(a3), "v"(b0), "v"(b1), "v"(b2), "v"(b3));
    }
    st = (st == 2) ? 0 : st + 1;
  }
  asm volatile("s_nop 15\n\ts_nop 15\n\ts_nop 7" ::: "memory");
  __builtin_amdgcn_s_barrier();
  asm volatile("" ::: "memory");
}

DI void zero_acc(f32x16 (&acc)[2][2]) {
#pragma unroll
  for (int a = 0; a < 2; ++a)
#pragma unroll
    for (int b = 0; b < 2; ++b)
#pragma unroll
      for (int i = 0; i < 16; ++i) acc[a][b][i] = 0.f;
}

DI bool tile_map(int L, int MT, int NTl, int SN, int& mt, int& nt) {
  const int xcd = L & 7, ix = L >> 3, per = 8 * SN, st = ix / per, w = ix % per;
  const int gst = st * 8 + xcd, SNT = NTl / SN, total = (MT >> 3) * SNT;
  if (gst >= total) return false;
  const int smt = gst / SNT, snt = gst % SNT;
  mt = smt * 8 + (w & 7); nt = snt * SN + (w >> 3);
  return true;
}
DI int tile_lmax(int MT, int NTl, int SN) { const int total = (MT >> 3) * (NTl / SN); return ((total + 7) >> 3) * 8 * SN * 8; }

struct EpiSwiglu {
  static constexpr bool PRE = false;
  bf16_t* ffh;
  DI void operator()(const f32x16 (&acc)[2][2], int m0, int n0) const {
    const int tid = TIDX, lane = tid & 63, wid = tid >> 6, wr = wid >> 1, wc = wid & 1, r = lane & 31, h = lane >> 5;
    const int hid = (n0 >> 7) * 64 + wc * 32 + r;
#pragma unroll
    for (int mi = 0; mi < 2; ++mi)
#pragma unroll
      for (int i = 0; i < 16; ++i) {
        const int row = m0 + wr * 64 + mi * 32 + crow(i, h);
        const float g = acc[mi][0][i], u = acc[mi][1][i];
        ffh[(size_t)row * DFF + hid] = f2bf(g * sigmoidf_(g) * u);
      }
  }
};
struct EpiResid {
  const float* res; float* out; float scale;
  static constexpr bool PRE = true;
  DI void pre(float (&rv)[2][2][16], int m0, int n0) const {
    const int tid = TIDX, lane = tid & 63, wid = tid >> 6, wr = wid >> 1, wc = wid & 1, r = lane & 31, h = lane >> 5;
#pragma unroll
    for (int mi = 0; mi < 2; ++mi)
#pragma unroll
      for (int ni = 0; ni < 2; ++ni)
#pragma unroll
        for (int i = 0; i < 16; ++i)
          rv[mi][ni][i] = res[(size_t)(m0 + wr * 64 + mi * 32 + crow(i, h)) * DM + n0 + wc * 64 + ni * 32 + r];
  }
  DI void operator()(const f32x16 (&acc)[2][2], int m0, int n0, const float (&rv)[2][2][16]) const {
    const int tid = TIDX, lane = tid & 63, wid = tid >> 6, wr = wid >> 1, wc = wid & 1, r = lane & 31, h = lane >> 5;
#pragma unroll
    for (int mi = 0; mi < 2; ++mi)
#pragma unroll
      for (int ni = 0; ni < 2; ++ni)
#pragma unroll
        for (int i = 0; i < 16; ++i)
          out[(size_t)(m0 + wr * 64 + mi * 32 + crow(i, h)) * DM + n0 + wc * 64 + ni * 32 + r] = rv[mi][ni][i] + scale * acc[mi][ni][i];
  }
};
struct EpiGelu {
  static constexpr bool PRE = false;
  bf16_t* o; const float* bias;
  DI void operator()(const f32x16 (&acc)[2][2], int m0, int n0) const {
    const int tid = TIDX, lane = tid & 63, wid = tid >> 6, wr = wid >> 1, wc = wid & 1, r = lane & 31, h = lane >> 5;
#pragma unroll
    for (int mi = 0; mi < 2; ++mi)
#pragma unroll
      for (int ni = 0; ni < 2; ++ni) {
        const int col = n0 + wc * 64 + ni * 32 + r;
        const float bv = bias[col];
#pragma unroll
        for (int i = 0; i < 16; ++i) {
          const int row = m0 + wr * 64 + mi * 32 + crow(i, h);
          const float x = acc[mi][ni][i] + bv;
          o[(size_t)row * 256 + col] = f2bf(x * sigmoidf_(1.5957691216057308f * (x + 0.044715f * x * x * x)));
        }
      }
  }
};
template <int transposed> struct EpiCmpOut {
  static constexpr bool PRE = false;
  bf16_t* o;
  DI void operator()(const f32x16 (&acc)[2][2], int m0, int n0) const {
    const int tid = TIDX, lane = tid & 63, wid = tid >> 6, wr = wid >> 1, wc = wid & 1, r = lane & 31, h = lane >> 5;
    if (wc != 0) return;
#pragma unroll
    for (int mi = 0; mi < 2; ++mi)
#pragma unroll
      for (int ni = 0; ni < 2; ++ni) {
        const int col = ni * 32 + r;
#pragma unroll
        for (int i = 0; i < 16; ++i) {
          const int row = m0 + wr * 64 + mi * 32 + crow(i, h);
          const bf16_t v = f2bf(acc[mi][ni][i]);
          if (transposed) o[(size_t)(row >> 8) * 16384 + vfrag_idx(row & 255, col)] = v;
          else o[(size_t)(row >> 8) * 16384 + kfrag_idx(row & 255, col)] = v;
        }
      }
  }
};
struct EpiWin {
  static constexpr bool PRE = false;
  char* ws;
  DI void operator()(const f32x16 (&acc)[2][2], int m0, int n0) const {
    const int tid = TIDX, lane = tid & 63, wid = tid >> 6, wr = wid >> 1, wc = wid & 1, r = lane & 31, h = lane >> 5;
    const int cidx = (n0 >> 6) + wc;
    if (cidx >= 49) return;
    const int rowbase = m0 + wr * 64;
    const int b = rowbase >> 12;
    int kind;
    bf16_t* base; int ld = 0, colb = 0, hb = 0, dil = 1; bool kfrag = false;
    if (cidx < 6) { kind = 0; base = (bf16_t*)(ws + OFF_QN); ld = 384; colb = cidx * 64; }
    else if (cidx < 18) { const int t = (cidx - 6) >> 1, g = (cidx - 6) & 1; hb = b * 2 + g;
      const size_t off = (t == 0) ? OFF_KCMP : (t == 1) ? OFF_VCMP : (t == 2) ? OFF_KSEL : (t == 3) ? OFF_VSELT : (t == 4) ? OFF_KWIN : OFF_VWINT;
      base = (bf16_t*)(ws + off); kind = (t == 3 || t == 5) ? 2 : 1; kfrag = (t == 2 || t == 4); }
    else if (cidx < 22) { kind = 0; base = (bf16_t*)(ws + OFF_QM); ld = 256; colb = (cidx - 18) * 64; }
    else if (cidx < 26) { kind = 1; kfrag = true; base = (bf16_t*)(ws + OFF_KM); hb = b * 4 + (cidx - 22); }
    else if (cidx < 30) { kind = 2; base = (bf16_t*)(ws + OFF_VMT); hb = b * 4 + (cidx - 26); }
    else if (cidx < 36) { kind = 0; base = (bf16_t*)(ws + OFF_QD); ld = 384; colb = (cidx - 30) * 64; }
    else if (cidx < 42) { kind = 1; kfrag = true; base = (bf16_t*)(ws + OFF_KD); hb = b * 6 + (cidx - 36); const int g = (cidx - 36) >> 1; dil = (g == 0) ? 1 : (g == 1 ? 4 : 16); }
    else if (cidx < 48) { kind = 2; base = (bf16_t*)(ws + OFF_VDT); hb = b * 6 + (cidx - 42); const int g = (cidx - 42) >> 1; dil = (g == 0) ? 1 : (g == 1 ? 4 : 16); }
    else { kind = 3; base = nullptr; }
    if (kind == 0) {
#pragma unroll
      for (int mi = 0; mi < 2; ++mi)
#pragma unroll
        for (int ni = 0; ni < 2; ++ni)
#pragma unroll
          for (int i = 0; i < 16; ++i) {
            const int row = rowbase + mi * 32 + crow(i, h);
            base[(size_t)row * ld + colb + ni * 32 + r] = f2bf(acc[mi][ni][i] * 0.18033688011112042f);
          }
    } else if (kind == 1) {
#pragma unroll
      for (int mi = 0; mi < 2; ++mi)
#pragma unroll
        for (int ni = 0; ni < 2; ++ni)
#pragma unroll
          for (int i = 0; i < 16; ++i) {
            const int s = (rowbase & 4095) + mi * 32 + crow(i, h);
            if (kfrag) { const int pos = (dil == 1) ? s : (s % dil) * (4096 / dil) + s / dil; base[(size_t)hb * 262144 + kfrag_idx(pos, ni * 32 + r)] = f2bf(acc[mi][ni][i]); }
            else base[((size_t)hb * 4096 + s) * 64 + ni * 32 + r] = f2bf(acc[mi][ni][i]);
          }
    } else if (kind == 2) {
      if (dil == 1) {
#pragma unroll
        for (int mi = 0; mi < 2; ++mi)
#pragma unroll
          for (int ni = 0; ni < 2; ++ni)
#pragma unroll
            for (int q = 0; q < 4; ++q) {
              const int s = (rowbase & 4095) + mi * 32 + 8 * q + 4 * h;
              u32x2 v; v.x = pack2(acc[mi][ni][4 * q], acc[mi][ni][4 * q + 1]); v.y = pack2(acc[mi][ni][4 * q + 2], acc[mi][ni][4 * q + 3]);
              *(u32x2*)(base + (size_t)hb * 262144 + vfrag_idx(s, ni * 32 + r)) = v;
            }
      } else {
        const int L = 4096 / dil;
#pragma unroll
        for (int mi = 0; mi < 2; ++mi)
#pragma unroll
          for (int ni = 0; ni < 2; ++ni)
#pragma unroll
            for (int i = 0; i < 16; ++i) {
              const int s = (rowbase & 4095) + mi * 32 + crow(i, h);
              const int pos = (s % dil) * L + s / dil;
              base[(size_t)hb * 262144 + vfrag_idx(pos, ni * 32 + r)] = f2bf(acc[mi][ni][i]);
            }
      }
    } else {
      float* gt = (float*)(ws + OFF_GATES);
      if (r < 18) {
#pragma unroll
        for (int mi = 0; mi < 2; ++mi)
#pragma unroll
          for (int i = 0; i < 16; ++i) {
            const int row = rowbase + mi * 32 + crow(i, h);
            gt[(size_t)row * 18 + r] = sigmoidf_(acc[mi][0][i]);
          }
      }
    }
  }
};

template <class Epi>
DI void gemm_phase(const bf16_t* A, int lda, const bf16_t* Bt, int ldb, int K, int MT, int NTl, int SN, const Epi& epi, char* lds, bool rev = false) {
  const int lmax = tile_lmax(MT, NTl, SN);
  int L = blockIdx.x, mt = 0, nt = 0;
  bool have = false;
  for (; L < lmax; L += gridDim.x) if (tile_map(L, MT, NTl, SN, mt, nt)) { have = true; if (rev) mt = MT - 1 - mt; break; }
  f32x16 dummy[2][2];
  if (have) gemm_core<1>(A + (size_t)mt * 256 * lda, lda, Bt + (size_t)nt * 128 * ldb, ldb, K, dummy, lds);
  while (have) {
    f32x16 acc[2][2];
    zero_acc(acc);
    const int cmt = mt, cnt = nt;
    float rv[Epi::PRE ? 2 : 1][2][16];
    if constexpr (Epi::PRE) epi.pre(rv, cmt * 256, cnt * 128);
    gemm_core<2>(A + (size_t)cmt * 256 * lda, lda, Bt + (size_t)cnt * 128 * ldb, ldb, K, acc, lds);
    have = false;
    for (L += gridDim.x; L < lmax; L += gridDim.x) if (tile_map(L, MT, NTl, SN, mt, nt)) { have = true; if (rev) mt = MT - 1 - mt; break; }
    if (have) gemm_core<1>(A + (size_t)mt * 256 * lda, lda, Bt + (size_t)nt * 128 * ldb, ldb, K, dummy, lds);
    if constexpr (Epi::PRE) epi(acc, cmt * 256, cnt * 128, rv); else epi(acc, cmt * 256, cnt * 128);
  }
}

struct ConvD { const float* src; const float* src2; bf16_t* dst; int K, Nsrc, Nout, mode, coloff, nvalid; };
constexpr int CONV_NT[14] = {1408, 704, 1408, 704, 800, 768, 128, 128, 8, 8, 96, 64, 32, 256};
constexpr int CONV_PER_LAYER = 6512;

DI ConvD get_conv(const Params& p, int l, int id) {
  ConvD c; c.src2 = nullptr; c.mode = 0; c.coloff = 0;
  bf16_t* wl = (bf16_t*)(p.ws + OFF_W) + (size_t)l * W_LAYER;
  switch (id) {
    case 0: c.src = p.in[I_F1G] + (size_t)l * 1024 * DFF; c.src2 = p.in[I_F1U] + (size_t)l * 1024 * DFF; c.dst = wl + OW_GU1; c.K = 1024; c.Nsrc = DFF; c.Nout = 5632; c.mode = 1; c.nvalid = 5632; break;
    case 1: c.src = p.in[I_F1D] + (size_t)l * DFF * 1024; c.dst = wl + OW_DN1; c.K = DFF; c.Nsrc = 1024; c.Nout = 1024; c.nvalid = 1024; break;
    case 2: c.src = p.in[I_F2G] + (size_t)l * 1024 * DFF; c.src2 = p.in[I_F2U] + (size_t)l * 1024 * DFF; c.dst = wl + OW_GU2; c.K = 1024; c.Nsrc = DFF; c.Nout = 5632; c.mode = 1; c.nvalid = 5632; break;
    case 3: c.src = p.in[I_F2D] + (size_t)l * DFF * 1024; c.dst = wl + OW_DN2; c.K = DFF; c.Nsrc = 1024; c.Nout = 1024; c.nvalid = 1024; break;
    case 4: c.src = p.in[I_WIN] + (size_t)l * 1024 * 6162; c.dst = wl + OW_INM; c.K = 1024; c.Nsrc = 6162; c.Nout = 3200; c.mode = 2; c.nvalid = 3090; break;
    case 5: c.src = p.in[I_WIN] + (size_t)l * 1024 * 6162; c.dst = wl + OW_ING; c.K = 1024; c.Nsrc = 6162; c.Nout = 3072; c.coloff = 3090; c.nvalid = 3072; break;
    case 6: c.src = p.in[I_PK1] + (size_t)l * 2048 * 256; c.dst = wl + OW_PK1; c.K = 2048; c.Nsrc = 256; c.Nout = 256; c.nvalid = 256; break;
    case 7: c.src = p.in[I_PV1] + (size_t)l * 2048 * 256; c.dst = wl + OW_PV1; c.K = 2048; c.Nsrc = 256; c.Nout = 256; c.nvalid = 256; break;
    case 8: c.src = p.in[I_PK2] + (size_t)l * 256 * 64; c.dst = wl + OW_PK2; c.K = 256; c.Nsrc = 64; c.Nout = 128; c.nvalid = 64; break;
    case 9: c.src = p.in[I_PV2] + (size_t)l * 256 * 64; c.dst = wl + OW_PV2; c.K = 256; c.Nsrc = 64; c.Nout = 128; c.nvalid = 64; break;
    case 10: c.src = p.in[I_UA] + (size_t)l * 384 * 1024; c.dst = wl + OW_UA; c.K = 384; c.Nsrc = 1024; c.Nout = 1024; c.nvalid = 1024; break;
    case 11: c.src = p.in[I_UB] + (size_t)l * 256 * 1024; c.dst = wl + OW_UB; c.K = 256; c.Nsrc = 1024; c.Nout = 1024; c.nvalid = 1024; break;
    case 12: c.src = p.in[I_UC] + (size_t)l * 128 * 1024; c.dst = wl + OW_UC; c.K = 128; c.Nsrc = 1024; c.Nout = 1024; c.nvalid = 1024; break;
    default: c.src = p.in[I_WO] + (size_t)l * 1024 * 1024; c.dst = wl + OW_WO; c.K = 1024; c.Nsrc = 1024; c.Nout = 1024; c.nvalid = 1024; break;
  }
  return c;
}

DI void conv_tile(const ConvD& c, int tn, int tk, float* lds) {
  const int tid = TIDX;
  const int n0 = tn * 64, k0 = tk * 64;
  {
    const int j = tid & 63, np = n0 + j;
    const float* sp = c.src; int col = -1;
    if (c.mode == 0) { if (np < c.nvalid) col = c.coloff + np; }
    else if (c.mode == 1) { const int tile = np >> 7, within = np & 127, wc = within >> 6, part = (within & 63) >> 5, jj = within & 31;
      col = tile * 64 + wc * 32 + jj; if (part) sp = c.src2; }
    else { if (np < 1152) col = np; else if (np < 3072) col = 1170 + (np - 1152); else if (np < 3090) col = 1152 + (np - 3072); }
    float tv[8];
#pragma unroll
    for (int i = 0; i < 8; ++i) {
      const int kk = (tid >> 6) + 8 * i;
      tv[i] = (col >= 0) ? sp[(size_t)(k0 + kk) * c.Nsrc + col] : 0.f;
    }
#pragma unroll
    for (int i = 0; i < 8; ++i) lds[((tid >> 6) + 8 * i) * 65 + j] = tv[i];
  }
  __syncthreads();
  {
    const int kk = tid & 63;
#pragma unroll
    for (int i = 0; i < 8; ++i) {
      const int j = (tid >> 6) + 8 * i;
      c.dst[(size_t)(n0 + j) * c.K + k0 + kk] = f2bf(lds[kk * 65 + j]);
    }
  }
  __syncthreads();
}

DI void rms_phase(const float* x, const float* gain, bf16_t* hn) {
  const int lane = TIDX & 63;
  const int gw = blockIdx.x * 8 + (TIDX >> 6), nw = gridDim.x * 8;
  f32x4 g[4];
#pragma unroll
  for (int i = 0; i < 4; ++i) g[i] = *(const f32x4*)(gain + i * 256 + lane * 4);
  for (int row = gw; row < NT; row += 2 * nw) {
    const int row2 = (row + nw < NT) ? row + nw : row;
    f32x4 v[4], w2[4]; float ss = 0.f, ss2 = 0.f;
#pragma unroll
    for (int i = 0; i < 4; ++i) { v[i] = *(const f32x4*)(x + (size_t)row * DM + i * 256 + lane * 4); w2[i] = *(const f32x4*)(x + (size_t)row2 * DM + i * 256 + lane * 4); }
#pragma unroll
    for (int i = 0; i < 4; ++i) { ss += v[i][0] * v[i][0] + v[i][1] * v[i][1] + v[i][2] * v[i][2] + v[i][3] * v[i][3]; ss2 += w2[i][0] * w2[i][0] + w2[i][1] * w2[i][1] + w2[i][2] * w2[i][2] + w2[i][3] * w2[i][3]; }
#pragma unroll
    for (int o = 32; o >= 1; o >>= 1) { ss += __shfl_xor(ss, o); ss2 += __shfl_xor(ss2, o); }
    const float rs = rsqrtf(ss * (1.f / 1024.f) + 1e-6f), rs2 = rsqrtf(ss2 * (1.f / 1024.f) + 1e-6f);
#pragma unroll
    for (int i = 0; i < 4; ++i) {
      u32x2 w; w.x = pack2(v[i][0] * rs * g[i][0], v[i][1] * rs * g[i][1]); w.y = pack2(v[i][2] * rs * g[i][2], v[i][3] * rs * g[i][3]);
      *(u32x2*)(hn + (size_t)row * DM + i * 256 + lane * 4) = w;
      u32x2 w3; w3.x = pack2(w2[i][0] * rs2 * g[i][0], w2[i][1] * rs2 * g[i][1]); w3.y = pack2(w2[i][2] * rs2 * g[i][2], w2[i][3] * rs2 * g[i][3]);
      *(u32x2*)(hn + (size_t)row2 * DM + i * 256 + lane * 4) = w3;
    }
  }
}
DI void final_norm_phase(float* x, const float* gain) {
  const int lane = TIDX & 63;
  const int gw = blockIdx.x * 8 + (TIDX >> 6), nw = gridDim.x * 8;
  f32x4 g[4];
#pragma unroll
  for (int i = 0; i < 4; ++i) g[i] = *(const f32x4*)(gain + i * 256 + lane * 4);
  for (int row = gw; row < NT; row += nw) {
    f32x4 v[4]; float ss = 0.f;
#pragma unroll
    for (int i = 0; i < 4; ++i) { v[i] = *(const f32x4*)(x + (size_t)row * DM + i * 256 + lane * 4); ss += v[i][0] * v[i][0] + v[i][1] * v[i][1] + v[i][2] * v[i][2] + v[i][3] * v[i][3]; }
#pragma unroll
    for (int o = 32; o >= 1; o >>= 1) ss += __shfl_xor(ss, o);
    const float rs = rsqrtf(ss * (1.f / 1024.f) + 1e-6f);
#pragma unroll
    for (int i = 0; i < 4; ++i) {
      f32x4 w; w[0] = v[i][0] * rs * g[i][0]; w[1] = v[i][1] * rs * g[i][1]; w[2] = v[i][2] * rs * g[i][2]; w[3] = v[i][3] * rs * g[i][3];
      *(f32x4*)(x + (size_t)row * DM + i * 256 + lane * 4) = w;
    }
  }
}

DI void phase0(const Params& p, char* lds) {
  if (blockIdx.x == 0 && TIDX < 64) { ((unsigned*)(p.ws + OFF_MISC))[TIDX] = 0u; ((unsigned*)(p.ws + OFF_MISC + 6144))[TIDX] = 0u; }
  for (int it = blockIdx.x; it < 4; it += gridDim.x) {
    const int l = it >> 1, kv = it & 1;
    const float* pe = p.in[kv ? I_PEV : I_PEK] + (size_t)l * 2048;
    const float* w = p.in[kv ? I_PV1 : I_PK1] + (size_t)l * 2048 * 256;
    const int n = TIDX;
    if (n < 256) {
      float s = 0.f;
      for (int k = 0; k < 2048; ++k) s += pe[k] * w[(size_t)k * 256 + n];
      ((float*)(p.ws + OFF_MISC + 256))[it * 256 + n] = s;
    }
  }
  for (int w = blockIdx.x; w < 2 * CONV_PER_LAYER; w += gridDim.x) {
    const int l = w / CONV_PER_LAYER; int ww = w % CONV_PER_LAYER; int id = 0;
#pragma unroll
    for (int i = 0; i < 14; ++i) { if (id == i && ww >= CONV_NT[i]) { ww -= CONV_NT[i]; id = i + 1; } }
    const ConvD c = get_conv(p, l, id);
    const int ntn = c.Nout >> 6;
    conv_tile(c, ww % ntn, ww / ntn, (float*)lds);
  }
  rms_phase(p.in[I_X], p.in[I_F1N], (bf16_t*)(p.ws + OFF_HN));
}

constexpr int BK_THR[15] = {22, 30, 40, 54, 73, 99, 134, 182, 246, 332, 450, 609, 825, 1117, 1513};
struct AttnSt { float m, l; f32x16 o0, o1; };
DI void attn_init(AttnSt& st) { st.m = NEGINF; st.l = 0.f;
#pragma unroll
  for (int i = 0; i < 16; ++i) { st.o0[i] = 0.f; st.o1[i] = 0.f; } }

DI void load_q(bf16x8 (&qf)[4], const bf16_t* qrow) {
#pragma unroll
  for (int s = 0; s < 4; ++s) qf[s] = *(const bf16x8*)(qrow + 16 * s);
}
DI f32x16 qk_tile(const bf16x8 (&qf)[4], const bf16_t* krow) {
  f32x16 s;
#pragma unroll
  for (int i = 0; i < 16; ++i) s[i] = 0.f;
#pragma unroll
  for (int ss = 0; ss < 4; ++ss) { const bf16x8 kf = *(const bf16x8*)(krow + 512 * ss); s = MFMA32(kf, qf[ss], s); }
  return s;
}
DI void pv_tile(AttnSt& st, const float (&pr)[16], const bf16_t* v0, size_t rowstride) {
#pragma unroll
  for (int s2 = 0; s2 < 2; ++s2) {
    u32x4 pk; pk.x = pack2(pr[8 * s2], pr[8 * s2 + 1]); pk.y = pack2(pr[8 * s2 + 2], pr[8 * s2 + 3]); pk.z = pack2(pr[8 * s2 + 4], pr[8 * s2 + 5]); pk.w = pack2(pr[8 * s2 + 6], pr[8 * s2 + 7]);
    const bf16x8 pb = __builtin_bit_cast(bf16x8, pk);
    {
      const s16x4 lo = *(const s16x4*)(v0 + 256 * (s2 * 4 + 0)), hi = *(const s16x4*)(v0 + 256 * (s2 * 4 + 1));
      const bf16x8 va = __builtin_shufflevector(lo, hi, 0, 1, 2, 3, 4, 5, 6, 7);
      st.o0 = MFMA32(va, pb, st.o0);
    }
    {
      const s16x4 lo = *(const s16x4*)(v0 + 256 * (s2 * 4 + 2)), hi = *(const s16x4*)(v0 + 256 * (s2 * 4 + 3));
      const bf16x8 va = __builtin_shufflevector(lo, hi, 0, 1, 2, 3, 4, 5, 6, 7);
      st.o1 = MFMA32(va, pb, st.o1);
    }
  }
}
DI void softmax_step(AttnSt& st, const float (&lg)[16], const bf16_t* v0, size_t rowstride) {
  float mx = NEGINF;
#pragma unroll
  for (int i = 0; i < 16; ++i) mx = fmaxf(mx, lg[i]);
  mx = fmaxf(mx, shx32(mx));
  if (__ballot(mx > NEGINF) == 0ull) return;
  const float mnew = fmaxf(st.m, mx);
  const float muse = (mnew == NEGINF) ? 0.f : mnew;
  const float alpha = ex2(st.m - muse);
  float pr[16]; float rs = 0.f;
#pragma unroll
  for (int i = 0; i < 16; ++i) { pr[i] = ex2(lg[i] - muse); rs += pr[i]; }
  st.l = st.l * alpha + rs; st.m = mnew;
#pragma unroll
  for (int i = 0; i < 16; ++i) { st.o0[i] *= alpha; st.o1[i] *= alpha; }
  pv_tile(st, pr, v0, rowstride);
}

struct KVT { bf16x8 k[4]; s16x4 v[8]; };
DI void load_kv(KVT& t, const bf16_t* krow, const bf16_t* v0, size_t rowstride) {
#pragma unroll
  for (int ss = 0; ss < 4; ++ss) t.k[ss] = *(const bf16x8*)(krow + 512 * ss);
#pragma unroll
  for (int j = 0; j < 8; ++j) t.v[j] = *(const s16x4*)(v0 + 256 * j);
}
DI void softmax_step_r(AttnSt& st, const float (&lg)[16], const KVT& t) {
  float mx = NEGINF;
#pragma unroll
  for (int i = 0; i < 16; ++i) mx = fmaxf(mx, lg[i]);
  mx = fmaxf(mx, shx32(mx));
  if (__ballot(mx > NEGINF) == 0ull) return;
  const float mnew = fmaxf(st.m, mx);
  const float muse = (mnew == NEGINF) ? 0.f : mnew;
  const float alpha = ex2(st.m - muse);
  float pr[16]; float rs = 0.f;
#pragma unroll
  for (int i = 0; i < 16; ++i) { pr[i] = ex2(lg[i] - muse); rs += pr[i]; }
  st.l = st.l * alpha + rs;
  if (__ballot(mnew != st.m) != 0ull) {
#pragma unroll
    for (int i = 0; i < 16; ++i) { st.o0[i] *= alpha; st.o1[i] *= alpha; }
  }
  st.m = mnew;
#pragma unroll
  for (int s2 = 0; s2 < 2; ++s2) {
    u32x4 pk; pk.x = pack2(pr[8 * s2], pr[8 * s2 + 1]); pk.y = pack2(pr[8 * s2 + 2], pr[8 * s2 + 3]); pk.z = pack2(pr[8 * s2 + 4], pr[8 * s2 + 5]); pk.w = pack2(pr[8 * s2 + 6], pr[8 * s2 + 7]);
    const bf16x8 pb = __builtin_bit_cast(bf16x8, pk);
    const bf16x8 va0 = __builtin_shufflevector(t.v[s2 * 4 + 0], t.v[s2 * 4 + 1], 0, 1, 2, 3, 4, 5, 6, 7);
    st.o0 = MFMA32(va0, pb, st.o0);
    const bf16x8 va1 = __builtin_shufflevector(t.v[s2 * 4 + 2], t.v[s2 * 4 + 3], 0, 1, 2, 3, 4, 5, 6, 7);
    st.o1 = MFMA32(va1, pb, st.o1);
  }
}
template <class KP, class VP, class ACT, class FILL>
DI void attn_loop(AttnSt& st, const bf16x8 (&qf)[4], int k0, int k1, size_t vstride, KP kp, VP vp, ACT act, FILL fill) {
  KVT cur, nxt;
  {
    KVT t0; load_kv(t0, kp(k0), vp(k0), vstride);
#pragma unroll
    for (int i = 0; i < 8; ++i) cur.v[i] = t0.v[i];
#pragma unroll
    for (int i = 0; i < 4; ++i) cur.k[i] = t0.k[i];
  }
  f32x16 s_cur;
  { const float z = 0.f;
#pragma unroll
    for (int i = 0; i < 16; ++i) s_cur[i] = z; }
#pragma unroll
  for (int ss = 0; ss < 4; ++ss) s_cur = MFMA32(cur.k[ss], qf[ss], s_cur);
  {
    const int kn = (k0 < k1) ? k0 + 1 : k1;
    const bf16_t* krow = kp(kn);
#pragma unroll
    for (int ss = 0; ss < 4; ++ss) nxt.k[ss] = *(const bf16x8*)(krow + 512 * ss);
  }
  for (int kt = k0; kt <= k1; ++kt) {
    const int kn = (kt < k1) ? kt + 1 : k1;
    const int kn2 = (kt + 2 <= k1) ? kt + 2 : k1;
    {
      const bf16_t* v0 = vp(kn);
#pragma unroll
      for (int j = 0; j < 8; ++j) nxt.v[j] = *(const s16x4*)(v0 + 256 * j);
    }
    bf16x8 k2[4];
    {
      const bf16_t* krow = kp(kn2);
#pragma unroll
      for (int ss = 0; ss < 4; ++ss) k2[ss] = *(const bf16x8*)(krow + 512 * ss);
    }
    f32x16 s_next;
#pragma unroll
    for (int i = 0; i < 16; ++i) s_next[i] = 0.f;
#pragma unroll
    for (int ss = 0; ss < 4; ++ss) s_next = MFMA32(nxt.k[ss], qf[ss], s_next);
    if (act(kt)) {
      float lg[16];
      fill(kt, s_cur, lg);
      softmax_step_r(st, lg, cur);
    }
    s_cur = s_next;
#pragma unroll
    for (int i = 0; i < 8; ++i) cur.v[i] = nxt.v[i];
#pragma unroll
    for (int ss = 0; ss < 4; ++ss) nxt.k[ss] = k2[ss];
  }
}

DI float lut_bias(const unsigned char* blut, const float* tblh, int dist) {
  const int d = dist < 0 ? 0 : (dist > 2048 ? 2048 : dist);
  return tblh[blut[d]];
}
DI void bias16(const unsigned char* blut, const float* tblh, const int (&dist)[16], float (&bv)[16]) {
  int bk[16];
#pragma unroll
  for (int i = 0; i < 16; ++i) { const int d = dist[i] < 0 ? 0 : (dist[i] > 2048 ? 2048 : dist[i]); bk[i] = blut[d]; }
#pragma unroll
  for (int i = 0; i < 16; ++i) asm volatile("" : "+v"(bk[i]));
#pragma unroll
  for (int i = 0; i < 16; ++i) bv[i] = tblh[bk[i]];
#pragma unroll
  for (int i = 0; i < 16; ++i) asm volatile("" : "+v"(bv[i]));
}
DI void store_o(bf16_t* dst, const f32x16& o0, const f32x16& o1, int h) {
#pragma unroll
  for (int g = 0; g < 4; ++g) {
    u32x2 a; a.x = pack2(o0[4 * g], o0[4 * g + 1]); a.y = pack2(o0[4 * g + 2], o0[4 * g + 3]);
    *(u32x2*)(dst + 8 * g + 4 * h) = a;
    u32x2 b; b.x = pack2(o1[4 * g], o1[4 * g + 1]); b.y = pack2(o1[4 * g + 2], o1[4 * g + 3]);
    *(u32x2*)(dst + 32 + 8 * g + 4 * h) = b;
  }
}

DI void build_lut(unsigned char* blut, float* tbl, const float* rel_bias) {
  for (int n = TIDX; n < 2049; n += NTHREADS) {
    int bk = n;
    if (n >= 16) { bk = 16;
#pragma unroll
      for (int k = 0; k < 15; ++k) bk += (n >= BK_THR[k]) ? 1 : 0; }
    blut[n] = (unsigned char)bk;
  }
  for (int i = TIDX; i < 512; i += NTHREADS) { const int hd = i >> 5, bk = i & 31; tbl[i] = rel_bias[bk * 16 + hd] * 1.4426950408889634f; }
  __syncthreads();
}

DI int wave_fetch(unsigned* ctr) {
  int v = 0;
  if ((TIDX & 63) == 0) v = (int)atomicAdd(ctr, 1u);
  return __shfl(v, 0);
}

DI void nsa_cmp_item(const Params& p, int item, const unsigned char* blut, const float* tbl, float* impw) {
  const int lane = TIDX & 63, r = lane & 31, h = lane >> 5;
  const int qb = 127 - (item >> 4), bg = item & 15, b = bg >> 1, g = bg & 1;
  const int t = qb * 32 + r;
  const int ntile = (qb >> 4) + 1;
  const bf16_t* KC = (const bf16_t*)(p.ws + OFF_KC) + (size_t)bg * 256 * 64;
  const bf16_t* VCT = (const bf16_t*)(p.ws + OFF_VCT) + (size_t)bg * 64 * 256;
  const float* gates = (const float*)(p.ws + OFF_GATES) + (size_t)(b * 4096 + t) * 18;
#pragma unroll 4
  for (int j = 0; j < 32; ++j) impw[r * 65 + 2 * j + h] = 0.f;
  for (int rr = 0; rr < 3; ++rr) {
    const int head = g * 3 + rr;
    const float* tblh = tbl + head * 32;
    bf16x8 qf[4];
    load_q(qf, (const bf16_t*)(p.ws + OFF_QN) + (size_t)(b * 4096 + t) * 384 + head * 64 + 8 * h);
    float m = NEGINF, l = 0.f;
    for (int kt = 0; kt < ntile; ++kt) {
      const f32x16 s = qk_tile(qf, KC + (size_t)kt * 2048 + (h * 32 + r) * 8);
      float lg[16]; float mx = NEGINF;
      int dist[16]; float bv[16];
#pragma unroll
      for (int i = 0; i < 16; ++i) dist[i] = t - (16 * (kt * 32 + crow(i, h)) + 31);
      bias16(blut, tblh, dist, bv);
#pragma unroll
      for (int i = 0; i < 16; ++i) { lg[i] = (dist[i] >= 0) ? s[i] + bv[i] : NEGINF; mx = fmaxf(mx, lg[i]); }
      mx = fmaxf(mx, shx32(mx));
      const float mnew = fmaxf(m, mx), muse = (mnew == NEGINF) ? 0.f : mnew;
      float rs = 0.f;
#pragma unroll
      for (int i = 0; i < 16; ++i) rs += ex2(lg[i] - muse);
      l = l * ex2(m - muse) + rs; m = mnew;
    }
    l += shx32(l);
    const float muse = (m == NEGINF) ? 0.f : m;
    const float inv = (l > 0.f) ? 1.f / l : 0.f;
    AttnSt st; attn_init(st);
    float prev3 = 0.f;
#pragma unroll 1
    for (int kt = 0; kt < ntile; ++kt) {
      {
        const f32x16 s = qk_tile(qf, KC + (size_t)kt * 2048 + (h * 32 + r) * 8);
        float pr[16];
        int dist[16]; float bv[16];
#pragma unroll
        for (int i = 0; i < 16; ++i) dist[i] = t - (16 * (kt * 32 + crow(i, h)) + 31);
        bias16(blut, tblh, dist, bv);
#pragma unroll
        for (int i = 0; i < 16; ++i) pr[i] = (dist[i] >= 0) ? ex2(s[i] + bv[i] - muse) * inv : 0.f;
        float recv[4];
#pragma unroll
        for (int q = 0; q < 4; ++q) recv[q] = shx32(pr[4 * q + 3]);
#pragma unroll
        for (int q = 0; q < 4; ++q) {
          const float qs = (pr[4 * q] + pr[4 * q + 1]) + (pr[4 * q + 2] + pr[4 * q + 3]);
          const float cin = h ? recv[q] : (q ? recv[q > 0 ? q - 1 : 0] : prev3);
          impw[r * 65 + 8 * kt + 2 * q + h] += qs + cin;
        }
        prev3 = recv[3];
        pv_tile(st, pr, VCT + (size_t)kt * 2048 + (h * 32 + r) * 4, 256);
      }
    }
    const float g0 = gates[head * 3 + 0];
#pragma unroll
    for (int i = 0; i < 16; ++i) { st.o0[i] *= g0; st.o1[i] *= g0; }
    store_o((bf16_t*)(p.ws + OFF_OC) + (size_t)(b * 4096 + t) * 384 + head * 64, st.o0, st.o1, h);
  }
  const int cur = t >> 6;
  unsigned long long mask;
  if (cur < 16) {
    mask = (2ull << cur) - 1ull;
  } else {
    float own[32], oth[32];
#pragma unroll
    for (int j = 0; j < 32; ++j) {
      const int u = 2 * j + h, uo = 2 * j + 1 - h;
      const float a = impw[r * 65 + u], bb = impw[r * 65 + uo];
      own[j] = ((u >= 1) && (u <= cur - 2)) ? a : -1.f;
      oth[j] = ((uo >= 1) && (uo <= cur - 2)) ? bb : -1.f;
    }
    float prev = __builtin_inff();
#pragma unroll 1
    for (int round = 0; round < 13; ++round) {
      float m = -2.f;
#pragma unroll
      for (int j = 0; j < 32; ++j) { m = fmaxf(m, own[j] < prev ? own[j] : -2.f); m = fmaxf(m, oth[j] < prev ? oth[j] : -2.f); }
      prev = m;
    }
    unsigned mlo = 0u, mhi = 0u;
#pragma unroll
    for (int j = 0; j < 32; ++j) {
      const int u = 2 * j + h;
      const bool forced = (u == 0) || (u == cur) || (u == cur - 1);
      const bool cand = (u >= 1) && (u <= cur - 2);
      const bool sel = forced || (cand && own[j] >= prev);
      if (j < 16) mlo |= sel ? (1u << u) : 0u; else mhi |= sel ? (1u << (u - 32)) : 0u;
    }
    mlo |= (unsigned)shx32i((int)mlo);
    mhi |= (unsigned)shx32i((int)mhi);
    mask = ((unsigned long long)mhi << 32) | mlo;
  }
  if (h == 0) ((unsigned long long*)(p.ws + OFF_SELM))[(size_t)bg * 4096 + t] = mask;
}

DI void nsa_win_item(const Params& p, int b, int head, int qb, const unsigned char* blut, const float* tbl) {
  const int lane = TIDX & 63, r = lane & 31, h = lane >> 5;
  const int g = head / 3, bg = b * 2 + g;
  const int t = qb * 32 + r;
  const float* tblh = tbl + head * 32;
  bf16x8 qf[4];
  load_q(qf, (const bf16_t*)(p.ws + OFF_QN) + (size_t)(b * 4096 + t) * 384 + head * 64 + 8 * h);
  const float g2 = ((const float*)(p.ws + OFF_GATES))[(size_t)(b * 4096 + t) * 18 + head * 3 + 2];
  f32x16 y0, y1;
#pragma unroll
  for (int i = 0; i < 16; ++i) { y0[i] = 0.f; y1[i] = 0.f; }
  {
    const bf16_t* K = (const bf16_t*)(p.ws + OFF_KWIN) + (size_t)bg * 4096 * 64;
    const bf16_t* Vt = (const bf16_t*)(p.ws + OFF_VWINT) + (size_t)bg * 64 * 4096;
    AttnSt st; attn_init(st);
    const int k0 = qb >= 16 ? qb - 16 : 0;
    attn_loop(st, qf, k0, qb, 32,
      [&](int kt) { return K + (size_t)kt * 2048 + (h * 32 + r) * 8; },
      [&](int kt) { return Vt + (size_t)kt * 2048 + (h * 32 + r) * 4; },
      [&](int kt) { return true; },
      [&](int kt, const f32x16& s, float (&lg)[16]) {
        int dist[16]; float bv[16];
#pragma unroll
        for (int i = 0; i < 16; ++i) dist[i] = t - (kt * 32 + crow(i, h));
        bias16(blut, tblh, dist, bv);
#pragma unroll
        for (int i = 0; i < 16; ++i) lg[i] = (dist[i] >= 0 && dist[i] < 512) ? s[i] + bv[i] : NEGINF;
      });
    float l = st.l + shx32(st.l);
    const float sc = (l > 0.f) ? g2 / l : 0.f;
#pragma unroll
    for (int i = 0; i < 16; ++i) { y0[i] += sc * st.o0[i]; y1[i] += sc * st.o1[i]; }
  }
  store_o((bf16_t*)(p.ws + OFF_Y) + (size_t)(b * 4096 + t) * 768 + head * 64, y0, y1, h);
}

DI void nsa_main_item(const Params& p, int b, int head, int qb, const unsigned char* blut, const float* tbl) {
  const int lane = TIDX & 63, r = lane & 31, h = lane >> 5;
  const int g = head / 3, bg = b * 2 + g;
  const int t = qb * 32 + r;
  const float* tblh = tbl + head * 32;
  bf16x8 qf[4];
  load_q(qf, (const bf16_t*)(p.ws + OFF_QN) + (size_t)(b * 4096 + t) * 384 + head * 64 + 8 * h);
  const unsigned long long selm = ((const unsigned long long*)(p.ws + OFF_SELM))[(size_t)bg * 4096 + t];
  const float* gates = (const float*)(p.ws + OFF_GATES) + (size_t)(b * 4096 + t) * 18 + head * 3;
  const float g1 = gates[1];
  f32x16 y0, y1;
  {
    const bf16_t* oc = (const bf16_t*)(p.ws + OFF_OC) + (size_t)(b * 4096 + t) * 384 + head * 64;
    const bf16_t* yw = (const bf16_t*)(p.ws + OFF_Y) + (size_t)(b * 4096 + t) * 768 + head * 64;
#pragma unroll
    for (int i = 0; i < 16; ++i) { y0[i] = bf2f(oc[crow(i, h)]) + bf2f(yw[crow(i, h)]); y1[i] = bf2f(oc[32 + crow(i, h)]) + bf2f(yw[32 + crow(i, h)]); }
  }
  {
    const bf16_t* K = (const bf16_t*)(p.ws + OFF_KSEL) + (size_t)bg * 4096 * 64;
    const bf16_t* Vt = (const bf16_t*)(p.ws + OFF_VSELT) + (size_t)bg * 64 * 4096;
    AttnSt st; attn_init(st);
    attn_loop(st, qf, 0, qb, 32,
      [&](int kt) { return K + (size_t)kt * 2048 + (h * 32 + r) * 8; },
      [&](int kt) { return Vt + (size_t)kt * 2048 + (h * 32 + r) * 4; },
      [&](int kt) { return __ballot((selm >> (kt >> 1)) & 1ull) != 0ull; },
      [&](int kt, const f32x16& s, float (&lg)[16]) {
        const bool bs = (selm >> (kt >> 1)) & 1ull;
        if (qb * 32 - (kt * 32 + 31) >= 1513) {
          const float b31 = tblh[31];
#pragma unroll
          for (int i = 0; i < 16; ++i) lg[i] = bs ? s[i] + b31 : NEGINF;
        } else {
          int dist[16]; float bv[16];
#pragma unroll
          for (int i = 0; i < 16; ++i) dist[i] = t - (kt * 32 + crow(i, h));
          bias16(blut, tblh, dist, bv);
#pragma unroll
          for (int i = 0; i < 16; ++i) lg[i] = (bs && dist[i] >= 0) ? s[i] + bv[i] : NEGINF;
        }
      });
    float l = st.l + shx32(st.l);
    const float sc = (l > 0.f) ? g1 / l : 0.f;
#pragma unroll
    for (int i = 0; i < 16; ++i) { y0[i] += sc * st.o0[i]; y1[i] += sc * st.o1[i]; }
  }
  store_o((bf16_t*)(p.ws + OFF_Y) + (size_t)(b * 4096 + t) * 768 + head * 64, y0, y1, h);
}

DI void moba_item(const Params& p, int b, int hd, int qb, const unsigned char* blut, const float* tbl) {
  const int lane = TIDX & 63, r = lane & 31, h = lane >> 5;
  const int bh = b * 4 + hd;
  const int t = qb * 32 + r;
  const int c = qb >> 3;
  const float* tblh = tbl + (6 + hd) * 32;
  bf16x8 qf[4];
  load_q(qf, (const bf16_t*)(p.ws + OFF_QM) + (size_t)(b * 4096 + t) * 256 + hd * 64 + 8 * h);
  unsigned mmask = 0u;
  if (c > 0) {
    const bf16_t* km = (const bf16_t*)(p.ws + OFF_KMEAN) + (size_t)bh * 16 * 64 + (size_t)(r & 15) * 64 + 8 * h;
    f32x16 s;
#pragma unroll
    for (int i = 0; i < 16; ++i) s[i] = 0.f;
#pragma unroll
    for (int ss = 0; ss < 4; ++ss) {
      bf16x8 kf = *(const bf16x8*)(km + 16 * ss);
      if (r >= 16) {
#pragma unroll
        for (int j = 0; j < 8; ++j) kf[j] = 0;
      }
      s = MFMA32(kf, qf[ss], s);
    }
    float g16[16];
#pragma unroll
    for (int i = 0; i < 8; ++i) {
      const float own = s[i], oth = shx32(own);
      const int base = (i & 3) + 8 * (i >> 2);
      g16[base] = h ? oth : own;
      g16[base + 4] = h ? own : oth;
    }
#pragma unroll
    for (int n = 0; n < 16; ++n) g16[n] = (n < c) ? g16[n] : NEGINF;
#pragma unroll
    for (int round = 0; round < 3; ++round) {
      float best = NEGINF; int bi = -1;
#pragma unroll
      for (int n = 0; n < 16; ++n) if (g16[n] > best) { best = g16[n]; bi = n; }
      if (bi >= 0) mmask |= 1u << bi;
#pragma unroll
      for (int n = 0; n < 16; ++n) if (n == bi) g16[n] = NEGINF;
    }
  }
  mmask |= 1u << c;
  const bf16_t* K = (const bf16_t*)(p.ws + OFF_KM) + (size_t)bh * 4096 * 64;
  const bf16_t* Vt = (const bf16_t*)(p.ws + OFF_VMT) + (size_t)bh * 64 * 4096;
  AttnSt st; attn_init(st);
  attn_loop(st, qf, 0, qb, 32,
    [&](int kt) { return K + (size_t)kt * 2048 + (h * 32 + r) * 8; },
    [&](int kt) { return Vt + (size_t)kt * 2048 + (h * 32 + r) * 4; },
    [&](int kt) { return __ballot((mmask >> (kt >> 3)) & 1u) != 0ull; },
    [&](int kt, const f32x16& s, float (&lg)[16]) {
      const bool bs = (mmask >> (kt >> 3)) & 1u;
      if (qb * 32 - (kt * 32 + 31) >= 1513) {
        const float b31 = tblh[31];
#pragma unroll
        for (int i = 0; i < 16; ++i) lg[i] = bs ? s[i] + b31 : NEGINF;
      } else {
        int dist[16]; float bv[16];
#pragma unroll
        for (int i = 0; i < 16; ++i) dist[i] = t - (kt * 32 + crow(i, h));
        bias16(blut, tblh, dist, bv);
#pragma unroll
        for (int i = 0; i < 16; ++i) lg[i] = (bs && dist[i] >= 0) ? s[i] + bv[i] : NEGINF;
      }
    });
  float l = st.l + shx32(st.l);
  const float sc = (l > 0.f) ? 1.f / l : 0.f;
#pragma unroll
  for (int i = 0; i < 16; ++i) { st.o0[i] *= sc; st.o1[i] *= sc; }
  store_o((bf16_t*)(p.ws + OFF_Y) + (size_t)(b * 4096 + t) * 768 + 384 + hd * 64, st.o0, st.o1, h);
}

DI void dil_item(const Params& p, int b, int j, int qi, const unsigned char* blut, const float* tbl) {
  const int lane = TIDX & 63, r = lane & 31, h = lane >> 5;
  const int rho = qi & 15, ub = qi >> 4;
  const int t = rho + 16 * (ub * 32 + r);
  const int tmin = rho + 16 * (ub * 32), tmax = rho + 16 * (ub * 32 + 31);
  AttnSt st; attn_init(st);
#pragma unroll
  for (int g = 0; g < 3; ++g) {
    const int dil = (g == 0) ? 1 : (g == 1 ? 4 : 16), window = 128 * dil, L = 4096 / dil;
    const int hd = 2 * g + j;
    const float* tblh = tbl + (10 + hd) * 32;
    const int rg = rho % dil;
    bf16x8 qf[4];
    load_q(qf, (const bf16_t*)(p.ws + OFF_QD) + (size_t)(b * 4096 + t) * 384 + hd * 64 + 8 * h);
    const bf16_t* K = (const bf16_t*)(p.ws + OFF_KD) + (size_t)(b * 6 + hd) * 4096 * 64;
    const bf16_t* Vt = (const bf16_t*)(p.ws + OFF_VDT) + (size_t)(b * 6 + hd) * 64 * 4096 + (size_t)(rg * L >> 5) * 2048;
    int vlo = tmin / dil - 128; if (vlo < 0) vlo = 0;
    const int vhi = tmax / dil;
    attn_loop(st, qf, vlo >> 5, vhi >> 5, 32,
      [&](int kt) { return K + (size_t)((rg * L >> 5) + kt) * 2048 + (h * 32 + r) * 8; },
      [&](int kt) { return Vt + (size_t)kt * 2048 + (h * 32 + r) * 4; },
      [&](int kt) { return true; },
      [&](int kt, const f32x16& s, float (&lg)[16]) {
        int dist[16]; float bv[16];
#pragma unroll
        for (int i = 0; i < 16; ++i) dist[i] = t - ((kt * 32 + crow(i, h)) * dil + rg);
        bias16(blut, tblh, dist, bv);
#pragma unroll
        for (int i = 0; i < 16; ++i) lg[i] = (dist[i] >= 0 && dist[i] <= window) ? s[i] + bv[i] : NEGINF;
      });
  }
  float l = st.l + shx32(st.l);
  const float sc = (l > 0.f) ? 1.f / l : 0.f;
#pragma unroll
  for (int i = 0; i < 16; ++i) { st.o0[i] *= sc; st.o1[i] *= sc; }
  store_o((bf16_t*)(p.ws + OFF_Y) + (size_t)(b * 4096 + t) * 768 + 640 + j * 64, st.o0, st.o1, h);
}

DI void phaseX(const Params& p, int layer, char* lds, int rep = 0) {
  unsigned char* blut = (unsigned char*)lds; float* tbl = (float*)(lds + 4096);
  build_lut(blut, tbl, p.in[I_RELB]);
  unsigned* ctr = (unsigned*)(p.ws + OFF_MISC) + layer * 2 + rep * 8;
  for (;;) {
    const int item = wave_fetch(ctr);
    if (item >= 2048 + 64 * 48) break;
    if (item < 2048) nsa_cmp_item(p, item, blut, tbl, (float*)(lds + 8192) + (TIDX >> 6) * (32 * 65));
    else { const int it2 = item - 2048, qb = 63 - it2 / 48, sub = it2 % 48; nsa_win_item(p, sub / 6, sub % 6, qb, blut, tbl); }
  }
  __syncthreads();
}
DI void filler_items(const Params& p, int layer, char* lds, int which) {
  __syncthreads();
  unsigned char* blut = (unsigned char*)lds; float* tbl = (float*)(lds + 4096);
  build_lut(blut, tbl, p.in[I_RELB]);
  unsigned* ctr = (unsigned*)(p.ws + OFF_MISC) + 16 + layer * 2 + which;
  for (;;) {
    const int item = wave_fetch(ctr);
    if (which == 0) {
      if (item >= 128 * 16 + 64 * 48) break;
      if (item < 128 * 16) { const int qb = 127 - item / 16, sub = item % 16; dil_item(p, sub >> 1, sub & 1, qb, blut, tbl); }
      else { const int it2 = item - 128 * 16, qb = 127 - it2 / 48, sub = it2 % 48; nsa_win_item(p, sub / 6, sub % 6, qb, blut, tbl); }
    }
    else { if (item >= 128 * 32) break; const int qb = 127 - item / 32, sub = item % 32; moba_item(p, sub >> 2, sub & 3, qb, blut, tbl); }
  }
  __syncthreads();
}
DI void phaseY(const Params& p, int layer, char* lds, int rep = 0) {
  unsigned char* blut = (unsigned char*)lds; float* tbl = (float*)(lds + 4096);
  build_lut(blut, tbl, p.in[I_RELB]);
  unsigned* ctr = (unsigned*)(p.ws + OFF_MISC) + layer * 2 + 1 + rep * 8;
  for (;;) {
    const int item = wave_fetch(ctr);
    if (item >= 128 * 48) break;
    const int qb = 127 - item / 48, sub = item % 48;
    nsa_main_item(p, sub / 6, sub % 6, qb, blut, tbl);
  }
  __syncthreads();
}

DI void kmean_phase(const Params& p) {
  const int lane = TIDX & 63;
  const int gw = blockIdx.x * 8 + (TIDX >> 6), nw = gridDim.x * 8;
  const bf16_t* KM = (const bf16_t*)(p.ws + OFF_KM);
  bf16_t* o = (bf16_t*)(p.ws + OFF_KMEAN);
  for (int it = gw; it < 512; it += nw) {
    const bf16_t* src = KM + (size_t)it * 256 * 64;
    float s = 0.f;
    for (int k = 0; k < 256; ++k) s += bf2f(KM[(size_t)(it >> 4) * 262144 + kfrag_idx((it & 15) * 256 + k, lane)]);
    o[it * 64 + lane] = f2bf(s * (1.f / 256.f));
  }
}

DI void merge_phase(const Params& p, int layer, char* lds) {
  const bf16_t* wl = (const bf16_t*)(p.ws + OFF_W) + (size_t)layer * W_LAYER;
  const bf16_t* hn = (const bf16_t*)(p.ws + OFF_HN);
  const bf16_t* y = (const bf16_t*)(p.ws + OFF_Y);
  bf16_t* mg = (bf16_t*)(p.ws + OFF_MERGED);
  const int lmax = tile_lmax(128, 8, 4);
  for (int L = blockIdx.x; L < lmax; L += gridDim.x) {
    int mt, nt;
    if (!tile_map(L, 128, 8, 4, mt, nt)) continue;
    f32x16 macc[2][2];
    zero_acc(macc);
#pragma unroll 1
    for (int br = 0; br < 3; ++br) {
      const int kw = (br == 0) ? 384 : (br == 1 ? 256 : 128);
      const int yo = (br == 0) ? 0 : (br == 1 ? 384 : 640);
      const bf16_t* wu = wl + ((br == 0) ? OW_UA : (br == 1 ? OW_UB : OW_UC));
      unsigned sg[2][2][8];
      {
        f32x16 ag[2][2];
        zero_acc(ag);
        gemm_core(hn + (size_t)mt * 256 * 1024, 1024, wl + OW_ING + (size_t)(br * 1024 + nt * 128) * 1024, 1024, 1024, ag, lds);
#pragma unroll
        for (int a = 0; a < 2; ++a)
#pragma unroll
          for (int c = 0; c < 2; ++c)
#pragma unroll
            for (int i = 0; i < 8; ++i) sg[a][c][i] = pack2(sigmoidf_(ag[a][c][2 * i]), sigmoidf_(ag[a][c][2 * i + 1]));
      }
      f32x16 au[2][2];
      zero_acc(au);
      gemm_core(y + (size_t)mt * 256 * 768 + yo, 768, wu + (size_t)nt * 128 * kw, kw, kw, au, lds);
#pragma unroll
      for (int a = 0; a < 2; ++a)
#pragma unroll
        for (int c = 0; c < 2; ++c)
#pragma unroll
          for (int i = 0; i < 8; ++i) {
            macc[a][c][2 * i] += __uint_as_float(sg[a][c][i] << 16) * au[a][c][2 * i];
            macc[a][c][2 * i + 1] += __uint_as_float(sg[a][c][i] & 0xffff0000u) * au[a][c][2 * i + 1];
          }
    }
    const int tid = TIDX, lane = tid & 63, wid = tid >> 6, wr = wid >> 1, wc = wid & 1, r = lane & 31, h = lane >> 5;
#pragma unroll
    for (int a = 0; a < 2; ++a)
#pragma unroll
      for (int c = 0; c < 2; ++c)
#pragma unroll
        for (int i = 0; i < 16; ++i)
          mg[(size_t)(mt * 256 + wr * 64 + a * 32 + crow(i, h)) * 1024 + nt * 128 + wc * 64 + c * 32 + r] = f2bf(macc[a][c][i]);
  }
}

constexpr int NPHASE = 1 + 2 * 14 + 1;

DI void run_phase(const Params& p, int ph, char* lds, int rep = 0) {
#ifdef TESTQ
  if (ph == 0) { if (TESTQ == 100) phase0(p, lds); return; }
  if ((ph - 1) % 14 != TESTQ) return;
#endif
  if (ph == 0) { phase0(p, lds); return; }
  if (ph == NPHASE - 1) { final_norm_phase(p.out, p.in[I_FINN]); return; }
  const int layer = (ph - 1) / 14, q = (ph - 1) % 14;
  const bf16_t* wl = (const bf16_t*)(p.ws + OFF_W) + (size_t)layer * W_LAYER;
  bf16_t* hn = (bf16_t*)(p.ws + OFF_HN);
  switch (q) {
    case 0: { EpiSwiglu e{(bf16_t*)(p.ws + OFF_FFH)}; gemm_phase(hn, 1024, wl + OW_GU1, 1024, 1024, 128, 44, 4, e, lds); } break;
    case 1: { EpiResid e{layer == 0 ? p.in[I_X] : p.out, p.out, 0.5f}; gemm_phase((const bf16_t*)(p.ws + OFF_FFH), DFF, wl + OW_DN1, DFF, DFF, 128, 8, 4, e, lds, true); } break;
    case 2: rms_phase(p.out, p.in[I_MIXN] + layer * 1024, hn); break;
    case 3: { EpiWin e{p.ws}; gemm_phase(hn, 1024, wl + OW_INM, 1024, 1024, 128, 25, 5, e, lds); } break;
    case 4: {
      { EpiGelu e{(bf16_t*)(p.ws + OFF_H1K), (const float*)(p.ws + OFF_MISC + 256) + (layer * 2 + 0) * 256}; gemm_phase((const bf16_t*)(p.ws + OFF_KCMP), 1024, wl + OW_PK1, 2048, 2048, 16, 2, 2, e, lds); }
      { EpiGelu e{(bf16_t*)(p.ws + OFF_H1V), (const float*)(p.ws + OFF_MISC + 256) + (layer * 2 + 1) * 256}; gemm_phase((const bf16_t*)(p.ws + OFF_VCMP), 1024, wl + OW_PV1, 2048, 2048, 16, 2, 2, e, lds); }
      kmean_phase(p);
      filler_items(p, layer, lds, 0);
    } break;
    case 5: {
      { EpiCmpOut<0> e{(bf16_t*)(p.ws + OFF_KC)}; gemm_phase((const bf16_t*)(p.ws + OFF_H1K), 256, wl + OW_PK2, 256, 256, 16, 1, 1, e, lds); }
      { EpiCmpOut<1> e{(bf16_t*)(p.ws + OFF_VCT)}; gemm_phase((const bf16_t*)(p.ws + OFF_H1V), 256, wl + OW_PV2, 256, 256, 16, 1, 1, e, lds); }
      filler_items(p, layer, lds, 1);
    } break;
    case 6: phaseX(p, layer, lds, rep); break;
    case 7: phaseY(p, layer, lds, rep); break;
    case 8: merge_phase(p, layer, lds); break;
    case 9: { EpiResid e{p.out, p.out, 1.0f}; gemm_phase((const bf16_t*)(p.ws + OFF_MERGED), 1024, wl + OW_WO, 1024, 1024, 128, 8, 4, e, lds); } break;
    case 10: rms_phase(p.out, p.in[I_F2N] + layer * 1024, hn); break;
    case 11: { EpiSwiglu e{(bf16_t*)(p.ws + OFF_FFH)}; gemm_phase(hn, 1024, wl + OW_GU2, 1024, 1024, 128, 44, 4, e, lds); } break;
    case 12: { EpiResid e{p.out, p.out, 0.5f}; gemm_phase((const bf16_t*)(p.ws + OFF_FFH), DFF, wl + OW_DN2, DFF, DFF, 128, 8, 4, e, lds, true); } break;
    default: if (layer == 0) rms_phase(p.out, p.in[I_F1N] + 1024, hn); break;
  }
}


DI void grid_barrier(unsigned* ctr, unsigned target) {
  __syncthreads();
  if (threadIdx.x == 0) {
    __threadfence();
    __hip_atomic_fetch_add(ctr, 1u, __ATOMIC_RELAXED, __HIP_MEMORY_SCOPE_AGENT);
    unsigned spins = 0;
    while (__hip_atomic_load(ctr, __ATOMIC_RELAXED, __HIP_MEMORY_SCOPE_AGENT) < target && spins < (1u << 26)) { __builtin_amdgcn_s_sleep(2); ++spins; }
    __threadfence();
  }
  __syncthreads();
}
#if MEGA
__global__ void __launch_bounds__(NTHREADS) mega_kernel(Params p) {
  extern __shared__ __attribute__((aligned(16))) char lds[];
  cg::grid_group grid = cg::this_grid();
  unsigned bar_gen = 0;
  for (int ph = 0; ph < NPHASE; ++ph) {
#ifdef REPQ
    const int nrep = (REPQ >= 100) ? ((ph == REPQ - 100) ? 2 : 1) : ((ph > 0 && ph < NPHASE - 1 && (ph - 1) % 14 == REPQ) ? 2 : 1);
#else
    const int nrep = 1;
#endif
    if (ph == NPHASE - 2) continue;
    for (int rep = 0; rep < nrep; ++rep) {
      run_phase(p, ph, lds, rep);
      if (ph + 1 < NPHASE) {
        if (ph == 0) grid.sync();
        else { ++bar_gen; grid_barrier((unsigned*)(p.ws + OFF_MISC + 6144), bar_gen * gridDim.x); }
      }
    }
  }
}
#else
__global__ void __launch_bounds__(NTHREADS) phase_kernel(Params p, int ph) {
  extern __shared__ __attribute__((aligned(16))) char lds[];
  run_phase(p, ph, lds);
}
#endif

extern "C" void kernel_launch(void* const* d_in, const int* in_sizes, int n_in, void* d_out, int out_size, void* d_ws, size_t ws_size, hipStream_t stream) {
  Params p;
  memset(&p, 0, sizeof(p));
  for (int i = 0; i < 23; ++i) p.in[i] = (const float*)d_in[i];
  p.out = (float*)d_out;
  p.ws = (char*)d_ws;
  if (ws_size < OFF_END) fprintf(stderr, "workspace too small: %zu < %zu\n", ws_size, (size_t)OFF_END);
  static int grid_blocks = 0;
  if (!grid_blocks) {
    int dev = 0, cus = 0, per_cu = 0;
    (void)hipGetDevice(&dev);
    (void)hipDeviceGetAttribute(&cus, hipDeviceAttributeMultiprocessorCount, dev);
#if MEGA
    if (hipFuncSetAttribute((const void*)mega_kernel, hipFuncAttributeMaxDynamicSharedMemorySize, LDS_BYTES) != hipSuccess) fprintf(stderr, "hipFuncSetAttribute failed\n");
    (void)hipOccupancyMaxActiveBlocksPerMultiprocessor(&per_cu, mega_kernel, NTHREADS, LDS_BYTES);
#else
    per_cu = 1;
#endif
    if (per_cu < 1) per_cu = 1;
    if (per_cu > 2) per_cu = 2;
    grid_blocks = cus * per_cu;
  }
#if MEGA
  void* args[] = {&p};
  hipError_t e = hipLaunchCooperativeKernel((void*)mega_kernel, dim3(grid_blocks), dim3(NTHREADS), args, LDS_BYTES, stream);
  if (e != hipSuccess) fprintf(stderr, "cooperative launch failed: %s (grid %d)\n", hipGetErrorString(e), grid_blocks);
#else
  for (int ph = 0; ph < NPHASE; ++ph) phase_kernel<<<grid_blocks, NTHREADS, LDS_BYTES, stream>>>(p, ph);
#endif
}
```

```cpp
#include <hip/hip_runtime.h>
#include <hip/hip_cooperative_groups.h>
#include <stdint.h>
#include <stdio.h>
#include <string.h>
namespace cg = cooperative_groups;

#ifndef MEGA
#define MEGA 1
#endif

typedef unsigned short bf16_t;
typedef short bf16x8 __attribute__((ext_vector_type(8)));
typedef short s16x4 __attribute__((ext_vector_type(4)));
typedef float f32x16 __attribute__((ext_vector_type(16)));
typedef float f32x4 __attribute__((ext_vector_type(4)));
typedef unsigned u32x4 __attribute__((ext_vector_type(4)));
typedef unsigned u32x2 __attribute__((ext_vector_type(2)));

#define DI __device__ __forceinline__
#define MFMA32(a, b, c) __builtin_amdgcn_mfma_f32_32x32x16_bf16((a), (b), (c), 0, 0, 0)
#define NEGINF (-__builtin_inff())

constexpr int NB = 8, SEQ = 4096, DM = 1024, NT = NB * SEQ, DFF = 2816;
constexpr int NTHREADS = 512;

constexpr size_t W_GU = 5632ull * 1024, W_DN = 1024ull * 2816, W_INM = 3200ull * 1024, W_ING = 3072ull * 1024,
                 W_P1 = 256ull * 2048, W_P2 = 128ull * 256, W_UA = 1024ull * 384, W_UB = 1024ull * 256, W_UC = 1024ull * 128, W_WO = 1024ull * 1024;
constexpr size_t OW_GU1 = 0, OW_DN1 = OW_GU1 + W_GU, OW_GU2 = OW_DN1 + W_DN, OW_DN2 = OW_GU2 + W_GU, OW_INM = OW_DN2 + W_DN,
                 OW_ING = OW_INM + W_INM, OW_PK1 = OW_ING + W_ING, OW_PV1 = OW_PK1 + W_P1, OW_PK2 = OW_PV1 + W_P1, OW_PV2 = OW_PK2 + W_P2,
                 OW_UA = OW_PV2 + W_P2, OW_UB = OW_UA + W_UA, OW_UC = OW_UB + W_UB, OW_WO = OW_UC + W_UC, W_LAYER = OW_WO + W_WO;
constexpr size_t OFF_W = 0;
constexpr size_t OFF_MISC = OFF_W + 2 * W_LAYER * 2;
constexpr size_t OFF_HN = OFF_MISC + 8192;
constexpr size_t OFF_C = OFF_HN + (size_t)NT * DM * 2;
constexpr size_t OFF_FFH = OFF_C;
constexpr size_t OFF_QN = OFF_C;
constexpr size_t OFF_QM = OFF_QN + (size_t)NT * 384 * 2;
constexpr size_t OFF_QD = OFF_QM + (size_t)NT * 256 * 2;
constexpr size_t OFF_MERGED = OFF_C;
constexpr size_t SZ_G2 = 16ull * 4096 * 64 * 2;
constexpr size_t OFF_KCMP = OFF_QD + (size_t)NT * 384 * 2;
constexpr size_t OFF_VCMP = OFF_KCMP + SZ_G2 + 4096;
constexpr size_t OFF_KSEL = OFF_VCMP + SZ_G2 + 4096;
constexpr size_t OFF_VSELT = OFF_KSEL + SZ_G2;
constexpr size_t OFF_KWIN = OFF_VSELT + SZ_G2;
constexpr size_t OFF_VWINT = OFF_KWIN + SZ_G2;
constexpr size_t OFF_KM = OFF_VWINT + SZ_G2;
constexpr size_t OFF_VMT = OFF_KM + 2 * SZ_G2;
constexpr size_t OFF_KD = OFF_VMT + 2 * SZ_G2;
constexpr size_t OFF_VDT = OFF_KD + 3 * SZ_G2;
constexpr size_t OFF_GATES = OFF_VDT + 3 * SZ_G2;
constexpr size_t OFF_H1K = OFF_GATES + (size_t)NT * 18 * 4;
constexpr size_t OFF_H1V = OFF_H1K + 4096ull * 256 * 2;
constexpr size_t OFF_KC = OFF_H1V + 4096ull * 256 * 2;
constexpr size_t OFF_VCT = OFF_KC + 16ull * 256 * 64 * 2;
constexpr size_t OFF_KMEAN = OFF_VCT + 16ull * 256 * 64 * 2;
constexpr size_t OFF_SELM = OFF_KMEAN + 32ull * 16 * 64 * 2;
constexpr size_t OFF_OC = OFF_SELM + 16ull * 4096 * 8;
constexpr size_t OFF_Y = OFF_OC + (size_t)NT * 384 * 2;
constexpr size_t OFF_END = OFF_Y + (size_t)NT * 768 * 2;
static_assert(OFF_FFH + (size_t)NT * DFF * 2 <= OFF_END, "ffh fits");

struct Params {
  const float* in[23];
  float* out;
  char* ws;
};

enum { I_X = 0, I_RELB, I_F1N, I_F1G, I_F1U, I_F1D, I_MIXN, I_WIN, I_PEK, I_PEV, I_PK1, I_PK2, I_PV1, I_PV2, I_UA, I_UB, I_UC, I_WO, I_F2N, I_F2G, I_F2U, I_F2D, I_FINN };

DI int get_tid_() { int t = threadIdx.x; asm volatile("" : "+v"(t)); return t; }
#define TIDX get_tid_()
DI float shx32(float v) { const auto r = __builtin_amdgcn_permlane32_swap(__float_as_uint(v), __float_as_uint(v), false, false); return __uint_as_float((threadIdx.x & 32) ? r[0] : r[1]); }
DI int shx32i(int v) { const auto r = __builtin_amdgcn_permlane32_swap((unsigned)v, (unsigned)v, false, false); return (int)((threadIdx.x & 32) ? r[0] : r[1]); }
DI float ex2(float x) { return __builtin_amdgcn_exp2f(x); }
DI size_t kfrag_idx(int pos, int d) { return ((size_t)((pos >> 5) * 4 + (d >> 4)) * 64 + ((d >> 3) & 1) * 32 + (pos & 31)) * 8 + (d & 7); }
DI size_t vfrag_idx(int pos, int d) { return ((size_t)((pos >> 5) * 8 + ((pos >> 4) & 1) * 4 + (d >> 5) * 2 + ((pos >> 3) & 1)) * 64 + ((pos >> 2) & 1) * 32 + (d & 31)) * 4 + (pos & 3); }
DI bf16_t f2bf(float x) { unsigned r; asm("v_cvt_pk_bf16_f32 %0, %1, %1" : "=v"(r) : "v"(x)); return (bf16_t)(r & 0xffffu); }
DI float bf2f(bf16_t b) { return __uint_as_float(((unsigned)b) << 16); }
DI unsigned pack2(float a, float b) { unsigned r; asm("v_cvt_pk_bf16_f32 %0, %1, %2" : "=v"(r) : "v"(a), "v"(b)); return r; }
DI int crow(int i, int h) { return (i & 3) + 8 * (i >> 2) + 4 * h; }
DI float sigmoidf_(float x) { return 1.f / (1.f + __expf(-x)); }

DI int lds_off(int row, int chunk) { return row * 128 + ((chunk ^ ((row >> 1) & 7)) << 4); }

#define LAS __attribute__((address_space(3)))
constexpr int NSTAGE = 3;
constexpr int STAGE_B = 49152;
constexpr int LDS_BYTES = NSTAGE * STAGE_B;
DI void glds16(const void* g, char* l) { __builtin_amdgcn_global_load_lds((const unsigned*)g, (LAS unsigned*)l, 16, 0, 0); }

template <int PART = 0>
DI void gemm_core(const bf16_t* __restrict__ A, int lda, const bf16_t* __restrict__ Bt, int ldb, int K,
                  f32x16 (&acc)[2][2], char* lds) {
  const int tid = TIDX, lane = tid & 63, wid = tid >> 6, wr = wid >> 1, wc = wid & 1, r = lane & 31, h = lane >> 5;
  const int ch = (tid & 7) ^ ((tid >> 4) & 7);
  unsigned avo[4], bvo[2];
#pragma unroll
  for (int i = 0; i < 4; ++i) avo[i] = (unsigned)(((tid >> 3) + 64 * i) * lda * 2 + ch * 16);
#pragma unroll
  for (int i = 0; i < 2; ++i) bvo[i] = (unsigned)(((tid >> 3) + 64 * i) * ldb * 2 + ch * 16);
  const char* Ab = (const char*)A; const char* Bb = (const char*)Bt;
  char* lw = lds + tid * 16;
  const int nk = K >> 6;
  const unsigned swz = (unsigned)((r >> 1) & 7);
  const unsigned arow_u = (unsigned)((wr * 64 + r) * 128), brow_u = (unsigned)((wc * 64 + r) * 128);
  const unsigned co0 = ((0u + h) ^ swz) << 4, co1 = ((2u + h) ^ swz) << 4, co2 = ((4u + h) ^ swz) << 4, co3 = ((6u + h) ^ swz) << 4;
#define GEMM_ISSUE(kt_, st_) do { char* sb_ = lw + (st_) * STAGE_B; const char* ak_ = Ab + (size_t)(kt_) * 128; const char* bk_ = Bb + (size_t)(kt_) * 128; \
    _Pragma("unroll") for (int i_ = 0; i_ < 4; ++i_) glds16(ak_ + avo[i_], sb_ + i_ * 8192); \
    _Pragma("unroll") for (int i_ = 0; i_ < 2; ++i_) glds16(bk_ + bvo[i_], sb_ + 32768 + i_ * 8192); } while (0)
  if (PART != 2) {
    GEMM_ISSUE(0, 0);
    if (nk > 1) GEMM_ISSUE(1, 1);
  }
  if (PART == 1) return;
  int st = 0;
  for (int kt = 0; kt < nk; ++kt) {
    if (kt + 1 < nk) asm volatile("s_waitcnt vmcnt(6)" ::: "memory");
    else asm volatile("s_waitcnt vmcnt(0)" ::: "memory");
    __builtin_amdgcn_s_barrier();
    asm volatile("" ::: "memory");
    if (kt + 2 < nk) { const int st2 = (st >= 1) ? st - 1 : 2; GEMM_ISSUE(kt + 2, st2); }
    const char* la = lds + st * STAGE_B;
    const char* lb = la + 32768;
    const unsigned sa_u = (unsigned)(size_t)la + arow_u, sb_u = (unsigned)(size_t)lb + brow_u;
    const unsigned a0 = sa_u + co0, a1 = sa_u + co1, a2 = sa_u + co2, a3 = sa_u + co3;
    const unsigned b0 = sb_u + co0, b1 = sb_u + co1, b2 = sb_u + co2, b3 = sb_u + co3;
    {
      bf16x8 p0, p1, q0, q1, u0, u1, w0, w1;
      asm volatile(
        "ds_read_b128 %4, %12\n\tds_read_b128 %5, %12 offset:4096\n\tds_read_b128 %6, %16\n\tds_read_b128 %7, %16 offset:4096\n\t"
        "ds_read_b128 %8, %13\n\tds_read_b128 %9, %13 offset:4096\n\tds_read_b128 %10, %17\n\tds_read_b128 %11, %17 offset:4096\n\t"
        "s_waitcnt lgkmcnt(4)\n\t"
        "v_mfma_f32_32x32x16_bf16 %0, %4, %6, %0\n\tv_mfma_f32_32x32x16_bf16 %1, %4, %7, %1\n\tv_mfma_f32_32x32x16_bf16 %2, %5, %6, %2\n\tv_mfma_f32_32x32x16_bf16 %3, %5, %7, %3\n\t"
        "ds_read_b128 %4, %14\n\tds_read_b128 %5, %14 offset:4096\n\tds_read_b128 %6, %18\n\tds_read_b128 %7, %18 offset:4096\n\t"
        "s_waitcnt lgkmcnt(4)\n\t"
        "v_mfma_f32_32x32x16_bf16 %0, %8, %10, %0\n\tv_mfma_f32_32x32x16_bf16 %1, %8, %11, %1\n\tv_mfma_f32_32x32x16_bf16 %2, %9, %10, %2\n\tv_mfma_f32_32x32x16_bf16 %3, %9, %11, %3\n\t"
        "ds_read_b128 %8, %15\n\tds_read_b128 %9, %15 offset:4096\n\tds_read_b128 %10, %19\n\tds_read_b128 %11, %19 offset:4096\n\t"
        "s_waitcnt lgkmcnt(4)\n\t"
        "v_mfma_f32_32x32x16_bf16 %0, %4, %6, %0\n\tv_mfma_f32_32x32x16_bf16 %1, %4, %7, %1\n\tv_mfma_f32_32x32x16_bf16 %2, %5, %6, %2\n\tv_mfma_f32_32x32x16_bf16 %3, %5, %7, %3\n\t"
        "s_waitcnt lgkmcnt(0)\n\t"
        "v_mfma_f32_32x32x16_bf16 %0, %8, %10, %0\n\tv_mfma_f32_32x32x16_bf16 %1, %8, %11, %1\n\tv_mfma_f32_32x32x16_bf16 %2, %9, %10, %2\n\tv_mfma_f32_32x32x16_bf16 %3, %9, %11, %3"
        : "+v"(acc[0][0]), "+v"(acc[0][1]), "+v"(acc[1][0]), "+v"(acc[1][1]),
          "=&v"(p0), "=&v"(p1), "=&v"(q0), "=&v"(q1), "=&v"(u0), "=&v"(u1), "=&v"(w0), "=&v"(w1)
        : "v"(a0), "v"(a1), "v"(a2), "v"(a3), "v"(b0), "v"(b1), "v"(b2), "v"(b3));
    }
    st = (st == 2) ? 0 : st + 1;
  }
  asm volatile("s_nop 15\n\ts_nop 15\n\ts_nop 7" ::: "memory");
  __builtin_amdgcn_s_barrier();
  asm volatile("" ::: "memory");
}

DI void zero_acc(f32x16 (&acc)[2][2]) {
#pragma unroll
  for (int a = 0; a < 2; ++a)
#pragma unroll
    for (int b = 0; b < 2; ++b)
#pragma unroll
      for (int i = 0; i < 16; ++i) acc[a][b][i] = 0.f;
}

DI bool tile_map(int L, int MT, int NTl, int SN, int& mt, int& nt) {
  const int xcd = L & 7, ix = L >> 3, per = 8 * SN, st = ix / per, w = ix % per;
  const int gst = st * 8 + xcd, SNT = NTl / SN, total = (MT >> 3) * SNT;
  if (gst >= total) return false;
  const int smt = gst / SNT, snt = gst % SNT;
  mt = smt * 8 + (w & 7); nt = snt * SN + (w >> 3);
  return true;
}
DI int tile_lmax(int MT, int NTl, int SN) { const int total = (MT >> 3) * (NTl / SN); return ((total + 7) >> 3) * 8 * SN * 8; }

struct EpiSwiglu {
  static constexpr bool PRE = false;
  bf16_t* ffh;
  DI void operator()(const f32x16 (&acc)[2][2], int m0, int n0) const {
    const int tid = TIDX, lane = tid & 63, wid = tid >> 6, wr = wid >> 1, wc = wid & 1, r = lane & 31, h = lane >> 5;
    const int hid = (n0 >> 7) * 64 + wc * 32 + r;
#pragma unroll
    for (int mi = 0; mi < 2; ++mi)
#pragma unroll
      for (int i = 0; i < 16; ++i) {
        const int row = m0 + wr * 64 + mi * 32 + crow(i, h);
        const float g = acc[mi][0][i], u = acc[mi][1][i];
        ffh[(size_t)row * DFF + hid] = f2bf(g * sigmoidf_(g) * u);
      }
  }
};
struct EpiResid {
  const float* res; float* out; float scale;
  static constexpr bool PRE = true;
  DI void pre(float (&rv)[2][2][16], int m0, int n0) const {
    const int tid = TIDX, lane = tid & 63, wid = tid >> 6, wr = wid >> 1, wc = wid & 1, r = lane & 31, h = lane >> 5;
#pragma unroll
    for (int mi = 0; mi < 2; ++mi)
#pragma unroll
      for (int ni = 0; ni < 2; ++ni)
#pragma unroll
        for (int i = 0; i < 16; ++i)
          rv[mi][ni][i] = res[(size_t)(m0 + wr * 64 + mi * 32 + crow(i, h)) * DM + n0 + wc * 64 + ni * 32 + r];
  }
  DI void operator()(const f32x16 (&acc)[2][2], int m0, int n0, const float (&rv)[2][2][16]) const {
    const int tid = TIDX, lane = tid & 63, wid = tid >> 6, wr = wid >> 1, wc = wid & 1, r = lane & 31, h = lane >> 5;
#pragma unroll
    for (int mi = 0; mi < 2; ++mi)
#pragma unroll
      for (int ni = 0; ni < 2; ++ni)
#pragma unroll
        for (int i = 0; i < 16; ++i)
          out[(size_t)(m0 + wr * 64 + mi * 32 + crow(i, h)) * DM + n0 + wc * 64 + ni * 32 + r] = rv[mi][ni][i] + scale * acc[mi][ni][i];
  }
};
struct EpiGelu {
  static constexpr bool PRE = false;
  bf16_t* o; const float* bias;
  DI void operator()(const f32x16 (&acc)[2][2], int m0, int n0) const {
    const int tid = TIDX, lane = tid & 63, wid = tid >> 6, wr = wid >> 1, wc = wid & 1, r = lane & 31, h = lane >> 5;
#pragma unroll
    for (int mi = 0; mi < 2; ++mi)
#pragma unroll
      for (int ni = 0; ni < 2; ++ni) {
        const int col = n0 + wc * 64 + ni * 32 + r;
        const float bv = bias[col];
#pragma unroll
        for (int i = 0; i < 16; ++i) {
          const int row = m0 + wr * 64 + mi * 32 + crow(i, h);
          const float x = acc[mi][ni][i] + bv;
          o[(size_t)row * 256 + col] = f2bf(x * sigmoidf_(1.5957691216057308f * (x + 0.044715f * x * x * x)));
        }
      }
  }
};
template <int transposed> struct EpiCmpOut {
  static constexpr bool PRE = false;
  bf16_t* o;
  DI void operator()(const f32x16 (&acc)[2][2], int m0, int n0) const {
    const int tid = TIDX, lane = tid & 63, wid = tid >> 6, wr = wid >> 1, wc = wid & 1, r = lane & 31, h = lane >> 5;
    if (wc != 0) return;
#pragma unroll
    for (int mi = 0; mi < 2; ++mi)
#pragma unroll
      for (int ni = 0; ni < 2; ++ni) {
        const int col = ni * 32 + r;
#pragma unroll
        for (int i = 0; i < 16; ++i) {
          const int row = m0 + wr * 64 + mi * 32 + crow(i, h);
          const bf16_t v = f2bf(acc[mi][ni][i]);
          if (transposed) o[(size_t)(row >> 8) * 16384 + vfrag_idx(row & 255, col)] = v;
          else o[(size_t)(row >> 8) * 16384 + kfrag_idx(row & 255, col)] = v;
        }
      }
  }
};
struct EpiWin {
  static constexpr bool PRE = false;
  char* ws;
  DI void operator()(const f32x16 (&acc)[2][2], int m0, int n0) const {
    const int tid = TIDX, lane = tid & 63, wid = tid >> 6, wr = wid >> 1, wc = wid & 1, r = lane & 31, h = lane >> 5;
    const int cidx = (n0 >> 6) + wc;
    if (cidx >= 49) return;
    const int rowbase = m0 + wr * 64;
    const int b = rowbase >> 12;
    int kind;
    bf16_t* base; int ld = 0, colb = 0, hb = 0, dil = 1; bool kfrag = false;
    if (cidx < 6) { kind = 0; base = (bf16_t*)(ws + OFF_QN); ld = 384; colb = cidx * 64; }
    else if (cidx < 18) { const int t = (cidx - 6) >> 1, g = (cidx - 6) & 1; hb = b * 2 + g;
      const size_t off = (t == 0) ? OFF_KCMP : (t == 1) ? OFF_VCMP : (t == 2) ? OFF_KSEL : (t == 3) ? OFF_VSELT : (t == 4) ? OFF_KWIN : OFF_VWINT;
      base = (bf16_t*)(ws + off); kind = (t == 3 || t == 5) ? 2 : 1; kfrag = (t == 2 || t == 4); }
    else if (cidx < 22) { kind = 0; base = (bf16_t*)(ws + OFF_QM); ld = 256; colb = (cidx - 18) * 64; }
    else if (cidx < 26) { kind = 1; kfrag = true; base = (bf16_t*)(ws + OFF_KM); hb = b * 4 + (cidx - 22); }
    else if (cidx < 30) { kind = 2; base = (bf16_t*)(ws + OFF_VMT); hb = b * 4 + (cidx - 26); }
    else if (cidx < 36) { kind = 0; base = (bf16_t*)(ws + OFF_QD); ld = 384; colb = (cidx - 30) * 64; }
    else if (cidx < 42) { kind = 1; kfrag = true; base = (bf16_t*)(ws + OFF_KD); hb = b * 6 + (cidx - 36); const int g = (cidx - 36) >> 1; dil = (g == 0) ? 1 : (g == 1 ? 4 : 16); }
    else if (cidx < 48) { kind = 2; base = (bf16_t*)(ws + OFF_VDT); hb = b * 6 + (cidx - 42); const int g = (cidx - 42) >> 1; dil = (g == 0) ? 1 : (g == 1 ? 4 : 16); }
    else { kind = 3; base = nullptr; }
    if (kind == 0) {
#pragma unroll
      for (int mi = 0; mi < 2; ++mi)
#pragma unroll
        for (int ni = 0; ni < 2; ++ni)
#pragma unroll
          for (int i = 0; i < 16; ++i) {
            const int row = rowbase + mi * 32 + crow(i, h);
            base[(size_t)row * ld + colb + ni * 32 + r] = f2bf(acc[mi][ni][i] * 0.18033688011112042f);
          }
    } else if (kind == 1) {
#pragma unroll
      for (int mi = 0; mi < 2; ++mi)
#pragma unroll
        for (int ni = 0; ni < 2; ++ni)
#pragma unroll
          for (int i = 0; i < 16; ++i) {
            const int s = (rowbase & 4095) + mi * 32 + crow(i, h);
            if (kfrag) { const int pos = (dil == 1) ? s : (s % dil) * (4096 / dil) + s / dil; base[(size_t)hb * 262144 + kfrag_idx(pos, ni * 32 + r)] = f2bf(acc[mi][ni][i]); }
            else base[((size_t)hb * 4096 + s) * 64 + ni * 32 + r] = f2bf(acc[mi][ni][i]);
          }
    } else if (kind == 2) {
      if (dil == 1) {
#pragma unroll
        for (int mi = 0; mi < 2; ++mi)
#pragma unroll
          for (int ni = 0; ni < 2; ++ni)
#pragma unroll
            for (int q = 0; q < 4; ++q) {
              const int s = (rowbase & 4095) + mi * 32 + 8 * q + 4 * h;
              u32x2 v; v.x = pack2(acc[mi][ni][4 * q], acc[mi][ni][4 * q + 1]); v.y = pack2(acc[mi][ni][4 * q + 2], acc[mi][ni][4 * q + 3]);
              *(u32x2*)(base + (size_t)hb * 262144 + vfrag_idx(s, ni * 32 + r)) = v;
            }
      } else {
        const int L = 4096 / dil;
#pragma unroll
        for (int mi = 0; mi < 2; ++mi)
#pragma unroll
          for (int ni = 0; ni < 2; ++ni)
#pragma unroll
            for (int i = 0; i < 16; ++i) {
              const int s = (rowbase & 4095) + mi * 32 + crow(i, h);
              const int pos = (s % dil) * L + s / dil;
              base[(size_t)hb * 262144 + vfrag_idx(pos, ni * 32 + r)] = f2bf(acc[mi][ni][i]);
            }
      }
    } else {
      float* gt = (float*)(ws + OFF_GATES);
      if (r < 18) {
#pragma unroll
        for (int mi = 0; mi < 2; ++mi)
#pragma unroll
          for (int i = 0; i < 16; ++i) {
            const int row = rowbase + mi * 32 + crow(i, h);
            gt[(size_t)row * 18 + r] = sigmoidf_(acc[mi][0][i]);
          }
      }
    }
  }
};

template <class Epi>
DI void gemm_phase(const bf16_t* A, int lda, const bf16_t* Bt, int ldb, int K, int MT, int NTl, int SN, const Epi& epi, char* lds, bool rev = false) {
  const int lmax = tile_lmax(MT, NTl, SN);
  int L = blockIdx.x, mt = 0, nt = 0;
  bool have = false;
  for (; L < lmax; L += gridDim.x) if (tile_map(L, MT, NTl, SN, mt, nt)) { have = true; if (rev) mt = MT - 1 - mt; break; }
  f32x16 dummy[2][2];
  if (have) gemm_core<1>(A + (size_t)mt * 256 * lda, lda, Bt + (size_t)nt * 128 * ldb, ldb, K, dummy, lds);
  while (have) {
    f32x16 acc[2][2];
    zero_acc(acc);
    const int cmt = mt, cnt = nt;
    float rv[Epi::PRE ? 2 : 1][2][16];
    if constexpr (Epi::PRE) epi.pre(rv, cmt * 256, cnt * 128);
    gemm_core<2>(A + (size_t)cmt * 256 * lda, lda, Bt + (size_t)cnt * 128 * ldb, ldb, K, acc, lds);
    have = false;
    for (L += gridDim.x; L < lmax; L += gridDim.x) if (tile_map(L, MT, NTl, SN, mt, nt)) { have = true; if (rev) mt = MT - 1 - mt; break; }
    if (have) gemm_core<1>(A + (size_t)mt * 256 * lda, lda, Bt + (size_t)nt * 128 * ldb, ldb, K, dummy, lds);
    if constexpr (Epi::PRE) epi(acc, cmt * 256, cnt * 128, rv); else epi(acc, cmt * 256, cnt * 128);
  }
}

struct ConvD { const float* src; const float* src2; bf16_t* dst; int K, Nsrc, Nout, mode, coloff, nvalid; };
constexpr int CONV_NT[14] = {1408, 704, 1408, 704, 800, 768, 128, 128, 8, 8, 96, 64, 32, 256};
constexpr int CONV_PER_LAYER = 6512;

DI ConvD get_conv(const Params& p, int l, int id) {
  ConvD c; c.src2 = nullptr; c.mode = 0; c.coloff = 0;
  bf16_t* wl = (bf16_t*)(p.ws + OFF_W) + (size_t)l * W_LAYER;
  switch (id) {
    case 0: c.src = p.in[I_F1G] + (size_t)l * 1024 * DFF; c.src2 = p.in[I_F1U] + (size_t)l * 1024 * DFF; c.dst = wl + OW_GU1; c.K = 1024; c.Nsrc = DFF; c.Nout = 5632; c.mode = 1; c.nvalid = 5632; break;
    case 1: c.src = p.in[I_F1D] + (size_t)l * DFF * 1024; c.dst = wl + OW_DN1; c.K = DFF; c.Nsrc = 1024; c.Nout = 1024; c.nvalid = 1024; break;
    case 2: c.src = p.in[I_F2G] + (size_t)l * 1024 * DFF; c.src2 = p.in[I_F2U] + (size_t)l * 1024 * DFF; c.dst = wl + OW_GU2; c.K = 1024; c.Nsrc = DFF; c.Nout = 5632; c.mode = 1; c.nvalid = 5632; break;
    case 3: c.src = p.in[I_F2D] + (size_t)l * DFF * 1024; c.dst = wl + OW_DN2; c.K = DFF; c.Nsrc = 1024; c.Nout = 1024; c.nvalid = 1024; break;
    case 4: c.src = p.in[I_WIN] + (size_t)l * 1024 * 6162; c.dst = wl + OW_INM; c.K = 1024; c.Nsrc = 6162; c.Nout = 3200; c.mode = 2; c.nvalid = 3090; break;
    case 5: c.src = p.in[I_WIN] + (size_t)l * 1024 * 6162; c.dst = wl + OW_ING; c.K = 1024; c.Nsrc = 6162; c.Nout = 3072; c.coloff = 3090; c.nvalid = 3072; break;
    case 6: c.src = p.in[I_PK1] + (size_t)l * 2048 * 256; c.dst = wl + OW_PK1; c.K = 2048; c.Nsrc = 256; c.Nout = 256; c.nvalid = 256; break;
    case 7: c.src = p.in[I_PV1] + (size_t)l * 2048 * 256; c.dst = wl + OW_PV1; c.K = 2048; c.Nsrc = 256; c.Nout = 256; c.nvalid = 256; break;
    case 8: c.src = p.in[I_PK2] + (size_t)l * 256 * 64; c.dst = wl + OW_PK2; c.K = 256; c.Nsrc = 64; c.Nout = 128; c.nvalid = 64; break;
    case 9: c.src = p.in[I_PV2] + (size_t)l * 256 * 64; c.dst = wl + OW_PV2; c.K = 256; c.Nsrc = 64; c.Nout = 128; c.nvalid = 64; break;
    case 10: c.src = p.in[I_UA] + (size_t)l * 384 * 1024; c.dst = wl + OW_UA; c.K = 384; c.Nsrc = 1024; c.Nout = 1024; c.nvalid = 1024; break;
    case 11: c.src = p.in[I_UB] + (size_t)l * 256 * 1024; c.dst = wl + OW_UB; c.K = 256; c.Nsrc = 1024; c.Nout = 1024; c.nvalid = 1024; break;
    case 12: c.src = p.in[I_UC] + (size_t)l * 128 * 1024; c.dst = wl + OW_UC; c.K = 128; c.Nsrc = 1024; c.Nout = 1024; c.nvalid = 1024; break;
    default: c.src = p.in[I_WO] + (size_t)l * 1024 * 1024; c.dst = wl + OW_WO; c.K = 1024; c.Nsrc = 1024; c.Nout = 1024; c.nvalid = 1024; break;
  }
  return c;
}

DI void conv_tile(const ConvD& c, int tn, int tk, float* lds) {
  const int tid = TIDX;
  const int n0 = tn * 64, k0 = tk * 64;
  {
    const int j = tid & 63, np = n0 + j;
    const float* sp = c.src; int col = -1;
    if (c.mode == 0) { if (np < c.nvalid) col = c.coloff + np; }
    else if (c.mode == 1) { const int tile = np >> 7, within = np & 127, wc = within >> 6, part = (within & 63) >> 5, jj = within & 31;
      col = tile * 64 + wc * 32 + jj; if (part) sp = c.src2; }
    else { if (np < 1152) col = np; else if (np < 3072) col = 1170 + (np - 1152); else if (np < 3090) col = 1152 + (np - 3072); }
    float tv[8];
#pragma unroll
    for (int i = 0; i < 8; ++i) {
      const int kk = (tid >> 6) + 8 * i;
      tv[i] = (col >= 0) ? sp[(size_t)(k0 + kk) * c.Nsrc + col] : 0.f;
    }
#pragma unroll
    for (int i = 0; i < 8; ++i) lds[((tid >> 6) + 8 * i) * 65 + j] = tv[i];
  }
  __syncthreads();
  {
    const int kk = tid & 63;
#pragma unroll
    for (int i = 0; i < 8; ++i) {
      const int j = (tid >> 6) + 8 * i;
      c.dst[(size_t)(n0 + j) * c.K + k0 + kk] = f2bf(lds[kk * 65 + j]);
    }
  }
  __syncthreads();
}

DI void rms_phase(const float* x, const float* gain, bf16_t* hn) {
  const int lane = TIDX & 63;
  const int gw = blockIdx.x * 8 + (TIDX >> 6), nw = gridDim.x * 8;
  f32x4 g[4];
#pragma unroll
  for (int i = 0; i < 4; ++i) g[i] = *(const f32x4*)(gain + i * 256 + lane * 4);
  for (int row = gw; row < NT; row += 2 * nw) {
    const int row2 = (row + nw < NT) ? row + nw : row;
    f32x4 v[4], w2[4]; float ss = 0.f, ss2 = 0.f;
#pragma unroll
    for (int i = 0; i < 4; ++i) { v[i] = *(const f32x4*)(x + (size_t)row * DM + i * 256 + lane * 4); w2[i] = *(const f32x4*)(x + (size_t)row2 * DM + i * 256 + lane * 4); }
#pragma unroll
    for (int i = 0; i < 4; ++i) { ss += v[i][0] * v[i][0] + v[i][1] * v[i][1] + v[i][2] * v[i][2] + v[i][3] * v[i][3]; ss2 += w2[i][0] * w2[i][0] + w2[i][1] * w2[i][1] + w2[i][2] * w2[i][2] + w2[i][3] * w2[i][3]; }
#pragma unroll
    for (int o = 32; o >= 1; o >>= 1) { ss += __shfl_xor(ss, o); ss2 += __shfl_xor(ss2, o); }
    const float rs = rsqrtf(ss * (1.f / 1024.f) + 1e-6f), rs2 = rsqrtf(ss2 * (1.f / 1024.f) + 1e-6f);
#pragma unroll
    for (int i = 0; i < 4; ++i) {
      u32x2 w; w.x = pack2(v[i][0] * rs * g[i][0], v[i][1] * rs * g[i][1]); w.y = pack2(v[i][2] * rs * g[i][2], v[i][3] * rs * g[i][3]);
      *(u32x2*)(hn + (size_t)row * DM + i * 256 + lane * 4) = w;
      u32x2 w3; w3.x = pack2(w2[i][0] * rs2 * g[i][0], w2[i][1] * rs2 * g[i][1]); w3.y = pack2(w2[i][2] * rs2 * g[i][2], w2[i][3] * rs2 * g[i][3]);
      *(u32x2*)(hn + (size_t)row2 * DM + i * 256 + lane * 4) = w3;
    }
  }
}
DI void final_norm_phase(float* x, const float* gain) {
  const int lane = TIDX & 63;
  const int gw = blockIdx.x * 8 + (TIDX >> 6), nw = gridDim.x * 8;
  f32x4 g[4];
#pragma unroll
  for (int i = 0; i < 4; ++i) g[i] = *(const f32x4*)(gain + i * 256 + lane * 4);
  for (int row = gw; row < NT; row += nw) {
    f32x4 v[4]; float ss = 0.f;
#pragma unroll
    for (int i = 0; i < 4; ++i) { v[i] = *(const f32x4*)(x + (size_t)row * DM + i * 256 + lane * 4); ss += v[i][0] * v[i][0] + v[i][1] * v[i][1] + v[i][2] * v[i][2] + v[i][3] * v[i][3]; }
#pragma unroll
    for (int o = 32; o >= 1; o >>= 1) ss += __shfl_xor(ss, o);
    const float rs = rsqrtf(ss * (1.f / 1024.f) + 1e-6f);
#pragma unroll
    for (int i = 0; i < 4; ++i) {
      f32x4 w; w[0] = v[i][0] * rs * g[i][0]; w[1] = v[i][1] * rs * g[i][1]; w[2] = v[i][2] * rs * g[i][2]; w[3] = v[i][3] * rs * g[i][3];
      *(f32x4*)(x + (size_t)row * DM + i * 256 + lane * 4) = w;
    }
  }
}

DI void phase0(const Params& p, char* lds) {
  if (blockIdx.x == 0 && TIDX < 64) { ((unsigned*)(p.ws + OFF_MISC))[TIDX] = 0u; ((unsigned*)(p.ws + OFF_MISC + 6144))[TIDX] = 0u; }
  for (int it = blockIdx.x; it < 4; it += gridDim.x) {
    const int l = it >> 1, kv = it & 1;
    const float* pe = p.in[kv ? I_PEV : I_PEK] + (size_t)l * 2048;
    const float* w = p.in[kv ? I_PV1 : I_PK1] + (size_t)l * 2048 * 256;
    const int n = TIDX;
    if (n < 256) {
      float s = 0.f;
      for (int k = 0; k < 2048; ++k) s += pe[k] * w[(size_t)k * 256 + n];
      ((float*)(p.ws + OFF_MISC + 256))[it * 256 + n] = s;
    }
  }
  for (int w = blockIdx.x; w < 2 * CONV_PER_LAYER; w += gridDim.x) {
    const int l = w / CONV_PER_LAYER; int ww = w % CONV_PER_LAYER; int id = 0;
#pragma unroll
    for (int i = 0; i < 14; ++i) { if (id == i && ww >= CONV_NT[i]) { ww -= CONV_NT[i]; id = i + 1; } }
    const ConvD c = get_conv(p, l, id);
    const int ntn = c.Nout >> 6;
    conv_tile(c, ww % ntn, ww / ntn, (float*)lds);
  }
  rms_phase(p.in[I_X], p.in[I_F1N], (bf16_t*)(p.ws + OFF_HN));
}

constexpr int BK_THR[15] = {22, 30, 40, 54, 73, 99, 134, 182, 246, 332, 450, 609, 825, 1117, 1513};
struct AttnSt { float m, l; f32x16 o0, o1; };
DI void attn_init(AttnSt& st) { st.m = NEGINF; st.l = 0.f;
#pragma unroll
  for (int i = 0; i < 16; ++i) { st.o0[i] = 0.f; st.o1[i] = 0.f; } }

DI void load_q(bf16x8 (&qf)[4], const bf16_t* qrow) {
#pragma unroll
  for (int s = 0; s < 4; ++s) qf[s] = *(const bf16x8*)(qrow + 16 * s);
}
DI f32x16 qk_tile(const bf16x8 (&qf)[4], const bf16_t* krow) {
  f32x16 s;
#pragma unroll
  for (int i = 0; i < 16; ++i) s[i] = 0.f;
#pragma unroll
  for (int ss = 0; ss < 4; ++ss) { const bf16x8 kf = *(const bf16x8*)(krow + 512 * ss); s = MFMA32(kf, qf[ss], s); }
  return s;
}
DI void pv_tile(AttnSt& st, const float (&pr)[16], const bf16_t* v0, size_t rowstride) {
#pragma unroll
  for (int s2 = 0; s2 < 2; ++s2) {
    u32x4 pk; pk.x = pack2(pr[8 * s2], pr[8 * s2 + 1]); pk.y = pack2(pr[8 * s2 + 2], pr[8 * s2 + 3]); pk.z = pack2(pr[8 * s2 + 4], pr[8 * s2 + 5]); pk.w = pack2(pr[8 * s2 + 6], pr[8 * s2 + 7]);
    const bf16x8 pb = __builtin_bit_cast(bf16x8, pk);
    {
      const s16x4 lo = *(const s16x4*)(v0 + 256 * (s2 * 4 + 0)), hi = *(const s16x4*)(v0 + 256 * (s2 * 4 + 1));
      const bf16x8 va = __builtin_shufflevector(lo, hi, 0, 1, 2, 3, 4, 5, 6, 7);
      st.o0 = MFMA32(va, pb, st.o0);
    }
    {
      const s16x4 lo = *(const s16x4*)(v0 + 256 * (s2 * 4 + 2)), hi = *(const s16x4*)(v0 + 256 * (s2 * 4 + 3));
      const bf16x8 va = __builtin_shufflevector(lo, hi, 0, 1, 2, 3, 4, 5, 6, 7);
      st.o1 = MFMA32(va, pb, st.o1);
    }
  }
}
DI void softmax_step(AttnSt& st, const float (&lg)[16], const bf16_t* v0, size_t rowstride) {
  float mx = NEGINF;
#pragma unroll
  for (int i = 0; i < 16; ++i) mx = fmaxf(mx, lg[i]);
  mx = fmaxf(mx, shx32(mx));
  if (__ballot(mx > NEGINF) == 0ull) return;
  const float mnew = fmaxf(st.m, mx);
  const float muse = (mnew == NEGINF) ? 0.f : mnew;
  const float alpha = ex2(st.m - muse);
  float pr[16]; float rs = 0.f;
#pragma unroll
  for (int i = 0; i < 16; ++i) { pr[i] = ex2(lg[i] - muse); rs += pr[i]; }
  st.l = st.l * alpha + rs; st.m = mnew;
#pragma unroll
  for (int i = 0; i < 16; ++i) { st.o0[i] *= alpha; st.o1[i] *= alpha; }
  pv_tile(st, pr, v0, rowstride);
}

struct KVT { bf16x8 k[4]; s16x4 v[8]; };
DI void load_kv(KVT& t, const bf16_t* krow, const bf16_t* v0, size_t rowstride) {
#pragma unroll
  for (int ss = 0; ss < 4; ++ss) t.k[ss] = *(const bf16x8*)(krow + 512 * ss);
#pragma unroll
  for (int j = 0; j < 8; ++j) t.v[j] = *(const s16x4*)(v0 + 256 * j);
}
DI void softmax_step_r(AttnSt& st, const float (&lg)[16], const KVT& t) {
  float mx = NEGINF;
#pragma unroll
  for (int i = 0; i < 16; ++i) mx = fmaxf(mx, lg[i]);
  mx = fmaxf(mx, shx32(mx));
  if (__ballot(mx > NEGINF) == 0ull) return;
  const float mnew = fmaxf(st.m, mx);
  const float muse = (mnew == NEGINF) ? 0.f : mnew;
  const float alpha = ex2(st.m - muse);
  float pr[16]; float rs = 0.f;
#pragma unroll
  for (int i = 0; i < 16; ++i) { pr[i] = ex2(lg[i] - muse); rs += pr[i]; }
  st.l = st.l * alpha + rs;
  if (__ballot(mnew != st.m) != 0ull) {
#pragma unroll
    for (int i = 0; i < 16; ++i) { st.o0[i] *= alpha; st.o1[i] *= alpha; }
  }
  st.m = mnew;
#pragma unroll
  for (int s2 = 0; s2 < 2; ++s2) {
    u32x4 pk; pk.x = pack2(pr[8 * s2], pr[8 * s2 + 1]); pk.y = pack2(pr[8 * s2 + 2], pr[8 * s2 + 3]); pk.z = pack2(pr[8 * s2 + 4], pr[8 * s2 + 5]); pk.w = pack2(pr[8 * s2 + 6], pr[8 * s2 + 7]);
    const bf16x8 pb = __builtin_bit_cast(bf16x8, pk);
    const bf16x8 va0 = __builtin_shufflevector(t.v[s2 * 4 + 0], t.v[s2 * 4 + 1], 0, 1, 2, 3, 4, 5, 6, 7);
    st.o0 = MFMA32(va0, pb, st.o0);
    const bf16x8 va1 = __builtin_shufflevector(t.v[s2 * 4 + 2], t.v[s2 * 4 + 3], 0, 1, 2, 3, 4, 5, 6, 7);
    st.o1 = MFMA32(va1, pb, st.o1);
  }
}
template <class KP, class VP, class ACT, class FILL>
DI void attn_loop(AttnSt& st, const bf16x8 (&qf)[4], int k0, int k1, size_t vstride, KP kp, VP vp, ACT act, FILL fill) {
  KVT cur, nxt;
  {
    KVT t0; load_kv(t0, kp(k0), vp(k0), vstride);
#pragma unroll
    for (int i = 0; i < 8; ++i) cur.v[i] = t0.v[i];
#pragma unroll
    for (int i = 0; i < 4; ++i) cur.k[i] = t0.k[i];
  }
  f32x16 s_cur;
  { const float z = 0.f;
#pragma unroll
    for (int i = 0; i < 16; ++i) s_cur[i] = z; }
#pragma unroll
  for (int ss = 0; ss < 4; ++ss) s_cur = MFMA32(cur.k[ss], qf[ss], s_cur);
  {
    const int kn = (k0 < k1) ? k0 + 1 : k1;
    const bf16_t* krow = kp(kn);
#pragma unroll
    for (int ss = 0; ss < 4; ++ss) nxt.k[ss] = *(const bf16x8*)(krow + 512 * ss);
  }
  for (int kt = k0; kt <= k1; ++kt) {
    const int kn = (kt < k1) ? kt + 1 : k1;
    const int kn2 = (kt + 2 <= k1) ? kt + 2 : k1;
    {
      const bf16_t* v0 = vp(kn);
#pragma unroll
      for (int j = 0; j < 8; ++j) nxt.v[j] = *(const s16x4*)(v0 + 256 * j);
    }
    bf16x8 k2[4];
    {
      const bf16_t* krow = kp(kn2);
#pragma unroll
      for (int ss = 0; ss < 4; ++ss) k2[ss] = *(const bf16x8*)(krow + 512 * ss);
    }
    f32x16 s_next;
#pragma unroll
    for (int i = 0; i < 16; ++i) s_next[i] = 0.f;
#pragma unroll
    for (int ss = 0; ss < 4; ++ss) s_next = MFMA32(nxt.k[ss], qf[ss], s_next);
    if (act(kt)) {
      float lg[16];
      fill(kt, s_cur, lg);
      softmax_step_r(st, lg, cur);
    }
    s_cur = s_next;
#pragma unroll
    for (int i = 0; i < 8; ++i) cur.v[i] = nxt.v[i];
#pragma unroll
    for (int ss = 0; ss < 4; ++ss) nxt.k[ss] = k2[ss];
  }
}

DI float lut_bias(const unsigned char* blut, const float* tblh, int dist) {
  const int d = dist < 0 ? 0 : (dist > 2048 ? 2048 : dist);
  return tblh[blut[d]];
}
DI void bias16(const unsigned char* blut, const float* tblh, const int (&dist)[16], float (&bv)[16]) {
  int bk[16];
#pragma unroll
  for (int i = 0; i < 16; ++i) { const int d = dist[i] < 0 ? 0 : (dist[i] > 2048 ? 2048 : dist[i]); bk[i] = blut[d]; }
#pragma unroll
  for (int i = 0; i < 16; ++i) asm volatile("" : "+v"(bk[i]));
#pragma unroll
  for (int i = 0; i < 16; ++i) bv[i] = tblh[bk[i]];
#pragma unroll
  for (int i = 0; i < 16; ++i) asm volatile("" : "+v"(bv[i]));
}
DI void store_o(bf16_t* dst, const f32x16& o0, const f32x16& o1, int h) {
#pragma unroll
  for (int g = 0; g < 4; ++g) {
    u32x2 a; a.x = pack2(o0[4 * g], o0[4 * g + 1]); a.y = pack2(o0[4 * g + 2], o0[4 * g + 3]);
    *(u32x2*)(dst + 8 * g + 4 * h) = a;
    u32x2 b; b.x = pack2(o1[4 * g], o1[4 * g + 1]); b.y = pack2(o1[4 * g + 2], o1[4 * g + 3]);
    *(u32x2*)(dst + 32 + 8 * g + 4 * h) = b;
  }
}

DI void build_lut(unsigned char* blut, float* tbl, const float* rel_bias) {
  for (int n = TIDX; n < 2049; n += NTHREADS) {
    int bk = n;
    if (n >= 16) { bk = 16;
#pragma unroll
      for (int k = 0; k < 15; ++k) bk += (n >= BK_THR[k]) ? 1 : 0; }
    blut[n] = (unsigned char)bk;
  }
  for (int i = TIDX; i < 512; i += NTHREADS) { const int hd = i >> 5, bk = i & 31; tbl[i] = rel_bias[bk * 16 + hd] * 1.4426950408889634f; }
  __syncthreads();
}

DI int wave_fetch(unsigned* ctr) {
  int v = 0;
  if ((TIDX & 63) == 0) v = (int)atomicAdd(ctr, 1u);
  return __shfl(v, 0);
}

DI void nsa_cmp_item(const Params& p, int item, const unsigned char* blut, const float* tbl, float* impw) {
  const int lane = TIDX & 63, r = lane & 31, h = lane >> 5;
  const int qb = 127 - (item >> 4), bg = item & 15, b = bg >> 1, g = bg & 1;
  const int t = qb * 32 + r;
  const int ntile = (qb >> 4) + 1;
  const bf16_t* KC = (const bf16_t*)(p.ws + OFF_KC) + (size_t)bg * 256 * 64;
  const bf16_t* VCT = (const bf16_t*)(p.ws + OFF_VCT) + (size_t)bg * 64 * 256;
  const float* gates = (const float*)(p.ws + OFF_GATES) + (size_t)(b * 4096 + t) * 18;
#pragma unroll 4
  for (int j = 0; j < 32; ++j) impw[r * 65 + 2 * j + h] = 0.f;
  for (int rr = 0; rr < 3; ++rr) {
    const int head = g * 3 + rr;
    const float* tblh = tbl + head * 32;
    bf16x8 qf[4];
    load_q(qf, (const bf16_t*)(p.ws + OFF_QN) + (size_t)(b * 4096 + t) * 384 + head * 64 + 8 * h);
    float m = NEGINF, l = 0.f;
    for (int kt = 0; kt < ntile; ++kt) {
      const f32x16 s = qk_tile(qf, KC + (size_t)kt * 2048 + (h * 32 + r) * 8);
      float lg[16]; float mx = NEGINF;
      int dist[16]; float bv[16];
#pragma unroll
      for (int i = 0; i < 16; ++i) dist[i] = t - (16 * (kt * 32 + crow(i, h)) + 31);
      bias16(blut, tblh, dist, bv);
#pragma unroll
      for (int i = 0; i < 16; ++i) { lg[i] = (dist[i] >= 0) ? s[i] + bv[i] : NEGINF; mx = fmaxf(mx, lg[i]); }
      mx = fmaxf(mx, shx32(mx));
      const float mnew = fmaxf(m, mx), muse = (mnew == NEGINF) ? 0.f : mnew;
      float rs = 0.f;
#pragma unroll
      for (int i = 0; i < 16; ++i) rs += ex2(lg[i] - muse);
      l = l * ex2(m - muse) + rs; m = mnew;
    }
    l += shx32(l);
    const float muse = (m == NEGINF) ? 0.f : m;
    const float inv = (l > 0.f) ? 1.f / l : 0.f;
    AttnSt st; attn_init(st);
    float prev3 = 0.f;
#pragma unroll 1
    for (int kt = 0; kt < ntile; ++kt) {
      {
        const f32x16 s = qk_tile(qf, KC + (size_t)kt * 2048 + (h * 32 + r) * 8);
        float pr[16];
        int dist[16]; float bv[16];
#pragma unroll
        for (int i = 0; i < 16; ++i) dist[i] = t - (16 * (kt * 32 + crow(i, h)) + 31);
        bias16(blut, tblh, dist, bv);
#pragma unroll
        for (int i = 0; i < 16; ++i) pr[i] = (dist[i] >= 0) ? ex2(s[i] + bv[i] - muse) * inv : 0.f;
        float recv[4];
#pragma unroll
        for (int q = 0; q < 4; ++q) recv[q] = shx32(pr[4 * q + 3]);
#pragma unroll
        for (int q = 0; q < 4; ++q) {
          const float qs = (pr[4 * q] + pr[4 * q + 1]) + (pr[4 * q + 2] + pr[4 * q + 3]);
          const float cin = h ? recv[q] : (q ? recv[q > 0 ? q - 1 : 0] : prev3);
          impw[r * 65 + 8 * kt + 2 * q + h] += qs + cin;
        }
        prev3 = recv[3];
        pv_tile(st, pr, VCT + (size_t)kt * 2048 + (h * 32 + r) * 4, 256);
      }
    }
    const float g0 = gates[head * 3 + 0];
#pragma unroll
    for (int i = 0; i < 16; ++i) { st.o0[i] *= g0; st.o1[i] *= g0; }
    store_o((bf16_t*)(p.ws + OFF_OC) + (size_t)(b * 4096 + t) * 384 + head * 64, st.o0, st.o1, h);
  }
  const int cur = t >> 6;
  unsigned long long mask;
  if (cur < 16) {
    mask = (2ull << cur) - 1ull;
  } else {
    float own[32], oth[32];
#pragma unroll
    for (int j = 0; j < 32; ++j) {
      const int u = 2 * j + h, uo = 2 * j + 1 - h;
      const float a = impw[r * 65 + u], bb = impw[r * 65 + uo];
      own[j] = ((u >= 1) && (u <= cur - 2)) ? a : -1.f;
      oth[j] = ((uo >= 1) && (uo <= cur - 2)) ? bb : -1.f;
    }
    float prev = __builtin_inff();
#pragma unroll 1
    for (int round = 0; round < 13; ++round) {
      float m = -2.f;
#pragma unroll
      for (int j = 0; j < 32; ++j) { m = fmaxf(m, own[j] < prev ? own[j] : -2.f); m = fmaxf(m, oth[j] < prev ? oth[j] : -2.f); }
      prev = m;
    }
    unsigned mlo = 0u, mhi = 0u;
#pragma unroll
    for (int j = 0; j < 32; ++j) {
      const int u = 2 * j + h;
      const bool forced = (u == 0) || (u == cur) || (u == cur - 1);
      const bool cand = (u >= 1) && (u <= cur - 2);
      const bool sel = forced || (cand && own[j] >= prev);
      if (j < 16) mlo |= sel ? (1u << u) : 0u; else mhi |= sel ? (1u << (u - 32)) : 0u;
    }
    mlo |= (unsigned)shx32i((int)mlo);
    mhi |= (unsigned)shx32i((int)mhi);
    mask = ((unsigned long long)mhi << 32) | mlo;
  }
  if (h == 0) ((unsigned long long*)(p.ws + OFF_SELM))[(size_t)bg * 4096 + t] = mask;
}

DI void nsa_win_item(const Params& p, int b, int head, int qb, const unsigned char* blut, const float* tbl) {
  const int lane = TIDX & 63, r = lane & 31, h = lane >> 5;
  const int g = head / 3, bg = b * 2 + g;
  const int t = qb * 32 + r;
  const float* tblh = tbl + head * 32;
  bf16x8 qf[4];
  load_q(qf, (const bf16_t*)(p.ws + OFF_QN) + (size_t)(b * 4096 + t) * 384 + head * 64 + 8 * h);
  const float g2 = ((const float*)(p.ws + OFF_GATES))[(size_t)(b * 4096 + t) * 18 + head * 3 + 2];
  f32x16 y0, y1;
#pragma unroll
  for (int i = 0; i < 16; ++i) { y0[i] = 0.f; y1[i] = 0.f; }
  {
    const bf16_t* K = (const bf16_t*)(p.ws + OFF_KWIN) + (size_t)bg * 4096 * 64;
    const bf16_t* Vt = (const bf16_t*)(p.ws + OFF_VWINT) + (size_t)bg * 64 * 4096;
    AttnSt st; attn_init(st);
    const int k0 = qb >= 16 ? qb - 16 : 0;
    attn_loop(st, qf, k0, qb, 32,
      [&](int kt) { return K + (size_t)kt * 2048 + (h * 32 + r) * 8; },
      [&](int kt) { return Vt + (size_t)kt * 2048 + (h * 32 + r) * 4; },
      [&](int kt) { return true; },
      [&](int kt, const f32x16& s, float (&lg)[16]) {
        int dist[16]; float bv[16];
#pragma unroll
        for (int i = 0; i < 16; ++i) dist[i] = t - (kt * 32 + crow(i, h));
        bias16(blut, tblh, dist, bv);
#pragma unroll
        for (int i = 0; i < 16; ++i) lg[i] = (dist[i] >= 0 && dist[i] < 512) ? s[i] + bv[i] : NEGINF;
      });
    float l = st.l + shx32(st.l);
    const float sc = (l > 0.f) ? g2 / l : 0.f;
#pragma unroll
    for (int i = 0; i < 16; ++i) { y0[i] += sc * st.o0[i]; y1[i] += sc * st.o1[i]; }
  }
  store_o((bf16_t*)(p.ws + OFF_Y) + (size_t)(b * 4096 + t) * 768 + head * 64, y0, y1, h);
}

DI void nsa_main_item(const Params& p, int b, int head, int qb, const unsigned char* blut, const float* tbl) {
  const int lane = TIDX & 63, r = lane & 31, h = lane >> 5;
  const int g = head / 3, bg = b * 2 + g;
  const int t = qb * 32 + r;
  const float* tblh = tbl + head * 32;
  bf16x8 qf[4];
  load_q(qf, (const bf16_t*)(p.ws + OFF_QN) + (size_t)(b * 4096 + t) * 384 + head * 64 + 8 * h);
  const unsigned long long selm = ((const unsigned long long*)(p.ws + OFF_SELM))[(size_t)bg * 4096 + t];
  const float* gates = (const float*)(p.ws + OFF_GATES) + (size_t)(b * 4096 + t) * 18 + head * 3;
  const float g1 = gates[1];
  f32x16 y0, y1;
  {
    const bf16_t* oc = (const bf16_t*)(p.ws + OFF_OC) + (size_t)(b * 4096 + t) * 384 + head * 64;
    const bf16_t* yw = (const bf16_t*)(p.ws + OFF_Y) + (size_t)(b * 4096 + t) * 768 + head * 64;
#pragma unroll
    for (int i = 0; i < 16; ++i) { y0[i] = bf2f(oc[crow(i, h)]) + bf2f(yw[crow(i, h)]); y1[i] = bf2f(oc[32 + crow(i, h)]) + bf2f(yw[32 + crow(i, h)]); }
  }
  {
    const bf16_t* K = (const bf16_t*)(p.ws + OFF_KSEL) + (size_t)bg * 4096 * 64;
    const bf16_t* Vt = (const bf16_t*)(p.ws + OFF_VSELT) + (size_t)bg * 64 * 4096;
    AttnSt st; attn_init(st);
    attn_loop(st, qf, 0, qb, 32,
      [&](int kt) { return K + (size_t)kt * 2048 + (h * 32 + r) * 8; },
      [&](int kt) { return Vt + (size_t)kt * 2048 + (h * 32 + r) * 4; },
      [&](int kt) { return __ballot((selm >> (kt >> 1)) & 1ull) != 0ull; },
      [&](int kt, const f32x16& s, float (&lg)[16]) {
        const bool bs = (selm >> (kt >> 1)) & 1ull;
        if (qb * 32 - (kt * 32 + 31) >= 1513) {
          const float b31 = tblh[31];
#pragma unroll
          for (int i = 0; i < 16; ++i) lg[i] = bs ? s[i] + b31 : NEGINF;
        } else {
          int dist[16]; float bv[16];
#pragma unroll
          for (int i = 0; i < 16; ++i) dist[i] = t - (kt * 32 + crow(i, h));
          bias16(blut, tblh, dist, bv);
#pragma unroll
          for (int i = 0; i < 16; ++i) lg[i] = (bs && dist[i] >= 0) ? s[i] + bv[i] : NEGINF;
        }
      });
    float l = st.l + shx32(st.l);
    const float sc = (l > 0.f) ? g1 / l : 0.f;
#pragma unroll
    for (int i = 0; i < 16; ++i) { y0[i] += sc * st.o0[i]; y1[i] += sc * st.o1[i]; }
  }
  store_o((bf16_t*)(p.ws + OFF_Y) + (size_t)(b * 4096 + t) * 768 + head * 64, y0, y1, h);
}

DI void moba_item(const Params& p, int b, int hd, int qb, const unsigned char* blut, const float* tbl) {
  const int lane = TIDX & 63, r = lane & 31, h = lane >> 5;
  const int bh = b * 4 + hd;
  const int t = qb * 32 + r;
  const int c = qb >> 3;
  const float* tblh = tbl + (6 + hd) * 32;
  bf16x8 qf[4];
  load_q(qf, (const bf16_t*)(p.ws + OFF_QM) + (size_t)(b * 4096 + t) * 256 + hd * 64 + 8 * h);
  unsigned mmask = 0u;
  if (c > 0) {
    const bf16_t* km = (const bf16_t*)(p.ws + OFF_KMEAN) + (size_t)bh * 16 * 64 + (size_t)(r & 15) * 64 + 8 * h;
    f32x16 s;
#pragma unroll
    for (int i = 0; i < 16; ++i) s[i] = 0.f;
#pragma unroll
    for (int ss = 0; ss < 4; ++ss) {
      bf16x8 kf = *(const bf16x8*)(km + 16 * ss);
      if (r >= 16) {
#pragma unroll
        for (int j = 0; j < 8; ++j) kf[j] = 0;
      }
      s = MFMA32(kf, qf[ss], s);
    }
    float g16[16];
#pragma unroll
    for (int i = 0; i < 8; ++i) {
      const float own = s[i], oth = shx32(own);
      const int base = (i & 3) + 8 * (i >> 2);
      g16[base] = h ? oth : own;
      g16[base + 4] = h ? own : oth;
    }
#pragma unroll
    for (int n = 0; n < 16; ++n) g16[n] = (n < c) ? g16[n] : NEGINF;
#pragma unroll
    for (int round = 0; round < 3; ++round) {
      float best = NEGINF; int bi = -1;
#pragma unroll
      for (int n = 0; n < 16; ++n) if (g16[n] > best) { best = g16[n]; bi = n; }
      if (bi >= 0) mmask |= 1u << bi;
#pragma unroll
      for (int n = 0; n < 16; ++n) if (n == bi) g16[n] = NEGINF;
    }
  }
  mmask |= 1u << c;
  const bf16_t* K = (const bf16_t*)(p.ws + OFF_KM) + (size_t)bh * 4096 * 64;
  const bf16_t* Vt = (const bf16_t*)(p.ws + OFF_VMT) + (size_t)bh * 64 * 4096;
  AttnSt st; attn_init(st);
  attn_loop(st, qf, 0, qb, 32,
    [&](int kt) { return K + (size_t)kt * 2048 + (h * 32 + r) * 8; },
    [&](int kt) { return Vt + (size_t)kt * 2048 + (h * 32 + r) * 4; },
    [&](int kt) { return __ballot((mmask >> (kt >> 3)) & 1u) != 0ull; },
    [&](int kt, const f32x16& s, float (&lg)[16]) {
      const bool bs = (mmask >> (kt >> 3)) & 1u;
      if (qb * 32 - (kt * 32 + 31) >= 1513) {
        const float b31 = tblh[31];
#pragma unroll
        for (int i = 0; i < 16; ++i) lg[i] = bs ? s[i] + b31 : NEGINF;
      } else {
        int dist[16]; float bv[16];
#pragma unroll
        for (int i = 0; i < 16; ++i) dist[i] = t - (kt * 32 + crow(i, h));
        bias16(blut, tblh, dist, bv);
#pragma unroll
        for (int i = 0; i < 16; ++i) lg[i] = (bs && dist[i] >= 0) ? s[i] + bv[i] : NEGINF;
      }
    });
  float l = st.l + shx32(st.l);
  const float sc = (l > 0.f) ? 1.f / l : 0.f;
#pragma unroll
  for (int i = 0; i < 16; ++i) { st.o0[i] *= sc; st.o1[i] *= sc; }
  store_o((bf16_t*)(p.ws + OFF_Y) + (size_t)(b * 4096 + t) * 768 + 384 + hd * 64, st.o0, st.o1, h);
}

DI void dil_item(const Params& p, int b, int j, int qi, const unsigned char* blut, const float* tbl) {
  const int lane = TIDX & 63, r = lane & 31, h = lane >> 5;
  const int rho = qi & 15, ub = qi >> 4;
  const int t = rho + 16 * (ub * 32 + r);
  const int tmin = rho + 16 * (ub * 32), tmax = rho + 16 * (ub * 32 + 31);
  AttnSt st; attn_init(st);
#pragma unroll
  for (int g = 0; g < 3; ++g) {
    const int dil = (g == 0) ? 1 : (g == 1 ? 4 : 16), window = 128 * dil, L = 4096 / dil;
    const int hd = 2 * g + j;
    const float* tblh = tbl + (10 + hd) * 32;
    const int rg = rho % dil;
    bf16x8 qf[4];
    load_q(qf, (const bf16_t*)(p.ws + OFF_QD) + (size_t)(b * 4096 + t) * 384 + hd * 64 + 8 * h);
    const bf16_t* K = (const bf16_t*)(p.ws + OFF_KD) + (size_t)(b * 6 + hd) * 4096 * 64;
    const bf16_t* Vt = (const bf16_t*)(p.ws + OFF_VDT) + (size_t)(b * 6 + hd) * 64 * 4096 + (size_t)(rg * L >> 5) * 2048;
    int vlo = tmin / dil - 128; if (vlo < 0) vlo = 0;
    const int vhi = tmax / dil;
    attn_loop(st, qf, vlo >> 5, vhi >> 5, 32,
      [&](int kt) { return K + (size_t)((rg * L >> 5) + kt) * 2048 + (h * 32 + r) * 8; },
      [&](int kt) { return Vt + (size_t)kt * 2048 + (h * 32 + r) * 4; },
      [&](int kt) { return true; },
      [&](int kt, const f32x16& s, float (&lg)[16]) {
        int dist[16]; float bv[16];
#pragma unroll
        for (int i = 0; i < 16; ++i) dist[i] = t - ((kt * 32 + crow(i, h)) * dil + rg);
        bias16(blut, tblh, dist, bv);
#pragma unroll
        for (int i = 0; i < 16; ++i) lg[i] = (dist[i] >= 0 && dist[i] <= window) ? s[i] + bv[i] : NEGINF;
      });
  }
  float l = st.l + shx32(st.l);
  const float sc = (l > 0.f) ? 1.f / l : 0.f;
#pragma unroll
  for (int i = 0; i < 16; ++i) { st.o0[i] *= sc; st.o1[i] *= sc; }
  store_o((bf16_t*)(p.ws + OFF_Y) + (size_t)(b * 4096 + t) * 768 + 640 + j * 64, st.o0, st.o1, h);
}

DI void phaseX(const Params& p, int layer, char* lds, int rep = 0) {
  unsigned char* blut = (unsigned char*)lds; float* tbl = (float*)(lds + 4096);
  build_lut(blut, tbl, p.in[I_RELB]);
  unsigned* ctr = (unsigned*)(p.ws + OFF_MISC) + layer * 2 + rep * 8;
  for (;;) {
    const int item = wave_fetch(ctr);
    if (item >= 2048 + 32 * 48) break;
    if (item < 2048) nsa_cmp_item(p, item, blut, tbl, (float*)(lds + 8192) + (TIDX >> 6) * (32 * 65));
    else { const int it2 = item - 2048, qb = 31 - it2 / 48, sub = it2 % 48; nsa_win_item(p, sub / 6, sub % 6, qb, blut, tbl); }
  }
  __syncthreads();
}
DI void filler_items(const Params& p, int layer, char* lds, int which) {
  __syncthreads();
  unsigned char* blut = (unsigned char*)lds; float* tbl = (float*)(lds + 4096);
  build_lut(blut, tbl, p.in[I_RELB]);
  unsigned* ctr = (unsigned*)(p.ws + OFF_MISC) + 16 + layer * 2 + which;
  for (;;) {
    const int item = wave_fetch(ctr);
    if (which == 0) {
      if (item >= 128 * 16 + 96 * 48) break;
      if (item < 128 * 16) { const int qb = 127 - item / 16, sub = item % 16; dil_item(p, sub >> 1, sub & 1, qb, blut, tbl); }
      else { const int it2 = item - 128 * 16, qb = 127 - it2 / 48, sub = it2 % 48; nsa_win_item(p, sub / 6, sub % 6, qb, blut, tbl); }
    }
    else { if (item >= 128 * 32) break; const int qb = 127 - item / 32, sub = item % 32; moba_item(p, sub >> 2, sub & 3, qb, blut, tbl); }
  }
  __syncthreads();
}
DI void phaseY(const Params& p, int layer, char* lds, int rep = 0) {
  unsigned char* blut = (unsigned char*)lds; float* tbl = (float*)(lds + 4096);
  build_lut(blut, tbl, p.in[I_RELB]);
  unsigned* ctr = (unsigned*)(p.ws + OFF_MISC) + layer * 2 + 1 + rep * 8;
  for (;;) {
    const int item = wave_fetch(ctr);
    if (item >= 128 * 48) break;
    const int qb = 127 - item / 48, sub = item % 48;
    nsa_main_item(p, sub / 6, sub % 6, qb, blut, tbl);
  }
  __syncthreads();
}

DI void kmean_phase(const Params& p) {
  const int lane = TIDX & 63;
  const int gw = blockIdx.x * 8 + (TIDX >> 6), nw = gridDim.x * 8;
  const bf16_t* KM = (const bf16_t*)(p.ws + OFF_KM);
  bf16_t* o = (bf16_t*)(p.ws + OFF_KMEAN);
  for (int it = gw; it < 512; it += nw) {
    const bf16_t* src = KM + (size_t)it * 256 * 64;
    float s = 0.f;
    for (int k = 0; k < 256; ++k) s += bf2f(KM[(size_t)(it >> 4) * 262144 + kfrag_idx((it & 15) * 256 + k, lane)]);
    o[it * 64 + lane] = f2bf(s * (1.f / 256.f));
  }
}

DI void merge_phase(const Params& p, int layer, char* lds) {
  const bf16_t* wl = (const bf16_t*)(p.ws + OFF_W) + (size_t)layer * W_LAYER;
  const bf16_t* hn = (const bf16_t*)(p.ws + OFF_HN);
  const bf16_t* y = (const bf16_t*)(p.ws + OFF_Y);
  bf16_t* mg = (bf16_t*)(p.ws + OFF_MERGED);
  const int lmax = tile_lmax(128, 8, 4);
  for (int L = blockIdx.x; L < lmax; L += gridDim.x) {
    int mt, nt;
    if (!tile_map(L, 128, 8, 4, mt, nt)) continue;
    f32x16 macc[2][2];
    zero_acc(macc);
#pragma unroll 1
    for (int br = 0; br < 3; ++br) {
      const int kw = (br == 0) ? 384 : (br == 1 ? 256 : 128);
      const int yo = (br == 0) ? 0 : (br == 1 ? 384 : 640);
      const bf16_t* wu = wl + ((br == 0) ? OW_UA : (br == 1 ? OW_UB : OW_UC));
      unsigned sg[2][2][8];
      {
        f32x16 ag[2][2];
        zero_acc(ag);
        gemm_core(hn + (size_t)mt * 256 * 1024, 1024, wl + OW_ING + (size_t)(br * 1024 + nt * 128) * 1024, 1024, 1024, ag, lds);
#pragma unroll
        for (int a = 0; a < 2; ++a)
#pragma unroll
          for (int c = 0; c < 2; ++c)
#pragma unroll
            for (int i = 0; i < 8; ++i) sg[a][c][i] = pack2(sigmoidf_(ag[a][c][2 * i]), sigmoidf_(ag[a][c][2 * i + 1]));
      }
      f32x16 au[2][2];
      zero_acc(au);
      gemm_core(y + (size_t)mt * 256 * 768 + yo, 768, wu + (size_t)nt * 128 * kw, kw, kw, au, lds);
#pragma unroll
      for (int a = 0; a < 2; ++a)
#pragma unroll
        for (int c = 0; c < 2; ++c)
#pragma unroll
          for (int i = 0; i < 8; ++i) {
            macc[a][c][2 * i] += __uint_as_float(sg[a][c][i] << 16) * au[a][c][2 * i];
            macc[a][c][2 * i + 1] += __uint_as_float(sg[a][c][i] & 0xffff0000u) * au[a][c][2 * i + 1];
          }
    }
    const int tid = TIDX, lane = tid & 63, wid = tid >> 6, wr = wid >> 1, wc = wid & 1, r = lane & 31, h = lane >> 5;
#pragma unroll
    for (int a = 0; a < 2; ++a)
#pragma unroll
      for (int c = 0; c < 2; ++c)
#pragma unroll
        for (int i = 0; i < 16; ++i)
          mg[(size_t)(mt * 256 + wr * 64 + a * 32 + crow(i, h)) * 1024 + nt * 128 + wc * 64 + c * 32 + r] = f2bf(macc[a][c][i]);
  }
}

constexpr int NPHASE = 1 + 2 * 14 + 1;

DI void run_phase(const Params& p, int ph, char* lds, int rep = 0) {
#ifdef TESTQ
  if (ph == 0) { if (TESTQ == 100) phase0(p, lds); return; }
  if ((ph - 1) % 14 != TESTQ) return;
#endif
  if (ph == 0) { phase0(p, lds); return; }
  if (ph == NPHASE - 1) { final_norm_phase(p.out, p.in[I_FINN]); return; }
  const int layer = (ph - 1) / 14, q = (ph - 1) % 14;
  const bf16_t* wl = (const bf16_t*)(p.ws + OFF_W) + (size_t)layer * W_LAYER;
  bf16_t* hn = (bf16_t*)(p.ws + OFF_HN);
  switch (q) {
    case 0: { EpiSwiglu e{(bf16_t*)(p.ws + OFF_FFH)}; gemm_phase(hn, 1024, wl + OW_GU1, 1024, 1024, 128, 44, 4, e, lds); } break;
    case 1: { EpiResid e{layer == 0 ? p.in[I_X] : p.out, p.out, 0.5f}; gemm_phase((const bf16_t*)(p.ws + OFF_FFH), DFF, wl + OW_DN1, DFF, DFF, 128, 8, 4, e, lds, true); } break;
    case 2: rms_phase(p.out, p.in[I_MIXN] + layer * 1024, hn); break;
    case 3: { EpiWin e{p.ws}; gemm_phase(hn, 1024, wl + OW_INM, 1024, 1024, 128, 25, 5, e, lds); } break;
    case 4: {
      { EpiGelu e{(bf16_t*)(p.ws + OFF_H1K), (const float*)(p.ws + OFF_MISC + 256) + (layer * 2 + 0) * 256}; gemm_phase((const bf16_t*)(p.ws + OFF_KCMP), 1024, wl + OW_PK1, 2048, 2048, 16, 2, 2, e, lds); }
      { EpiGelu e{(bf16_t*)(p.ws + OFF_H1V), (const float*)(p.ws + OFF_MISC + 256) + (layer * 2 + 1) * 256}; gemm_phase((const bf16_t*)(p.ws + OFF_VCMP), 1024, wl + OW_PV1, 2048, 2048, 16, 2, 2, e, lds); }
      kmean_phase(p);
      filler_items(p, layer, lds, 0);
    } break;
    case 5: {
      { EpiCmpOut<0> e{(bf16_t*)(p.ws + OFF_KC)}; gemm_phase((const bf16_t*)(p.ws + OFF_H1K), 256, wl + OW_PK2, 256, 256, 16, 1, 1, e, lds); }
      { EpiCmpOut<1> e{(bf16_t*)(p.ws + OFF_VCT)}; gemm_phase((const bf16_t*)(p.ws + OFF_H1V), 256, wl + OW_PV2, 256, 256, 16, 1, 1, e, lds); }
      filler_items(p, layer, lds, 1);
    } break;
    case 6: phaseX(p, layer, lds, rep); break;
    case 7: phaseY(p, layer, lds, rep); break;
    case 8: merge_phase(p, layer, lds); break;
    case 9: { EpiResid e{p.out, p.out, 1.0f}; gemm_phase((const bf16_t*)(p.ws + OFF_MERGED), 1024, wl + OW_WO, 1024, 1024, 128, 8, 4, e, lds); } break;
    case 10: rms_phase(p.out, p.in[I_F2N] + layer * 1024, hn); break;
    case 11: { EpiSwiglu e{(bf16_t*)(p.ws + OFF_FFH)}; gemm_phase(hn, 1024, wl + OW_GU2, 1024, 1024, 128, 44, 4, e, lds); } break;
    case 12: { EpiResid e{p.out, p.out, 0.5f}; gemm_phase((const bf16_t*)(p.ws + OFF_FFH), DFF, wl + OW_DN2, DFF, DFF, 128, 8, 4, e, lds, true); } break;
    default: if (layer == 0) rms_phase(p.out, p.in[I_F1N] + 1024, hn); break;
  }
}


DI void grid_barrier(unsigned* ctr, unsigned target) {
  __syncthreads();
  if (threadIdx.x == 0) {
    __threadfence();
    __hip_atomic_fetch_add(ctr, 1u, __ATOMIC_RELAXED, __HIP_MEMORY_SCOPE_AGENT);
    unsigned spins = 0;
    while (__hip_atomic_load(ctr, __ATOMIC_RELAXED, __HIP_MEMORY_SCOPE_AGENT) < target && spins < (1u << 26)) { __builtin_amdgcn_s_sleep(2); ++spins; }
    __threadfence();
  }
  __syncthreads();
}
#if MEGA
__global__ void __launch_bounds__(NTHREADS) mega_kernel(Params p) {
  extern __shared__ __attribute__((aligned(16))) char lds[];
  cg::grid_group grid = cg::this_grid();
  unsigned bar_gen = 0;
  for (int ph = 0; ph < NPHASE; ++ph) {
#ifdef REPQ
    const int nrep = (REPQ >= 100) ? ((ph == REPQ - 100) ? 2 : 1) : ((ph > 0 && ph < NPHASE - 1 && (ph - 1) % 14 == REPQ) ? 2 : 1);
#else
    const int nrep = 1;
#endif
    if (ph == NPHASE - 2) continue;
    for (int rep = 0; rep < nrep; ++rep) {
      run_phase(p, ph, lds, rep);
      if (ph + 1 < NPHASE) {
        if (ph == 0) grid.sync();
        else { ++bar_gen; grid_barrier((unsigned*)(p.ws + OFF_MISC + 6144), bar_gen * gridDim.x); }
      }
    }
  }
}
#else
__global__ void __launch_bounds__(NTHREADS) phase_kernel(Params p, int ph) {
  extern __shared__ __attribute__((aligned(16))) char lds[];
  run_phase(p, ph, lds);
}
#endif

extern "C" void kernel_launch(void* const* d_in, const int* in_sizes, int n_in, void* d_out, int out_size, void* d_ws, size_t ws_size, hipStream_t stream) {
  Params p;
  memset(&p, 0, sizeof(p));
  for (int i = 0; i < 23; ++i) p.in[i] = (const float*)d_in[i];
  p.out = (float*)d_out;
  p.ws = (char*)d_ws;
  if (ws_size < OFF_END) fprintf(stderr, "workspace too small: %zu < %zu\n", ws_size, (size_t)OFF_END);
  static int grid_blocks = 0;
  if (!grid_blocks) {
    int dev = 0, cus = 0, per_cu = 0;
    (void)hipGetDevice(&dev);
    (void)hipDeviceGetAttribute(&cus, hipDeviceAttributeMultiprocessorCount, dev);
#if MEGA
    if (hipFuncSetAttribute((const void*)mega_kernel, hipFuncAttributeMaxDynamicSharedMemorySize, LDS_BYTES) != hipSuccess) fprintf(stderr, "hipFuncSetAttribute failed\n");
    (void)hipOccupancyMaxActiveBlocksPerMultiprocessor(&per_cu, mega_kernel, NTHREADS, LDS_BYTES);
#else
    per_cu = 1;
#endif
    if (per_cu < 1) per_cu = 1;
    if (per_cu > 2) per_cu = 2;
    grid_blocks = cus * per_cu;
  }
#if MEGA
  void* args[] = {&p};
  hipError_t e = hipLaunchCooperativeKernel((void*)mega_kernel, dim3(grid_blocks), dim3(NTHREADS), args, LDS_BYTES, stream);
  if (e != hipSuccess) fprintf(stderr, "cooperative launch failed: %s (grid %d)\n", hipGetErrorString(e), grid_blocks);
#else
  for (int ph = 0; ph < NPHASE; ++ph) phase_kernel<<<grid_blocks, NTHREADS, LDS_BYTES, stream>>>(p, ph);
#endif
}
```
